# Optimizing an MI355X kernel written in HIP

```python
import math
import jax, jax.numpy as jnp
from jax import lax
import numpy as np

D_MODEL = 1024
BATCH = 2
SEQ = 8192
DEPTH = 2

GRID_W = 64
CTX_LEN = 256
N_HEADS = 8
N_KV_HEADS = 2
HEAD_DIM = 64
Q_GROUP = N_HEADS // N_KV_HEADS
WINDOW = 128
ATTN_BLOCK = 128
ROPE_THETA = 10000.0
D_SSM = D_MODEL // 2
SSM_GROUP = 16
N_SSM_GROUPS = D_SSM // SSM_GROUP
SSM_STATE = 64
N_EXPERT_GROUPS = 4
EXPERTS_PER_GROUP = 8
N_EXPERTS = N_EXPERT_GROUPS * EXPERTS_PER_GROUP
TOP_K = 2
D_EXPERT = D_MODEL // 2
MOE_BLOCK = 128
Q_W = N_HEADS * HEAD_DIM
KV_W = N_KV_HEADS * HEAD_DIM
D_IN = Q_W + 2 * KV_W + D_SSM + 2 * D_MODEL
EPS = 1e-6
NEG_INF = -1e30
F32 = jnp.float32

kernel_name = 'hybrid_s5_swa_hmoe_prefix'


def rms_norm(x, g):
    xf = x.astype(F32)
    y = xf * lax.rsqrt(jnp.mean(xf * xf, axis=-1, keepdims=True) + EPS)
    return (y * g.astype(F32)).astype(x.dtype)


def modulate(h, shift, scale):
    return h * (1 + scale) + shift


def rope_2d(x, rows, cols):
    half = HEAD_DIM // 2
    quarter = half // 2
    freqs = ROPE_THETA ** (-jnp.arange(quarter, dtype=F32) / quarter)

    def rot(xa, pos):
        ang = pos[:, None] * freqs[None, :]
        cos = jnp.cos(ang)[None, :, None, :].astype(x.dtype)
        sin = jnp.sin(ang)[None, :, None, :].astype(x.dtype)
        x1, x2 = xa[..., :quarter], xa[..., quarter:]
        return jnp.concatenate([x1 * cos - x2 * sin, x1 * sin + x2 * cos], axis=-1)

    return jnp.concatenate([rot(x[..., :half], rows), rot(x[..., half:], cols)], axis=-1)


def latent_attention(q, k, v, kc, vc, sink):
    b, s = q.shape[0], q.shape[1]
    nb = s // ATTN_BLOCK
    scale = HEAD_DIM ** -0.5
    qb = q.reshape(b, nb, ATTN_BLOCK, N_KV_HEADS, Q_GROUP, HEAD_DIM)

    def band(t):
        tp = jnp.pad(t, ((0, 0), (ATTN_BLOCK, ATTN_BLOCK), (0, 0), (0, 0)))
        tp = tp.reshape(b, nb + 2, ATTN_BLOCK, N_KV_HEADS, HEAD_DIM)
        return jnp.concatenate([tp[:, :-2], tp[:, 1:-1], tp[:, 2:]], axis=2)

    kb, vb = band(k), band(v)
    s_loc = jnp.einsum('bnqhgd,bnjhd->bnhgqj', qb, kb).astype(F32) * scale
    s_ctx = jnp.einsum('bnqhgd,bchd->bnhgqc', qb, kc).astype(F32) * scale
    qpos = jnp.arange(nb)[:, None] * ATTN_BLOCK + jnp.arange(ATTN_BLOCK)[None, :]
    kpos = (jnp.arange(nb)[:, None] - 1) * ATTN_BLOCK + jnp.arange(3 * ATTN_BLOCK)[None, :]
    kp = kpos[:, None, :]
    valid = (jnp.abs(qpos[:, :, None] - kp) <= WINDOW) & (kp >= 0) & (kp < s)
    s_loc = jnp.where(valid[None, :, None, None], s_loc, NEG_INF)
    sink_l = jnp.broadcast_to(sink.astype(F32).reshape(N_KV_HEADS, Q_GROUP, 1, 1), s_loc.shape[:-1] + (1,))
    p = jax.nn.softmax(jnp.concatenate([s_loc, s_ctx, sink_l], axis=-1), axis=-1).astype(v.dtype)
    n_loc = 3 * ATTN_BLOCK
    n_ctx = kc.shape[1]
    o = (jnp.einsum('bnhgqj,bnjhd->bnqhgd', p[..., :n_loc], vb)
         + jnp.einsum('bnhgqc,bchd->bnqhgd', p[..., n_loc:n_loc + n_ctx], vc))
    return o.reshape(b, s, Q_W)


def context_attention(q, k, v, sink):
    b, n = q.shape[0], q.shape[1]
    qg = q.reshape(b, n, N_KV_HEADS, Q_GROUP, HEAD_DIM)
    sc = jnp.einsum('bqhgd,bjhd->bhgqj', qg, k).astype(F32) * HEAD_DIM ** -0.5
    sink_c = jnp.broadcast_to(sink.astype(F32).reshape(N_KV_HEADS, Q_GROUP, 1, 1), sc.shape[:-1] + (1,))
    p = jax.nn.softmax(jnp.concatenate([sc, sink_c], axis=-1), axis=-1)[..., :-1].astype(v.dtype)
    return jnp.einsum('bhgqj,bjhd->bqhgd', p, v).reshape(b, n, Q_W)


def ssm_discretise(lam_re, lam_im, log_dt, b_re, b_im):
    lr, li = lam_re.astype(F32), lam_im.astype(F32)
    dt = jnp.exp(log_dt.astype(F32))[:, None]
    mag = jnp.exp(lr * dt)
    a_re = mag * jnp.cos(li * dt)
    a_im = mag * jnp.sin(li * dt)
    den = lr * lr + li * li
    nr = a_re - 1.0
    f_re = (nr * lr + a_im * li) / den
    f_im = (a_im * lr - nr * li) / den
    br, bi = b_re.astype(F32), b_im.astype(F32)
    bb_re = f_re[..., None] * br - f_im[..., None] * bi
    bb_im = f_re[..., None] * bi + f_im[..., None] * br
    return a_re, a_im, bb_re, bb_im


def complex_affine_combine(e1, e2):
    a1r, a1i, b1r, b1i = e1
    a2r, a2i, b2r, b2i = e2
    return (a2r * a1r - a2i * a1i, a2r * a1i + a2i * a1r,
            a2r * b1r - a2i * b1i + b2r, a2r * b1i + a2i * b1r + b2i)


def ssm_scan(u, a_re, a_im, bb_re, bb_im, h0, reverse):
    bu_re = jnp.einsum('blgm,gpm->blgp', u, bb_re)
    bu_im = jnp.einsum('blgm,gpm->blgp', u, bb_im)
    if h0 is not None:
        h_re, h_im = h0
        idx = -1 if reverse else 0
        bu_re = bu_re.at[:, idx].add(a_re * h_re - a_im * h_im)
        bu_im = bu_im.at[:, idx].add(a_re * h_im + a_im * h_re)
    ar = jnp.broadcast_to(a_re, bu_re.shape)
    ai = jnp.broadcast_to(a_im, bu_im.shape)
    _, _, x_re, x_im = lax.associative_scan(complex_affine_combine, (ar, ai, bu_re, bu_im), reverse=reverse, axis=1)
    return x_re, x_im


def ssm_readout(x_re, x_im, c_re, c_im):
    return (jnp.einsum('blgp,gmp->blgm', x_re, c_re.astype(F32))
            - jnp.einsum('blgp,gmp->blgm', x_im, c_im.astype(F32)))


def ssm_branch(u, uc, ctx_out, lam_re, lam_im, log_dt, b_re, b_im, c_re, c_im, d_skip, w_glu):
    b, s, _ = u.shape
    n_ctx = uc.shape[1]
    ug = u.astype(F32).reshape(b, s, N_SSM_GROUPS, SSM_GROUP)
    ucg = uc.astype(F32).reshape(b, n_ctx, N_SSM_GROUPS, SSM_GROUP)
    dg = d_skip.astype(F32).reshape(N_SSM_GROUPS, SSM_GROUP)
    y = ug * dg
    yc = ucg * dg if ctx_out else None
    for direction, reverse in ((0, False), (1, True)):
        a_re, a_im, bb_re, bb_im = ssm_discretise(lam_re[direction], lam_im[direction], log_dt[direction],
                                                  b_re[direction], b_im[direction])
        xc_re, xc_im = ssm_scan(ucg, a_re, a_im, bb_re, bb_im, None, reverse)
        end = 0 if reverse else -1
        x_re, x_im = ssm_scan(ug, a_re, a_im, bb_re, bb_im, (xc_re[:, end], xc_im[:, end]), reverse)
        y = y + ssm_readout(x_re, x_im, c_re[direction], c_im[direction])
        if ctx_out:
            yc = yc + ssm_readout(xc_re, xc_im, c_re[direction], c_im[direction])

    def glu(z):
        z = jax.nn.gelu(z.reshape(z.shape[0], z.shape[1], D_SSM)).astype(u.dtype)
        return z * jax.nn.sigmoid(z @ w_glu)

    return glu(y), (glu(yc) if ctx_out else None)


def mixer(h, hc, rows, cols, ctx_out, w_in, sink, lam_re, lam_im, log_dt, b_re, b_im, c_re, c_im,
          d_skip, w_glu, w_br_attn, w_br_ssm, w_out):
    b, s, _ = h.shape
    n_ctx = hc.shape[1]
    o_k = Q_W
    o_v = o_k + KV_W
    o_u = o_v + KV_W
    o_ga = o_u + D_SSM
    o_gs = o_ga + D_MODEL
    p = h @ w_in
    q = rope_2d(p[..., :o_k].reshape(b, s, N_HEADS, HEAD_DIM), rows, cols)
    k = rope_2d(p[..., o_k:o_v].reshape(b, s, N_KV_HEADS, HEAD_DIM), rows, cols)
    v = p[..., o_v:o_u].reshape(b, s, N_KV_HEADS, HEAD_DIM)
    u = p[..., o_u:o_ga]
    ga = p[..., o_ga:o_gs]
    gs = p[..., o_gs:]
    w_ctx = w_in if ctx_out else w_in[:, o_k:o_ga]
    off = 0 if ctx_out else o_k
    pc = hc @ w_ctx
    kc = pc[..., o_k - off:o_v - off].reshape(b, n_ctx, N_KV_HEADS, HEAD_DIM)
    vc = pc[..., o_v - off:o_u - off].reshape(b, n_ctx, N_KV_HEADS, HEAD_DIM)
    uc = pc[..., o_u - off:o_ga - off]
    attn = latent_attention(q, k, v, kc, vc, sink)
    ssm, ssm_c = ssm_branch(u, uc, ctx_out, lam_re, lam_im, log_dt, b_re, b_im, c_re, c_im, d_skip, w_glu)
    y = (jax.nn.sigmoid(ga) * (attn @ w_br_attn) + jax.nn.sigmoid(gs) * (ssm @ w_br_ssm)) @ w_out
    if not ctx_out:
        return y, None
    qc = pc[..., :o_k].reshape(b, n_ctx, N_HEADS, HEAD_DIM)
    attn_c = context_attention(qc, kc, vc, sink)
    yc = (jax.nn.sigmoid(pc[..., o_ga:o_gs]) * (attn_c @ w_br_attn)
          + jax.nn.sigmoid(pc[..., o_gs:]) * (ssm_c @ w_br_ssm)) @ w_out
    return y, yc


def hier_moe(h, w_rg, w_re, w_gate, w_up, w_down):
    t, d = h.shape
    p_grp = jax.nn.softmax((h @ w_rg).astype(F32), axis=-1)
    g_prob, g_idx = lax.top_k(p_grp, 1)
    logits_e = (h @ w_re).astype(F32).reshape(t, N_EXPERT_GROUPS, EXPERTS_PER_GROUP)
    logits_sel = jnp.take_along_axis(logits_e, g_idx[:, :, None], axis=1)[:, 0]
    e_prob, e_idx = lax.top_k(jax.nn.softmax(logits_sel, axis=-1), TOP_K)
    e_prob = e_prob / jnp.sum(e_prob, axis=-1, keepdims=True)
    weight = (g_prob * e_prob).reshape(-1)
    expert = (g_idx * EXPERTS_PER_GROUP + e_idx).reshape(-1)
    token = jnp.repeat(jnp.arange(t), TOP_K)
    n_assign = t * TOP_K
    order = jnp.argsort(expert)
    s_exp, s_tok, s_w = expert[order], token[order], weight[order]
    counts = jnp.bincount(expert, length=N_EXPERTS)
    start = jnp.cumsum(counts) - counts
    pcounts = (counts + MOE_BLOCK - 1) // MOE_BLOCK * MOE_BLOCK
    pend = jnp.cumsum(pcounts)
    pstart = pend - pcounts
    dest = pstart[s_exp] + jnp.arange(n_assign) - start[s_exp]
    n_pad = -(-n_assign // MOE_BLOCK) * MOE_BLOCK + N_EXPERTS * MOE_BLOCK
    n_blk = n_pad // MOE_BLOCK
    buf_tok = jnp.full((n_pad,), t, jnp.int32).at[dest].set(s_tok.astype(jnp.int32))
    buf_w = jnp.zeros((n_pad,), h.dtype).at[dest].set(s_w.astype(h.dtype))
    blk_exp = jnp.minimum(jnp.searchsorted(pend, jnp.arange(n_blk) * MOE_BLOCK, side='right'), N_EXPERTS - 1)
    h_pad = jnp.concatenate([h, jnp.zeros((1, d), h.dtype)], axis=0)
    xb = h_pad[buf_tok].reshape(n_blk, MOE_BLOCK, d)

    def expert_block(args):
        xblk, e = args
        return (jax.nn.silu(xblk @ w_gate[e]) * (xblk @ w_up[e])) @ w_down[e]

    yb = lax.map(expert_block, (xb, blk_exp)).reshape(n_pad, d)
    out = jax.ops.segment_sum(yb * buf_w[:, None], buf_tok, num_segments=t + 1)
    return out[:t]


def setup_inputs(seed: int = 0) -> dict:
    key = jax.random.key(seed)
    ks = iter(jax.random.split(key, 40))
    nrm = lambda shape: jax.random.normal(next(ks), shape, F32)
    L2 = (DEPTH, 2, N_SSM_GROUPS)
    return {
        'x': nrm((BATCH, SEQ, D_MODEL)),
        'c': nrm((BATCH, D_MODEL)),
        'ctx': nrm((BATCH, CTX_LEN, D_MODEL)),
        'c_ctx': nrm((D_MODEL,)),
        'w_mod': nrm((DEPTH, D_MODEL, 6 * D_MODEL)) * (0.5 * D_MODEL ** -0.5),
        'b_mod': nrm((DEPTH, 6 * D_MODEL)) * 0.01,
        'g_norm1': 1.0 + 0.01 * nrm((DEPTH, D_MODEL)),
        'g_norm2': 1.0 + 0.01 * nrm((DEPTH, D_MODEL)),
        'w_in': nrm((DEPTH, D_MODEL, D_IN)) * D_MODEL ** -0.5,
        'attn_sink': 0.1 * nrm((DEPTH, N_HEADS)),
        'ssm_lam_re': -0.5 + 0.01 * nrm(L2 + (SSM_STATE,)),
        'ssm_lam_im': jnp.pi * jnp.arange(SSM_STATE, dtype=F32) + 0.01 * nrm(L2 + (SSM_STATE,)),
        'ssm_log_dt': jax.random.uniform(next(ks), L2, F32, minval=math.log(1e-3), maxval=math.log(1e-1)),
        'ssm_b_re': nrm(L2 + (SSM_STATE, SSM_GROUP)) * (2 * SSM_GROUP) ** -0.5,
        'ssm_b_im': nrm(L2 + (SSM_STATE, SSM_GROUP)) * (2 * SSM_GROUP) ** -0.5,
        'ssm_c_re': nrm(L2 + (SSM_GROUP, SSM_STATE)) * SSM_STATE ** -0.5,
        'ssm_c_im': nrm(L2 + (SSM_GROUP, SSM_STATE)) * SSM_STATE ** -0.5,
        'ssm_d': nrm((DEPTH, D_SSM)),
        'w_glu': nrm((DEPTH, D_SSM, D_SSM)) * D_SSM ** -0.5,
        'w_br_attn': nrm((DEPTH, Q_W, D_MODEL)) * Q_W ** -0.5,
        'w_br_ssm': nrm((DEPTH, D_SSM, D_MODEL)) * D_SSM ** -0.5,
        'w_out': nrm((DEPTH, D_MODEL, D_MODEL)) * D_MODEL ** -0.5,
        'w_router_group': nrm((DEPTH, D_MODEL, N_EXPERT_GROUPS)) * D_MODEL ** -0.5,
        'w_router_expert': nrm((DEPTH, D_MODEL, N_EXPERTS)) * D_MODEL ** -0.5,
        'w_exp_gate': nrm((DEPTH, N_EXPERTS, D_MODEL, D_EXPERT)) * D_MODEL ** -0.5,
        'w_exp_up': nrm((DEPTH, N_EXPERTS, D_MODEL, D_EXPERT)) * D_MODEL ** -0.5,
        'w_exp_down': nrm((DEPTH, N_EXPERTS, D_EXPERT, D_MODEL)) * D_EXPERT ** -0.5,
        'g_final': 1.0 + 0.01 * nrm((D_MODEL,)),
    }


def reference(x, c, ctx, c_ctx, w_mod, b_mod, g_norm1, g_norm2, w_in, attn_sink, ssm_lam_re, ssm_lam_im,
              ssm_log_dt, ssm_b_re, ssm_b_im, ssm_c_re, ssm_c_im, ssm_d, w_glu, w_br_attn, w_br_ssm, w_out,
              w_router_group, w_router_expert, w_exp_gate, w_exp_up, w_exp_down, g_final):
    b, s, d = x.shape
    n_rows = s // GRID_W
    rows = jnp.repeat(jnp.arange(n_rows), GRID_W).astype(F32)
    cols = jnp.tile(jnp.arange(GRID_W), n_rows).astype(F32)
    silu_c = jax.nn.silu(c)
    silu_cc = jax.nn.silu(c_ctx)
    for l in range(DEPTH):
        ctx_out = l < DEPTH - 1
        mod = silu_c @ w_mod[l] + b_mod[l]
        mod_c = silu_cc @ w_mod[l] + b_mod[l]
        sh1, sc1, gt1, sh2, sc2, gt2 = jnp.split(mod[:, None, :], 6, axis=-1)
        csh1, csc1, cgt1, csh2, csc2, cgt2 = jnp.split(mod_c, 6, axis=-1)
        h = modulate(rms_norm(x, g_norm1[l]), sh1, sc1)
        hc = modulate(rms_norm(ctx, g_norm1[l]), csh1, csc1)
        y, yc = mixer(h, hc, rows, cols, ctx_out, w_in[l], attn_sink[l], ssm_lam_re[l], ssm_lam_im[l],
                      ssm_log_dt[l], ssm_b_re[l], ssm_b_im[l], ssm_c_re[l], ssm_c_im[l], ssm_d[l], w_glu[l],
                      w_br_attn[l], w_br_ssm[l], w_out[l])
        x = x + gt1 * y
        h2 = modulate(rms_norm(x, g_norm2[l]), sh2, sc2).reshape(b * s, d)
        if ctx_out:
            ctx = ctx + cgt1 * yc
            hc2 = modulate(rms_norm(ctx, g_norm2[l]), csh2, csc2).reshape(-1, d)
            f = hier_moe(jnp.concatenate([h2, hc2], axis=0), w_router_group[l], w_router_expert[l],
                         w_exp_gate[l], w_exp_up[l], w_exp_down[l])
            x = x + gt2 * f[:b * s].reshape(b, s, d)
            ctx = ctx + cgt2 * f[b * s:].reshape(ctx.shape)
        else:
            f = hier_moe(h2, w_router_group[l], w_router_expert[l], w_exp_gate[l], w_exp_up[l], w_exp_down[l])
            x = x + gt2 * f.reshape(b, s, d)
    return rms_norm(x, g_final)
```

```cpp
#include <hip/hip_runtime.h>
#include <stdint.h>
#include <math.h>

namespace nv {
constexpr int D = 1024, NB = 2, S = 8192, CTX = 256, NTOK = NB * S, NCTX = NB * CTX, NALL = NTOK + NCTX;
constexpr int DIN = 3328, O_K = 512, O_V = 640, O_U = 768, O_GA = 1280, O_GS = 2304;
constexpr int NH = 8, NKV = 2, HD = 64, DSSM = 512, NG = 32, GS = 16, NST = 64;
constexpr int NE = 32, NEG = 4, EPG = 8, DE = 512;

__device__ __forceinline__ float sigmoidf_(float x) { return 1.f / (1.f + expf(-x)); }
__device__ __forceinline__ int which_of(int r) { return r < NTOK ? (r / S) : 2; }

__global__ void k_mod(const float* c, const float* c_ctx, const float* w_mod, const float* b_mod, float* mod) {
    int idx = blockIdx.x * blockDim.x + threadIdx.x;
    if (idx >= 2 * 3 * 6144) return;
    int col = idx % 6144, w = (idx / 6144) % 3, l = idx / (3 * 6144);
    const float* cv = w < 2 ? c + w * D : c_ctx;
    const float* W = w_mod + (size_t)l * D * 6144;
    float acc = 0.f;
    for (int k = 0; k < D; ++k) { float v = cv[k]; acc += (v * sigmoidf_(v)) * W[(size_t)k * 6144 + col]; }
    mod[idx] = acc + b_mod[l * 6144 + col];
}

__global__ void k_norm_mod(const float* X, const float* g, const float* modl, int shift_idx, int scale_idx, float* H) {
    __shared__ float red[4];
    int r = blockIdx.x, t = threadIdx.x;
    float4 v = *(const float4*)&X[(size_t)r * D + t * 4];
    float ss = v.x * v.x + v.y * v.y + v.z * v.z + v.w * v.w;
    for (int o = 1; o < 64; o <<= 1) ss += __shfl_xor(ss, o);
    if ((t & 63) == 0) red[t >> 6] = ss;
    __syncthreads();
    float tot = red[0] + red[1] + red[2] + red[3];
    float rinv = rsqrtf(tot * (1.f / D) + 1e-6f);
    const float* m = modl + which_of(r) * 6144;
    float xv[4] = {v.x, v.y, v.z, v.w}, o[4];
    for (int i = 0; i < 4; ++i) { int cidx = t * 4 + i; float y = xv[i] * rinv * g[cidx]; o[i] = y * (1.f + m[scale_idx * D + cidx]) + m[shift_idx * D + cidx]; }
    *(float4*)&H[(size_t)r * D + t * 4] = make_float4(o[0], o[1], o[2], o[3]);
}
__global__ void k_final_norm(const float* X, const float* g, float* out) {
    __shared__ float red[4];
    int r = blockIdx.x, t = threadIdx.x;
    float4 v = *(const float4*)&X[(size_t)r * D + t * 4];
    float ss = v.x * v.x + v.y * v.y + v.z * v.z + v.w * v.w;
    for (int o = 1; o < 64; o <<= 1) ss += __shfl_xor(ss, o);
    if ((t & 63) == 0) red[t >> 6] = ss;
    __syncthreads();
    float tot = red[0] + red[1] + red[2] + red[3];
    float rinv = rsqrtf(tot * (1.f / D) + 1e-6f);
    float4 gg = *(const float4*)&g[t * 4];
    *(float4*)&out[(size_t)r * D + t * 4] = make_float4(v.x * rinv * gg.x, v.y * rinv * gg.y, v.z * rinv * gg.z, v.w * rinv * gg.w);
}

struct EA { const float* p0; const float* p1; };
template <int EPI>
__global__ __launch_bounds__(256) void k_gemm(const float* A, int lda, const float* Bm, int ldb, float* C, int ldc, int K, EA ea) {
    __shared__ float As[16][68];
    __shared__ float Bs[16][68];
    const int tid = threadIdx.x, tx = tid & 15, ty = tid >> 4;
    const int m0 = blockIdx.y * 64, n0 = blockIdx.x * 64;
    float acc[4][4];
#pragma unroll
    for (int i = 0; i < 4; ++i)
#pragma unroll
        for (int j = 0; j < 4; ++j) acc[i][j] = 0.f;
    for (int k0 = 0; k0 < K; k0 += 16) {
        float4 a = *(const float4*)&A[(size_t)(m0 + (tid >> 2)) * lda + k0 + (tid & 3) * 4];
        As[(tid & 3) * 4 + 0][tid >> 2] = a.x; As[(tid & 3) * 4 + 1][tid >> 2] = a.y; As[(tid & 3) * 4 + 2][tid >> 2] = a.z; As[(tid & 3) * 4 + 3][tid >> 2] = a.w;
        float4 b = *(const float4*)&Bm[(size_t)(k0 + (tid >> 4)) * ldb + n0 + (tid & 15) * 4];
        *(float4*)&Bs[tid >> 4][(tid & 15) * 4] = b;
        __syncthreads();
#pragma unroll
        for (int k = 0; k < 16; ++k) {
            float4 av = *(const float4*)&As[k][ty * 4]; float4 bv = *(const float4*)&Bs[k][tx * 4];
            float aa[4] = {av.x, av.y, av.z, av.w}, bb[4] = {bv.x, bv.y, bv.z, bv.w};
#pragma unroll
            for (int i = 0; i < 4; ++i)
#pragma unroll
                for (int j = 0; j < 4; ++j) acc[i][j] += aa[i] * bb[j];
        }
        __syncthreads();
    }
#pragma unroll
    for (int i = 0; i < 4; ++i) {
        const int r = m0 + ty * 4 + i;
#pragma unroll
        for (int j = 0; j < 4; ++j) {
            const int cidx = n0 + tx * 4 + j; float v = acc[i][j]; float* dst = &C[(size_t)r * ldc + cidx];
            if (EPI == 0) *dst = v;
            else if (EPI == 1) *dst = ea.p0[(size_t)r * DSSM + cidx] * sigmoidf_(v);
            else if (EPI == 2) *dst = sigmoidf_(ea.p0[(size_t)r * DIN + O_GA + cidx]) * v;
            else if (EPI == 3) *dst += sigmoidf_(ea.p0[(size_t)r * DIN + O_GS + cidx]) * v;
            else if (EPI == 4) *dst += ea.p0[which_of(r) * 6144 + cidx] * v;
        }
    }
}

__global__ void k_rope(float* P) {
    size_t idx = (size_t)blockIdx.x * blockDim.x + threadIdx.x;
    if (idx >= (size_t)NTOK * 10 * 32) return;
    int i = idx % 32; int hh = (idx / 32) % 10; int r = idx / 320;
    int s = r % S; int rowpos = s / 64, colpos = s % 64;
    int half = i / 16, j = i % 16;
    float pos = half == 0 ? (float)rowpos : (float)colpos;
    float freq = (float)exp(-(double)j / 16.0 * log(10000.0));
    float ang = pos * freq;
    float cs = (float)cos((double)ang), sn = (float)sin((double)ang);
    float* base = P + (size_t)r * DIN + (hh < 8 ? hh * 64 : O_K + (hh - 8) * 64) + half * 32;
    float x1 = base[j], x2 = base[j + 16];
    base[j] = x1 * cs - x2 * sn; base[j + 16] = x1 * sn + x2 * cs;
}

__global__ __launch_bounds__(64) void k_attn(const float* P, const float* sink, float* ATT) {
    int idx = blockIdx.x * 64 + threadIdx.x;
    int h = idx % NH, r = idx / NH;
    if (r >= NTOK) return;
    int b = r / S, s = r % S, kvh = h / 4;
    float q[64], acc[64];
    const float* qp = P + (size_t)r * DIN + h * 64;
#pragma unroll
    for (int d = 0; d < 64; ++d) { q[d] = qp[d]; acc[d] = 0.f; }
    float m = -INFINITY, l = 0.f;
    int j0 = s - 128 < 0 ? 0 : s - 128, j1 = s + 128 > S - 1 ? S - 1 : s + 128;
    int nloc = j1 - j0 + 1;
    for (int t = 0; t < nloc + CTX; ++t) {
        int kr = t < nloc ? (b * S + j0 + t) : (NTOK + b * CTX + (t - nloc));
        const float* kp = P + (size_t)kr * DIN + O_K + kvh * 64;
        const float* vp = P + (size_t)kr * DIN + O_V + kvh * 64;
        float sc = 0.f;
#pragma unroll
        for (int d = 0; d < 64; d += 4) { float4 kk = *(const float4*)&kp[d]; sc += q[d] * kk.x + q[d + 1] * kk.y + q[d + 2] * kk.z + q[d + 3] * kk.w; }
        sc *= 0.125f;
        if (sc > m) { float f = expf(m - sc); l *= f;
#pragma unroll
            for (int d = 0; d < 64; ++d) acc[d] *= f;
            m = sc; }
        float p = expf(sc - m); l += p;
#pragma unroll
        for (int d = 0; d < 64; d += 4) { float4 vv = *(const float4*)&vp[d]; acc[d] += p * vv.x; acc[d + 1] += p * vv.y; acc[d + 2] += p * vv.z; acc[d + 3] += p * vv.w; }
    }
    float sk = sink[h];
    float m2 = fmaxf(m, sk); float f = expf(m - m2); l = l * f + expf(sk - m2);
    float inv = f / l;
    float* op = ATT + (size_t)r * 512 + h * 64;
#pragma unroll
    for (int d = 0; d < 64; ++d) op[d] = acc[d] * inv;
}
__global__ __launch_bounds__(64) void k_attn_ctx(const float* P, const float* sink, float* ATT) {
    int idx = blockIdx.x * 64 + threadIdx.x;
    int h = idx % NH, rc = idx / NH;
    if (rc >= NCTX) return;
    int r = NTOK + rc, b = rc / CTX, kvh = h / 4;
    float q[64], acc[64];
    const float* qp = P + (size_t)r * DIN + h * 64;
#pragma unroll
    for (int d = 0; d < 64; ++d) { q[d] = qp[d]; acc[d] = 0.f; }
    float m = -INFINITY, l = 0.f;
    for (int t = 0; t < CTX; ++t) {
        int kr = NTOK + b * CTX + t;
        const float* kp = P + (size_t)kr * DIN + O_K + kvh * 64;
        const float* vp = P + (size_t)kr * DIN + O_V + kvh * 64;
        float sc = 0.f;
#pragma unroll
        for (int d = 0; d < 64; d += 4) { float4 kk = *(const float4*)&kp[d]; sc += q[d] * kk.x + q[d + 1] * kk.y + q[d + 2] * kk.z + q[d + 3] * kk.w; }
        sc *= 0.125f;
        if (sc > m) { float f = expf(m - sc); l *= f;
#pragma unroll
            for (int d = 0; d < 64; ++d) acc[d] *= f;
            m = sc; }
        float p = expf(sc - m); l += p;
#pragma unroll
        for (int d = 0; d < 64; d += 4) { float4 vv = *(const float4*)&vp[d]; acc[d] += p * vv.x; acc[d + 1] += p * vv.y; acc[d + 2] += p * vv.z; acc[d + 3] += p * vv.w; }
    }
    float sk = sink[h];
    float m2 = fmaxf(m, sk); float f = expf(m - m2); l = l * f + expf(sk - m2);
    float inv = f / l;
    float* op = ATT + (size_t)r * 512 + h * 64;
#pragma unroll
    for (int d = 0; d < 64; ++d) op[d] = acc[d] * inv;
}

__global__ __launch_bounds__(64) void k_ssm(const float* P, const float* lam_re, const float* lam_im, const float* log_dt, const float* b_re, const float* b_im,
                                            const float* c_re, const float* c_im, const float* dsk, float* Y) {
    const int p = threadIdx.x, g = blockIdx.x % NG, b = blockIdx.x / NG;
    for (int dir = 0; dir < 2; ++dir) {
        const int pg = dir * NG + g;
        double lr = lam_re[pg * NST + p], li = lam_im[pg * NST + p], dt = exp((double)log_dt[pg]);
        double mag = exp(lr * dt), are = mag * cos(li * dt), aim = mag * sin(li * dt), den = lr * lr + li * li, nr = are - 1.0;
        double fre = (nr * lr + aim * li) / den, fim = (aim * lr - nr * li) / den;
        float a_re = (float)are, a_im = (float)aim;
        float bbr[16], bbi[16], cr[16], ci[16];
#pragma unroll
        for (int m = 0; m < 16; ++m) {
            double br = b_re[((size_t)pg * NST + p) * GS + m], bi = b_im[((size_t)pg * NST + p) * GS + m];
            bbr[m] = (float)(fre * br - fim * bi); bbi[m] = (float)(fre * bi + fim * br);
            cr[m] = c_re[((size_t)pg * GS + m) * NST + p]; ci[m] = c_im[((size_t)pg * GS + m) * NST + p];
        }
        float dval = p < 16 ? dsk[g * 16 + p] : 0.f;
        float xr = 0.f, xi = 0.f;
        for (int t = 0; t < CTX + S; ++t) {
            int row;
            if (dir == 0) row = t < CTX ? (NTOK + b * CTX + t) : (b * S + (t - CTX));
            else          row = t < CTX ? (NTOK + b * CTX + (CTX - 1 - t)) : (b * S + (S - 1 - (t - CTX)));
            const float* up = P + (size_t)row * DIN + O_U + g * 16;
            float bur = 0.f, bui = 0.f, umine = 0.f;
#pragma unroll
            for (int m = 0; m < 16; ++m) { float u = up[m]; bur += bbr[m] * u; bui += bbi[m] * u; if (m == p) umine = u; }
            float nxr = a_re * xr - a_im * xi + bur, nxi = a_re * xi + a_im * xr + bui;
            xr = nxr; xi = nxi;
            float mine = 0.f;
#pragma unroll
            for (int m = 0; m < 16; ++m) {
                float v = cr[m] * xr - ci[m] * xi;
                for (int o = 1; o < 64; o <<= 1) v += __shfl_xor(v, o);
                if (m == p) mine = v;
            }
            if (p < 16) {
                float* yp = Y + (size_t)row * DSSM + g * 16 + p;
                if (dir == 0) *yp = umine * dval + mine; else *yp += mine;
            }
        }
    }
}
__global__ void k_gelu(float* Y, size_t n) {
    size_t i = (size_t)blockIdx.x * blockDim.x + threadIdx.x;
    if (i >= n) return;
    float x = Y[i];
    Y[i] = 0.5f * x * (1.f + tanhf(0.7978845608028654f * (x + 0.044715f * x * x * x)));
}

__global__ __launch_bounds__(64) void k_route(const float* H, const float* w_rg, const float* w_re, int* r_e, float* r_w) {
    __shared__ float lg[36];
    int r = blockIdx.x, t = threadIdx.x;
    if (t < 36) {
        const float* h = H + (size_t)r * D; float acc = 0.f;
        if (t < 4) { for (int k = 0; k < D; ++k) acc += h[k] * w_rg[k * 4 + t]; }
        else { int j = t - 4; for (int k = 0; k < D; ++k) acc += h[k] * w_re[k * 32 + j]; }
        lg[t] = acc;
    }
    __syncthreads();
    if (t == 0) {
        int gi = 0; float gm = lg[0];
        for (int i = 1; i < 4; ++i) if (lg[i] > gm) { gm = lg[i]; gi = i; }
        float gs = 0.f; for (int i = 0; i < 4; ++i) gs += expf(lg[i] - gm);
        float gprob = 1.f / gs;
        const float* el = lg + 4 + gi * 8;
        int i1 = 0; float v1 = el[0];
        for (int i = 1; i < 8; ++i) if (el[i] > v1) { v1 = el[i]; i1 = i; }
        int i2 = -1; float v2 = -INFINITY;
        for (int i = 0; i < 8; ++i) if (i != i1 && el[i] > v2) { v2 = el[i]; i2 = i; }
        float e2 = expf(v2 - v1); float p1 = 1.f / (1.f + e2), p2 = e2 / (1.f + e2);
        r_e[r * 2 + 0] = gi * 8 + i1; r_e[r * 2 + 1] = gi * 8 + i2;
        r_w[r * 2 + 0] = gprob * p1; r_w[r * 2 + 1] = gprob * p2;
    }
}

__global__ __launch_bounds__(256) void k_moe(const float* H, const int* r_e, const float* r_w, const float* Wg, const float* Wu, const float* Wd, float* F) {
    __shared__ float hs[8][1024];
    __shared__ float hid[8][512];
    __shared__ int list[512]; __shared__ float lw[512]; __shared__ int cnt;
    const int e = blockIdx.x, chunk = blockIdx.y, t = threadIdx.x;
    if (t == 0) cnt = 0;
    __syncthreads();
    { int r = chunk * 256 + t;
      for (int k = 0; k < 2; ++k) if (r_e[r * 2 + k] == e) { int s = atomicAdd(&cnt, 1); list[s] = r; lw[s] = r_w[r * 2 + k]; } }
    __syncthreads();
    const int n = cnt;
    const float* wg = Wg + (size_t)e * D * DE; const float* wu = Wu + (size_t)e * D * DE; const float* wd = Wd + (size_t)e * DE * D;
    for (int base = 0; base < n; base += 8) {
        const int nt = n - base < 8 ? n - base : 8;
        for (int i = t; i < 8 * 1024; i += 256) { int tk = i >> 10, k = i & 1023; hs[tk][k] = tk < nt ? H[(size_t)list[base + tk] * D + k] : 0.f; }
        __syncthreads();
        float ag[2][8], au[2][8];
#pragma unroll
        for (int j = 0; j < 2; ++j)
#pragma unroll
            for (int tk = 0; tk < 8; ++tk) { ag[j][tk] = 0.f; au[j][tk] = 0.f; }
        for (int k = 0; k < D; ++k) {
            float g0 = wg[(size_t)k * DE + t], g1 = wg[(size_t)k * DE + t + 256], u0 = wu[(size_t)k * DE + t], u1 = wu[(size_t)k * DE + t + 256];
#pragma unroll
            for (int tk = 0; tk < 8; ++tk) { float hv = hs[tk][k]; ag[0][tk] += hv * g0; ag[1][tk] += hv * g1; au[0][tk] += hv * u0; au[1][tk] += hv * u1; }
        }
#pragma unroll
        for (int j = 0; j < 2; ++j)
#pragma unroll
            for (int tk = 0; tk < 8; ++tk) { float gt = ag[j][tk]; hid[tk][t + j * 256] = gt * sigmoidf_(gt) * au[j][tk]; }
        __syncthreads();
        float ao[4][8];
#pragma unroll
        for (int j = 0; j < 4; ++j)
#pragma unroll
            for (int tk = 0; tk < 8; ++tk) ao[j][tk] = 0.f;
        for (int k = 0; k < DE; ++k) {
            float w0 = wd[(size_t)k * D + t], w1 = wd[(size_t)k * D + t + 256], w2 = wd[(size_t)k * D + t + 512], w3 = wd[(size_t)k * D + t + 768];
#pragma unroll
            for (int tk = 0; tk < 8; ++tk) { float hv = hid[tk][k]; ao[0][tk] += hv * w0; ao[1][tk] += hv * w1; ao[2][tk] += hv * w2; ao[3][tk] += hv * w3; }
        }
#pragma unroll
        for (int tk = 0; tk < 8; ++tk) if (tk < nt) { int r = list[base + tk]; float w = lw[base + tk];
#pragma unroll
            for (int j = 0; j < 4; ++j) atomicAdd(&F[(size_t)r * D + t + j * 256], w * ao[j][tk]); }
        __syncthreads();
    }
}
__global__ void k_addgate(float* X, const float* F, const float* gate) {
    size_t i = (size_t)blockIdx.x * blockDim.x + threadIdx.x;
    if (i >= (size_t)NALL * D) return;
    int r = i / D, cidx = i % D;
    X[i] += gate[which_of(r) * 6144 + cidx] * F[i];
}
}

extern "C" void kernel_launch(void* const* d_in, const int* in_sizes, int n_in, void* d_out, int out_size, void* d_ws, size_t ws_size, hipStream_t stream) {
    using namespace nv;
    const float* x = (const float*)d_in[0]; const float* c = (const float*)d_in[1]; const float* ctx = (const float*)d_in[2]; const float* c_ctx = (const float*)d_in[3];
    const float* w_mod = (const float*)d_in[4]; const float* b_mod = (const float*)d_in[5]; const float* g1 = (const float*)d_in[6]; const float* g2 = (const float*)d_in[7];
    const float* w_in = (const float*)d_in[8]; const float* sink = (const float*)d_in[9];
    const float* lam_re = (const float*)d_in[10]; const float* lam_im = (const float*)d_in[11]; const float* log_dt = (const float*)d_in[12];
    const float* sb_re = (const float*)d_in[13]; const float* sb_im = (const float*)d_in[14]; const float* sc_re = (const float*)d_in[15]; const float* sc_im = (const float*)d_in[16];
    const float* ssm_d = (const float*)d_in[17]; const float* w_glu = (const float*)d_in[18]; const float* w_bra = (const float*)d_in[19]; const float* w_brs = (const float*)d_in[20];
    const float* w_out = (const float*)d_in[21]; const float* w_rg = (const float*)d_in[22]; const float* w_re = (const float*)d_in[23];
    const float* w_eg = (const float*)d_in[24]; const float* w_eu = (const float*)d_in[25]; const float* w_ed = (const float*)d_in[26]; const float* g_final = (const float*)d_in[27];
    float* out = (float*)d_out;
    float* ws = (float*)d_ws; size_t off = 0;
    auto take = [&](size_t n) { float* p = ws + off; off += (n + 63) & ~(size_t)63; return p; };
    float* P = take((size_t)NALL * DIN); float* H = take((size_t)NALL * D); float* XC = take((size_t)NALL * D); float* MB = take((size_t)NALL * D);
    float* ATT = take((size_t)NALL * 512); float* Y = take((size_t)NALL * 512); float* SB = take((size_t)NALL * 512);
    float* MOD = take(2 * 3 * 6144); int* RE = (int*)take((size_t)NALL * 2); float* RW = take((size_t)NALL * 2);
    if (off * 4 > ws_size) return;
    k_mod<<<(2 * 3 * 6144 + 255) / 256, 256, 0, stream>>>(c, c_ctx, w_mod, b_mod, MOD);
    hipMemcpyAsync(XC, x, (size_t)NTOK * D * 4, hipMemcpyDeviceToDevice, stream);
    hipMemcpyAsync(XC + (size_t)NTOK * D, ctx, (size_t)NCTX * D * 4, hipMemcpyDeviceToDevice, stream);
    for (int l = 0; l < 2; ++l) {
        const float* modl = MOD + l * 3 * 6144;
        k_norm_mod<<<NALL, 256, 0, stream>>>(XC, g1 + l * D, modl, 0, 1, H);
        k_gemm<0><<<dim3(DIN / 64, NALL / 64), 256, 0, stream>>>(H, D, w_in + (size_t)l * D * DIN, DIN, P, DIN, D, EA{nullptr, nullptr});
        k_rope<<<(NTOK * 320 + 255) / 256, 256, 0, stream>>>(P);
        k_attn<<<NTOK * NH / 64, 64, 0, stream>>>(P, sink + l * NH, ATT);
        k_attn_ctx<<<NCTX * NH / 64, 64, 0, stream>>>(P, sink + l * NH, ATT);
        k_ssm<<<NB * NG, 64, 0, stream>>>(P, lam_re + (size_t)l * 2 * NG * NST, lam_im + (size_t)l * 2 * NG * NST, log_dt + l * 2 * NG, sb_re + (size_t)l * 2 * NG * NST * GS,
                                          sb_im + (size_t)l * 2 * NG * NST * GS, sc_re + (size_t)l * 2 * NG * GS * NST, sc_im + (size_t)l * 2 * NG * GS * NST, ssm_d + l * DSSM, Y);
        k_gelu<<<(NALL * 512 + 255) / 256, 256, 0, stream>>>(Y, (size_t)NALL * 512);
        k_gemm<1><<<dim3(512 / 64, NALL / 64), 256, 0, stream>>>(Y, 512, w_glu + (size_t)l * 512 * 512, 512, SB, 512, 512, EA{Y, nullptr});
        k_gemm<2><<<dim3(D / 64, NALL / 64), 256, 0, stream>>>(ATT, 512, w_bra + (size_t)l * 512 * D, D, MB, D, 512, EA{P, nullptr});
        k_gemm<3><<<dim3(D / 64, NALL / 64), 256, 0, stream>>>(SB, 512, w_brs + (size_t)l * 512 * D, D, MB, D, 512, EA{P, nullptr});
        k_gemm<4><<<dim3(D / 64, NALL / 64), 256, 0, stream>>>(MB, D, w_out + (size_t)l * D * D, D, XC, D, D, EA{modl + 2 * D, nullptr});
        k_norm_mod<<<NALL, 256, 0, stream>>>(XC, g2 + l * D, modl, 3, 4, H);
        k_route<<<NALL, 64, 0, stream>>>(H, w_rg + (size_t)l * D * 4, w_re + (size_t)l * D * 32, RE, RW);
        hipMemsetAsync(MB, 0, (size_t)NALL * D * 4, stream);
        k_moe<<<dim3(NE, NALL / 256), 256, 0, stream>>>(H, RE, RW, w_eg + (size_t)l * NE * D * DE, w_eu + (size_t)l * NE * D * DE, w_ed + (size_t)l * NE * DE * D, MB);
        k_addgate<<<(int)(((size_t)NALL * D + 255) / 256), 256, 0, stream>>>(XC, MB, modl + 5 * D);
    }
    k_final_norm<<<NTOK, 256, 0, stream>>>(XC, g_final, out);
}
```

```cpp
#include <hip/hip_runtime.h>
#include <cstdint>
#include <cmath>
#ifndef MK_PER_PHASE
#define MK_PER_PHASE 0
#endif
namespace pg8 {
#define PG8_LAS __attribute__((address_space(3)))
typedef unsigned short bf16_t;
typedef short bf16x8 __attribute__((ext_vector_type(8)));
typedef float f32x4 __attribute__((ext_vector_type(4)));
typedef float f32x2 __attribute__((ext_vector_type(2)));
typedef unsigned u32x4 __attribute__((ext_vector_type(4)));
typedef unsigned u32x2 __attribute__((ext_vector_type(2)));
constexpr int BM = 256, BK = 64, HALF = 128, HTB = HALF * BK * 2, STAGE_BYTES = 8 * HTB, NXCD = 8, WGM = 8;

__host__ __device__ __forceinline__ int lds_byte(int r, int c) { const int st = (r >> 4) * 2 + (c >> 5), rr = r & 15, cc = c & 31, ob = rr * 64 + cc * 2; return st * 1024 + (ob ^ (((ob >> 9) & 1) << 5)); }
__host__ __device__ __forceinline__ void stage_rc(int b, int& R, int& C) { const int st = b / 1024, sb = b % 1024, swz = sb ^ (((sb >> 9) & 1) << 5); R = (st >> 1) * 16 + swz / 64; C = (st & 1) * 32 + (swz % 64) / 2; }
__host__ __device__ __forceinline__ int perm32(int rho) { const int n = rho >> 4, i = rho & 15; return 8 * (i >> 2) + 4 * n + (i & 3); }

struct Unit { const char* A; const char* B; int pm, pn, aux; };
typedef __bf16 bf16x2_t __attribute__((ext_vector_type(2)));
__device__ __forceinline__ unsigned cvt_pk_bf16(float lo, float hi) { f32x2 v = {lo, hi}; bf16x2_t b = __builtin_convertvector(v, bf16x2_t); return __builtin_bit_cast(unsigned, b); }
__device__ __forceinline__ float bf_lo(unsigned w) { return __uint_as_float(w << 16); }
__device__ __forceinline__ float bf_hi(unsigned w) { return __uint_as_float(w & 0xffff0000u); }

__device__ __forceinline__ void tile_of(int L, int nM, int nN, int& pm, int& pn) {
    const int nwg = nM * nN; int wgid = L;
    { const int q = nwg / NXCD, r = nwg % NXCD, xcd = wgid % NXCD, off = wgid / NXCD; wgid = (xcd < r ? xcd * (q + 1) : r * (q + 1) + (xcd - r) * q) + off; }
    const int nig = WGM * nN, gid = wgid / nig, fm = gid * WGM, gsz = (nM - fm) < WGM ? (nM - fm) : WGM;
    pm = fm + ((wgid % nig) % gsz); pn = (wgid % nig) / gsz;
}

template <class Epi, class Sched, bool ALIGN_EPI, bool SP2>
__device__ __forceinline__ void gemm_phase(PG8_LAS unsigned char* lds, const int K, const int lda, const int ldb, const Sched& S, const Epi& E) {
    int tid_ = threadIdx.x; asm volatile("" : "+v"(tid_));
    const int tid = tid_, wid = __builtin_amdgcn_readfirstlane(tid >> 6), lane = tid & 63, wr = wid >> 2, wc = wid & 3, fr = lane & 15, fq = lane >> 4;
    const int nt = K / BK;
    unsigned voffA[2], voffB[2];
#pragma unroll
    for (int i = 0; i < 2; ++i) { int R, C; stage_rc(tid * 16 + i * 8192, R, C); const int Rb = Epi::PERM ? ((R & ~31) + perm32(R & 31)) : R;
        voffA[i] = (unsigned)(R * lda + C) * 2u; voffB[i] = (unsigned)(Rb * ldb + C) * 2u; }
    const size_t kstep = (size_t)(BK * 2);
    const size_t hstepA = (size_t)HALF * lda * 2, hstepB = (size_t)HALF * ldb * 2;
    const unsigned ldsw = (unsigned)wid * 1024u;
    const int aoff = lds_byte(wr * 64 + fr, fq * 8), boff = lds_byte(wc * 32 + fr, fq * 8);
#define PG8_SA(b, h) (((b) * 2 + (h)) * HTB)
#define PG8_SB(b, h) ((4 + (b) * 2 + (h)) * HTB)
#define PG8_STAGE(bufoff, gbase, voff) do { _Pragma("unroll") for (int _i = 0; _i < 2; ++_i) \
        __builtin_amdgcn_global_load_lds((const unsigned*)((const char*)(gbase) + (voff)[_i]), (PG8_LAS unsigned*)(lds + (bufoff) + ldsw + _i * 8192), 16, 0, 0); } while (0)
#define PG8_LDA(dst, b, h) do { _Pragma("unroll") for (int m = 0; m < 4; ++m) _Pragma("unroll") for (int k = 0; k < 2; ++k) dst[m][k] = *(const PG8_LAS bf16x8*)(lds + PG8_SA(b, h) + aoff + m * 2048 + k * 1024); } while (0)
#define PG8_LDB(dst, b, h) do { _Pragma("unroll") for (int n = 0; n < 2; ++n) _Pragma("unroll") for (int k = 0; k < 2; ++k) dst[n][k] = *(const PG8_LAS bf16x8*)(lds + PG8_SB(b, h) + boff + n * 2048 + k * 1024); } while (0)
#define PG8_MMA(ai, bj, At, Bt) do { __builtin_amdgcn_s_setprio(1); _Pragma("unroll") for (int m = 0; m < 4; ++m) _Pragma("unroll") for (int n = 0; n < 2; ++n) _Pragma("unroll") for (int k = 0; k < 2; ++k) \
        acc[ai][bj][m][n] = __builtin_amdgcn_mfma_f32_16x16x32_bf16(Bt[n][k], At[m][k], acc[ai][bj][m][n], 0, 0, 0); __builtin_amdgcn_s_setprio(0); } while (0)
#define PG8_WAIT_V(n) asm volatile("s_waitcnt vmcnt(" #n ")" ::: "memory")
#define PG8_WAIT_L(n) asm volatile("s_waitcnt lgkmcnt(" #n ")" ::: "memory")
#define PG8_BAR __builtin_amdgcn_s_barrier()
#define PG8_SCHED __builtin_amdgcn_sched_barrier(0)
    Unit cur, nxt; int ui = 0;
    if (!S.next(0, cur)) return;
    f32x4 acc[2][2][4][2];
#pragma unroll
    for (int a = 0; a < 2; ++a)
#pragma unroll
        for (int b = 0; b < 2; ++b)
#pragma unroll
            for (int m = 0; m < 4; ++m)
#pragma unroll
                for (int n = 0; n < 2; ++n) acc[a][b][m][n] = (f32x4){0.f, 0.f, 0.f, 0.f};
    bf16x8 At[4][2], B0[2][2], B1[2][2];
    const char* cA = cur.A; const char* cB = cur.B;
    if constexpr (SP2) {
        PG8_STAGE(PG8_SB(0, 0), cB, voffB); PG8_STAGE(PG8_SB(0, 1), cB + hstepB, voffB); PG8_STAGE(PG8_SA(0, 0), cA, voffA); PG8_STAGE(PG8_SA(0, 1), cA + hstepA, voffA);
        if (wr == 1) PG8_BAR;
        PG8_WAIT_V(2); PG8_BAR;
        PG8_STAGE(PG8_SB(1, 0), cB + kstep, voffB); PG8_STAGE(PG8_SA(1, 0), cA + kstep, voffA); PG8_STAGE(PG8_SB(1, 1), cB + hstepB + kstep, voffB);
        PG8_WAIT_V(6); PG8_BAR;
    } else {
        PG8_STAGE(PG8_SB(0, 0), cB, voffB); PG8_STAGE(PG8_SA(0, 0), cA, voffA); PG8_STAGE(PG8_SB(0, 1), cB + hstepB, voffB); PG8_STAGE(PG8_SA(0, 1), cA + hstepA, voffA);
        if (wr == 1) PG8_BAR;
        PG8_WAIT_V(4); PG8_BAR;
        PG8_STAGE(PG8_SB(1, 0), cB + kstep, voffB); PG8_STAGE(PG8_SA(1, 0), cA + kstep, voffA); PG8_STAGE(PG8_SB(1, 1), cB + hstepB + kstep, voffB);
        PG8_WAIT_V(6); PG8_BAR;
    }
    for (;;) {
        const bool has_next = S.next(ui + 1, nxt);
        const char* nA = has_next ? nxt.A : cA; const char* nB = has_next ? nxt.B : cB;
        for (int t = 0; t < nt; t += 2) {
            const bool last = (t == nt - 2);
            const char* a1 = cA + (size_t)(t + 1) * kstep;
            const char* a2 = last ? nA : cA + (size_t)(t + 2) * kstep; const char* b2 = last ? nB : cB + (size_t)(t + 2) * kstep;
            const char* a3 = a2 + kstep; const char* b3 = b2 + kstep;
            if constexpr (SP2) {
            PG8_LDB(B0, 0, 0); PG8_LDB(B1, 0, 1); PG8_SCHED; PG8_LDA(At, 0, 0); PG8_STAGE(PG8_SA(1, 1), a1 + hstepA, voffA);
            PG8_WAIT_V(8); PG8_WAIT_L(0); PG8_BAR; PG8_MMA(0, 0, At, B0); PG8_MMA(0, 1, At, B1); PG8_BAR; PG8_SCHED;
            PG8_LDA(At, 0, 1); PG8_STAGE(PG8_SB(0, 0), b2, voffB); PG8_STAGE(PG8_SB(0, 1), b2 + hstepB, voffB); PG8_STAGE(PG8_SA(0, 0), a2, voffA);
            PG8_WAIT_V(8); PG8_WAIT_L(0); PG8_BAR; PG8_MMA(1, 0, At, B0); PG8_MMA(1, 1, At, B1); PG8_BAR; PG8_SCHED;
            PG8_LDB(B0, 1, 0); PG8_LDB(B1, 1, 1); PG8_SCHED; PG8_LDA(At, 1, 0); PG8_STAGE(PG8_SA(0, 1), a2 + hstepA, voffA);
            PG8_WAIT_V(8); PG8_WAIT_L(0); PG8_BAR; PG8_MMA(0, 0, At, B0); PG8_MMA(0, 1, At, B1); PG8_BAR; PG8_SCHED;
            PG8_LDA(At, 1, 1); PG8_STAGE(PG8_SB(1, 0), b3, voffB); PG8_STAGE(PG8_SB(1, 1), b3 + hstepB, voffB); PG8_STAGE(PG8_SA(1, 0), a3, voffA);
            PG8_WAIT_V(8); PG8_WAIT_L(0); PG8_BAR; PG8_MMA(1, 0, At, B0); PG8_MMA(1, 1, At, B1); PG8_BAR; PG8_SCHED;
            } else {
            PG8_LDB(B0, 0, 0); PG8_SCHED; PG8_LDA(At, 0, 0); PG8_STAGE(PG8_SA(1, 1), a1 + hstepA, voffA);
            PG8_WAIT_L(8); PG8_BAR; PG8_WAIT_L(0); PG8_MMA(0, 0, At, B0); PG8_BAR; PG8_SCHED;
            PG8_LDB(B1, 0, 1); PG8_STAGE(PG8_SB(0, 0), b2, voffB);
            PG8_BAR; PG8_WAIT_L(0); PG8_MMA(0, 1, At, B1); PG8_BAR;
            PG8_LDA(At, 0, 1); PG8_STAGE(PG8_SA(0, 0), a2, voffA);
            PG8_BAR; PG8_WAIT_L(0); PG8_MMA(1, 0, At, B0); PG8_BAR; PG8_SCHED;
            PG8_STAGE(PG8_SB(0, 1), b2 + hstepB, voffB);
            PG8_WAIT_V(6); PG8_BAR; PG8_MMA(1, 1, At, B1); PG8_BAR;
            PG8_LDB(B0, 1, 0); PG8_SCHED; PG8_LDA(At, 1, 0); PG8_STAGE(PG8_SA(0, 1), a2 + hstepA, voffA);
            PG8_WAIT_L(8); PG8_BAR; PG8_WAIT_L(0); PG8_MMA(0, 0, At, B0); PG8_BAR; PG8_SCHED;
            PG8_LDB(B1, 1, 1); PG8_STAGE(PG8_SB(1, 0), b3, voffB);
            PG8_BAR; PG8_WAIT_L(0); PG8_MMA(0, 1, At, B1); PG8_BAR;
            PG8_LDA(At, 1, 1); PG8_STAGE(PG8_SA(1, 0), a3, voffA);
            PG8_BAR; PG8_WAIT_L(0); PG8_MMA(1, 0, At, B0); PG8_BAR; PG8_SCHED;
            PG8_STAGE(PG8_SB(1, 1), b3 + hstepB, voffB);
            PG8_WAIT_V(6); PG8_BAR; PG8_MMA(1, 1, At, B1); PG8_BAR;
            }
        }
        if constexpr (ALIGN_EPI) { if (wr == 0) PG8_BAR; }
        { int fr_ = fr, fq_ = fq, wr_ = wr, wc_ = wc; asm volatile("" : "+v"(fr_), "+v"(fq_), "+s"(wr_), "+s"(wc_));
          E(acc, cur, wr_, wc_, fr_, fq_); }
        if (!has_next) break;
#pragma unroll
        for (int a = 0; a < 2; ++a)
#pragma unroll
            for (int b = 0; b < 2; ++b)
#pragma unroll
                for (int m = 0; m < 4; ++m)
#pragma unroll
                    for (int n = 0; n < 2; ++n) acc[a][b][m][n] = (f32x4){0.f, 0.f, 0.f, 0.f};
        cur = nxt; cA = nA; cB = nB; ++ui;
        if constexpr (ALIGN_EPI) { if (wr == 1) PG8_BAR; }
    }
    PG8_WAIT_V(0);
    if constexpr (!ALIGN_EPI) { if (wr == 0) PG8_BAR; }
    PG8_BAR;
#undef PG8_SA
#undef PG8_SB
#undef PG8_STAGE
#undef PG8_LDA
#undef PG8_LDB
#undef PG8_MMA
#undef PG8_WAIT_V
#undef PG8_WAIT_L
#undef PG8_BAR
#undef PG8_SCHED
}
}
constexpr int D = 1024, NB = 2, S = 8192, CTX = 256, NTOK = NB * S, NCTX = NB * CTX, NALL = NTOK + NCTX;
constexpr int DIN = 3328;
constexpr int NH = 8, NKV = 2, HD = 64, DSSM = 512, NG = 32, GS = 16, NST = 64, TC = 32;
constexpr int NE = 32, DE = 512;
constexpr int NCH = 768;
constexpr int NCHV = 528;
constexpr float C2 = 0.125f * 1.4426950408889634f;
constexpr float LOG2E = 1.4426950408889634f;
constexpr int NWAVES = 8;
constexpr int MAXROWS = 41984;

constexpr size_t MiB = 1u << 20;
constexpr size_t WS_CTL = 0, CTL_ZERO_BYTES = 1 * MiB;
constexpr size_t WS_SMALL = 1 * MiB;
constexpr size_t SM_MOD = WS_SMALL + 0;
constexpr size_t SM_ROPE = WS_SMALL + 0x30000;
constexpr size_t SM_WRT = WS_SMALL + 0x40000;
constexpr size_t SM_SSMTAB = WS_SMALL + 0x90000;
constexpr size_t SM_RE = WS_SMALL + 0xC0000;
constexpr size_t SM_RW = SM_RE + (size_t)NALL * 8;
constexpr size_t SM_RSLOT = SM_RW + (size_t)NALL * 8;
constexpr size_t SM_RDEST = SM_RSLOT + (size_t)NALL * 8;
constexpr size_t SM_RWS = SM_RDEST + (size_t)NALL * 8;
static_assert(SM_RWS + (size_t)MAXROWS * 4 <= 8 * MiB, "small region");
constexpr size_t WS_W = 8 * MiB;
constexpr size_t W_IN = WS_W, W_GLU = W_IN + (size_t)DIN * D * 2, W_BRA = W_GLU + 512 * 512 * 2, W_BRS = W_BRA + 1024 * 512 * 2, W_OUT = W_BRS + 1024 * 512 * 2;
constexpr size_t W_S3 = W_OUT + 1024 * 1024 * 2, W_SE = W_S3 + (size_t)NG * 512 * 768 * 2, W_GU = W_SE + (size_t)NG * 256 * 512 * 2, W_DN = W_GU + (size_t)NE * 1024 * 1024 * 2;
constexpr size_t WS_XC = W_DN + (size_t)NE * 1024 * 512 * 2;
static_assert(WS_XC == 147 * MiB, "weights region");
constexpr size_t WS_H = WS_XC + (size_t)NALL * D * 4;
constexpr size_t WS_BIG = WS_H + (size_t)NALL * D * 2;
constexpr size_t B_Q = WS_BIG, B_K = B_Q + (size_t)NALL * 512 * 2, B_VT = B_K + (size_t)NALL * 128 * 2, B_A3 = B_VT + (size_t)NALL * 128 * 2;
constexpr size_t B_GA = B_A3 + (size_t)NG * NCH * 768 * 2, B_GS = B_GA + (size_t)NALL * D * 2, B_ATT = B_GS + (size_t)NALL * D * 2, B_SEND = B_ATT + (size_t)NALL * 512 * 2;
constexpr size_t B_Z = B_SEND + (size_t)NG * NCH * 256 * 4, B_SG = B_Z + (size_t)NALL * 512 * 2, B_T1 = B_SG + (size_t)NALL * 512 * 2, B_MB = B_T1 + (size_t)NALL * D * 2;
constexpr size_t B_END1 = B_MB + (size_t)NALL * D * 2;
constexpr size_t B_HS = WS_BIG, B_ACT = B_HS + (size_t)MAXROWS * D * 2, B_YE = B_ACT + (size_t)MAXROWS * DE * 2, B_END2 = B_YE + (size_t)MAXROWS * D * 2;
constexpr size_t WS_END = 544 * MiB;
static_assert(B_END1 <= WS_END && B_END2 <= WS_END, "d_ws map");
constexpr int CW_TMO = 0, CW_CODE = 1;
constexpr int CW_BAR = 4096;
constexpr int CW_CNT = 8192;
constexpr int CW_WORK = 8448;

constexpr int LDS_BYTES = 147456;
constexpr int LDSCTL_OFF = 143360;
constexpr int L_BARST = LDSCTL_OFF + 32;
constexpr int L_MOETAB = LDSCTL_OFF + 256;
constexpr int L_WGCNT = LDSCTL_OFF + 1024;
constexpr int L_MISC = LDSCTL_OFF + 2048;

#define GAS __attribute__((address_space(1)))
#define LAS __attribute__((address_space(3)))
typedef unsigned short bf16;
typedef unsigned v4u __attribute__((ext_vector_type(4)));
typedef unsigned v2u __attribute__((ext_vector_type(2)));
typedef float f32x4 __attribute__((ext_vector_type(4)));
typedef float f32x16 __attribute__((ext_vector_type(16)));
typedef short bf16x8 __attribute__((ext_vector_type(8)));
typedef short bf16x4 __attribute__((ext_vector_type(4)));
typedef GAS unsigned gu32;
#define RLX_AGENT __ATOMIC_RELAXED, __HIP_MEMORY_SCOPE_AGENT
#define LDS_WAIT() asm volatile("s_waitcnt lgkmcnt(0)" ::: "memory")
#define VM_WAIT() asm volatile("s_waitcnt vmcnt(0)" ::: "memory")
using pg8::cvt_pk_bf16; using pg8::bf_lo; using pg8::bf_hi;
__device__ __forceinline__ float sigmoid_f(float x) { return __builtin_amdgcn_rcpf(1.f + __expf(-x)); }
__device__ __forceinline__ float gelu_tanh_f(float x) {
    const float u = 0.7978845608028654f * (x + 0.044715f * x * x * x);
    return x * sigmoid_f(2.f * u);
}

#define XB_TMO      128
#define XB_XCNT(j)  (256  + 64 * (j))
#define XB_XSUB(j)  (1280 + 64 * (j))
#define XB_XGEN(j)  (2304 + 64 * (j))
#define XB_TOP      3328
#define XB_TOPGEN   3392
#define XCD_BAR_WORDS 3456
#define XB_SPIN_CAP (1u << 18)
__device__ __forceinline__ unsigned xb_ld(unsigned* p)              { return __hip_atomic_load(p, __ATOMIC_RELAXED, __HIP_MEMORY_SCOPE_AGENT); }
__device__ __forceinline__ unsigned xb_add(unsigned* p, unsigned v) { return __hip_atomic_fetch_add(p, v, __ATOMIC_RELAXED, __HIP_MEMORY_SCOPE_AGENT); }
__device__ __forceinline__ unsigned xb_xcc_id() { return (unsigned)__builtin_amdgcn_s_getreg((3 << 11) | 20) & 0xFu; }
#define XB_SPIN(cond, bar) do { unsigned _sp = 0; while (cond) { __builtin_amdgcn_s_sleep(1); \
    if ((++_sp & 255u) == 0u) { if (xb_ld(&(bar)[XB_TMO])) break; if (_sp > XB_SPIN_CAP) { atomicAdd(&(bar)[XB_TMO], 1u); break; } } } } while (0)
struct XcdBarrier { unsigned* bar; unsigned x; volatile LAS unsigned* st; };
__device__ __forceinline__ XcdBarrier xcd_barrier_post(unsigned* bar, volatile LAS unsigned* st) {
    XcdBarrier b; b.bar = bar; b.x = xb_xcc_id(); b.st = st;
    if (threadIdx.x == 0) (void)xb_add(&bar[XB_XCNT(b.x)], 1u);
    return b;
}
__device__ __forceinline__ void xcd_barrier_complete(unsigned* bar, unsigned x, unsigned& nloc, unsigned& nx) {
    const unsigned G = gridDim.x * gridDim.y * gridDim.z;
    unsigned sum, cnt, mine, sp = 0u;
    for (;;) {
        sum = 0u; cnt = 0u; mine = 0u;
#pragma unroll 1
        for (unsigned j = 0; j < 16; ++j) { const unsigned c = xb_ld(&bar[XB_XCNT(j)]); sum += c; cnt += (c > 0u) ? 1u : 0u; mine = (j == x) ? c : mine; }
        if (sum == G) break;
        __builtin_amdgcn_s_sleep(1);
        if ((++sp & 255u) == 0u) { if (xb_ld(&bar[XB_TMO])) break; if (sp > XB_SPIN_CAP) { atomicAdd(&bar[XB_TMO], 1u); break; } }
    }
    nloc = mine > 0u ? mine : 1u; nx = cnt > 0u ? cnt : 1u;
}
__device__ __forceinline__ void xcd_barrier(const XcdBarrier& b) {
    asm volatile("s_waitcnt vmcnt(0)" ::: "memory");
    __syncthreads();
    if (threadIdx.x == 0) {
        unsigned* bar = b.bar;
        __builtin_amdgcn_s_waitcnt(0);
        unsigned nloc = b.st[0], nx = b.st[1];
        if (nloc == 0u) { xcd_barrier_complete(bar, b.x, nloc, nx); b.st[0] = nloc; b.st[1] = nx; }
        const unsigned old = xb_add(&bar[XB_XSUB(b.x)], 1u);
        const unsigned gen = old / nloc;
        if (old + 1u == (gen + 1u) * nloc) {
            __builtin_amdgcn_fence(__ATOMIC_RELEASE, "agent");
            asm volatile("s_waitcnt vmcnt(0)" ::: "memory");
            const unsigned og = xb_add(&bar[XB_TOP], 1u);
            const unsigned tg = og / nx;
            if (og + 1u == (tg + 1u) * nx) xb_add(&bar[XB_TOPGEN], 1u);
            else XB_SPIN(xb_ld(&bar[XB_TOPGEN]) == tg, bar);
            __builtin_amdgcn_fence(__ATOMIC_ACQUIRE, "agent");
            xb_add(&bar[XB_XGEN(b.x)], 1u);
            asm volatile("s_waitcnt vmcnt(0)" ::: "memory");
        } else {
            XB_SPIN(xb_ld(&bar[XB_XGEN(b.x)]) == gen, bar);
            __builtin_amdgcn_fence(__ATOMIC_ACQUIRE, "agent");
            asm volatile("s_waitcnt vmcnt(0)" ::: "memory");
        }
    }
    __syncthreads();
}

struct Inputs {
    const float *x, *c, *ctx, *c_ctx, *w_mod, *b_mod, *g1, *g2, *w_in, *sink, *lam_re, *lam_im, *log_dt, *sb_re, *sb_im, *sc_re, *sc_im, *ssm_d,
        *w_glu, *w_bra, *w_brs, *w_out, *w_rg, *w_re, *w_eg, *w_eu, *w_ed, *g_final;
};
struct Frame {
    LAS unsigned char* lds;
    gu32* ctl;
    unsigned char* ws;
    int tid, lane, wave;
    int vcu, G;
    float* out;
};
__device__ __forceinline__ float wave_sum(float v) {
#pragma unroll
    for (int o = 1; o < 64; o <<= 1) v += __shfl_xor(v, o);
    return v;
}
__device__ __forceinline__ int which_of_row(int r) { return r < NTOK ? (r >> 13) : 2; }
__device__ __forceinline__ unsigned f2bf_rne(float f) { unsigned u = __builtin_bit_cast(unsigned, f); return (u + 0x7fffu + ((u >> 16) & 1u)) >> 16; }
__device__ __forceinline__ unsigned pk2(float lo, float hi) { return f2bf_rne(lo) | (f2bf_rne(hi) << 16); }
__device__ __forceinline__ void transpose_item(const float* W, int K, int N, bf16* WT, int mode, LAS float* scr, int item, int lane) {
    const int nblk = N / 32, kb = item / nblk, nb = item % nblk, k0 = 64 * kb, n0 = 32 * nb;
#pragma unroll 8
    for (int i = 0; i < 32; ++i) { const int kk = 2 * i + (lane >> 5); scr[kk * 33 + (lane & 31)] = W[(size_t)(k0 + kk) * N + n0 + (lane & 31)]; }
    LDS_WAIT(); asm volatile("" ::: "memory");
    const int c = lane & 7;
#pragma unroll
    for (int j = 0; j < 4; ++j) { const int n = (lane >> 3) + 8 * j; const LAS float* s = scr + (8 * c) * 33 + n;
        v4u o; o.x = pk2(s[0 * 33], s[1 * 33]); o.y = pk2(s[2 * 33], s[3 * 33]); o.z = pk2(s[4 * 33], s[5 * 33]); o.w = pk2(s[6 * 33], s[7 * 33]);
        const int ng = n0 + n; const int row = mode == 0 ? ng : (8 * (ng >> 2) + (ng & 3) + (mode == 2 ? 4 : 0));
        *(GAS v4u*)(WT + (size_t)row * K + k0 + 8 * c) = o; }
    LDS_WAIT(); asm volatile("" ::: "memory");
}
constexpr int CV_IN = (D / 64) * (DIN / 32), CV_GLU = 8 * 16, CV_BR = 8 * 32, CV_OUT = 16 * 32, CV_G1 = 16 * 16, CV_D1 = 8 * 32;
constexpr int CV_TOTAL = CV_IN + CV_GLU + 2 * CV_BR + CV_OUT + NE * (2 * CV_G1 + CV_D1);
__device__ __forceinline__ void convert_item(const Inputs& I, unsigned char* ws, int l, int it, LAS float* scr, int lane) {
    int r = it;
    if (r < CV_IN) { transpose_item(I.w_in + (size_t)l * D * DIN, D, DIN, (bf16*)(ws + W_IN), 0, scr, r, lane); return; } r -= CV_IN;
    if (r < CV_GLU) { transpose_item(I.w_glu + (size_t)l * 512 * 512, 512, 512, (bf16*)(ws + W_GLU), 0, scr, r, lane); return; } r -= CV_GLU;
    if (r < CV_BR) { transpose_item(I.w_bra + (size_t)l * 512 * D, 512, D, (bf16*)(ws + W_BRA), 0, scr, r, lane); return; } r -= CV_BR;
    if (r < CV_BR) { transpose_item(I.w_brs + (size_t)l * 512 * D, 512, D, (bf16*)(ws + W_BRS), 0, scr, r, lane); return; } r -= CV_BR;
    if (r < CV_OUT) { transpose_item(I.w_out + (size_t)l * D * D, D, D, (bf16*)(ws + W_OUT), 0, scr, r, lane); return; } r -= CV_OUT;
    if (r < NE * CV_G1) { const int e = r / CV_G1; transpose_item(I.w_eg + ((size_t)l * NE + e) * D * DE, D, DE, (bf16*)(ws + W_GU) + (size_t)e * 1024 * 1024, 1, scr, r % CV_G1, lane); return; } r -= NE * CV_G1;
    if (r < NE * CV_G1) { const int e = r / CV_G1; transpose_item(I.w_eu + ((size_t)l * NE + e) * D * DE, D, DE, (bf16*)(ws + W_GU) + (size_t)e * 1024 * 1024, 2, scr, r % CV_G1, lane); return; } r -= NE * CV_G1;
    { const int e = r / CV_D1; transpose_item(I.w_ed + ((size_t)l * NE + e) * DE * D, DE, D, (bf16*)(ws + W_DN) + (size_t)e * 1024 * 512, 0, scr, r % CV_D1, lane); }
}
__device__ __forceinline__ void convert_weights(Frame& F, const Inputs& I, int l) {
    LAS float* scr = (LAS float*)(F.lds + F.wave * 16384);
    gu32* ctr = F.ctl + CW_WORK + 64 * l;
    for (;;) {
        int it = 0;
        if (F.lane == 0) it = (int)__hip_atomic_fetch_add(ctr, 1u, RLX_AGENT);
        it = __builtin_amdgcn_readfirstlane(it);
        if (it >= CV_TOTAL) break;
        convert_item(I, F.ws, l, it, scr, F.lane);
    }
}

__device__ __forceinline__ void ssm_cs(float li, float dt, int tau, float& c, float& s) {
    const double x = (double)tau * ((double)li * (double)dt);
    const double k = __builtin_rint(x * 0.15915494309189535);
    const float r = (float)(x - k * 6.283185307179586);
    c = cosf(r); s = sinf(r);
}
__device__ __forceinline__ void ssmgen_job(Frame& F, const Inputs& I, int l, int g) {
    LAS float* Kt = (LAS float*)(F.lds);
    LAS float* apw = (LAS float*)(F.lds + 65536);
    LAS float* Bb = (LAS float*)(F.lds + 99328);
    LAS float* Ct = (LAS float*)(F.lds + 115712);
    const int tid = F.tid;
    __syncthreads();
    if (tid < 128) {
        const int dir = tid >> 6, p = tid & 63, pg = (l * 2 + dir) * NG + g;
        const float lr = I.lam_re[pg * NST + p], li = I.lam_im[pg * NST + p], dt = expf(I.log_dt[pg]);
        float c1, s1; ssm_cs(li, dt, 1, c1, s1);
        const float mag = expf(lr * dt), sh = sinf(0.5f * li * dt);
        const float are = mag * c1, aim = mag * s1, nr = expm1f(lr * dt) * c1 - 2.f * sh * sh, den = lr * lr + li * li;
        const float fre = (nr * lr + aim * li) / den, fim = (aim * lr - nr * li) / den;
#pragma unroll 4
        for (int m = 0; m < 16; ++m) {
            const float br = I.sb_re[((size_t)pg * NST + p) * GS + m], bi = I.sb_im[((size_t)pg * NST + p) * GS + m];
            Bb[((dir * 64 + p) * 16 + m) * 2 + 0] = fre * br - fim * bi;
            Bb[((dir * 64 + p) * 16 + m) * 2 + 1] = fre * bi + fim * br;
            Ct[((dir * 64 + p) * 16 + m) * 2 + 0] = I.sc_re[((size_t)pg * GS + m) * NST + p];
            Ct[((dir * 64 + p) * 16 + m) * 2 + 1] = I.sc_im[((size_t)pg * GS + m) * NST + p];
        }
        float* tab = (float*)(F.ws + SM_SSMTAB);
        float c32, s32; ssm_cs(li, dt, 32, c32, s32);
        const float m32 = expf(32.f * lr * dt), a32r = m32 * c32, a32i = m32 * s32;
        float pr = a32r, pi = a32i;
#pragma unroll
        for (int q = 0; q < 5; ++q) { const float nr2 = pr * pr - pi * pi, ni2 = 2.f * pr * pi; pr = nr2; pi = ni2; }
        const float sr = pr * a32r - pi * a32i, si = pr * a32i + pi * a32r;
        const size_t ti = ((((size_t)l * NG + g) * 2 + dir) * 64 + p) * 2;
        tab[ti] = a32r; tab[ti + 1] = a32i; tab[16384 + ti] = sr; tab[16384 + ti + 1] = si;
    }
    for (int idx = tid; idx < 2 * 64 * 33; idx += 512) {
        const int tau = idx % 33, p = (idx / 33) & 63, dir = idx / (33 * 64), pg = (l * 2 + dir) * NG + g;
        const float lr = I.lam_re[pg * NST + p], li = I.lam_im[pg * NST + p], dt = expf(I.log_dt[pg]);
        float c, sn; ssm_cs(li, dt, tau, c, sn);
        const float mg = expf((float)tau * lr * dt);
        apw[idx * 2] = mg * c; apw[idx * 2 + 1] = mg * sn;
    }
    __syncthreads();
    for (int idx = tid; idx < 1024; idx += 512) {
        const int dir = idx >> 9, tau = (idx >> 4) & 31, mp = idx & 15;
        float acc[16];
#pragma unroll
        for (int m = 0; m < 16; ++m) acc[m] = 0.f;
        for (int p = 0; p < 64; ++p) {
            const float ar = apw[((dir * 64 + p) * 33 + tau) * 2], ai = apw[((dir * 64 + p) * 33 + tau) * 2 + 1];
            const float br = Bb[((dir * 64 + p) * 16 + mp) * 2], bi = Bb[((dir * 64 + p) * 16 + mp) * 2 + 1];
            const float tr = ar * br - ai * bi, ti = ar * bi + ai * br;
            const LAS f32x4* cp = (const LAS f32x4*)(Ct + (dir * 64 + p) * 32);
#pragma unroll
            for (int q = 0; q < 8; ++q) { const f32x4 cv = cp[q]; acc[2 * q] += cv.x * tr - cv.y * ti; acc[2 * q + 1] += cv.z * tr - cv.w * ti; }
        }
#pragma unroll
        for (int m = 0; m < 16; ++m) Kt[((dir * 32 + tau) * 16 + m) * 16 + mp] = acc[m];
    }
    __syncthreads();
    bf16* W3 = (bf16*)(F.ws + W_S3) + (size_t)g * 512 * 768;
    const float* dsk = I.ssm_d + l * DSSM + g * 16;
    for (int q = tid; q < 512 * 96; q += 512) {
        const int n = q / 96, k0 = (q % 96) * 8, t = n >> 4, m = n & 15;
        float v[8];
        if (k0 < 512) {
            const int s = k0 >> 4, mp0 = k0 & 15;
            if (s < t) { const LAS float* kp = Kt + ((0 * 32 + (t - s)) * 16 + m) * 16 + mp0;
#pragma unroll
                for (int j = 0; j < 8; ++j) v[j] = kp[j]; }
            else if (s > t) { const LAS float* kp = Kt + ((1 * 32 + (s - t)) * 16 + m) * 16 + mp0;
#pragma unroll
                for (int j = 0; j < 8; ++j) v[j] = kp[j]; }
            else { const LAS float* k0p = Kt + ((0 * 32 + 0) * 16 + m) * 16 + mp0; const LAS float* k1p = Kt + ((1 * 32 + 0) * 16 + m) * 16 + mp0; const float dv = dsk[m];
#pragma unroll
                for (int j = 0; j < 8; ++j) v[j] = k0p[j] + k1p[j] + ((mp0 + j) == m ? dv : 0.f); }
        } else {
            const int kk = k0 - 512, dir = kk >> 7, ri = (kk >> 6) & 1, p0 = kk & 63, tw = dir == 0 ? t + 1 : 32 - t;
#pragma unroll
            for (int j = 0; j < 8; ++j) { const int p = p0 + j;
                const float cr = Ct[((dir * 64 + p) * 16 + m) * 2], ci = Ct[((dir * 64 + p) * 16 + m) * 2 + 1];
                const float ar = apw[((dir * 64 + p) * 33 + tw) * 2], ai = apw[((dir * 64 + p) * 33 + tw) * 2 + 1];
                v[j] = ri == 0 ? (cr * ar - ci * ai) : -(cr * ai + ci * ar); }
        }
        v4u o; o.x = pk2(v[0], v[1]); o.y = pk2(v[2], v[3]); o.z = pk2(v[4], v[5]); o.w = pk2(v[6], v[7]);
        *(GAS v4u*)(W3 + (size_t)n * 768 + k0) = o;
    }
    bf16* E = (bf16*)(F.ws + W_SE) + (size_t)g * 256 * 512;
    for (int q = tid; q < 256 * 64; q += 512) {
        const int n = q >> 6, k0 = (q & 63) * 8, dir = n >> 7, ri = (n >> 6) & 1, p = n & 63, s = k0 >> 4, mp0 = k0 & 15, te = dir == 0 ? 31 - s : s;
        const float ar = apw[((dir * 64 + p) * 33 + te) * 2], ai = apw[((dir * 64 + p) * 33 + te) * 2 + 1];
        float v[8];
#pragma unroll
        for (int j = 0; j < 8; ++j) { const float br = Bb[((dir * 64 + p) * 16 + mp0 + j) * 2], bi = Bb[((dir * 64 + p) * 16 + mp0 + j) * 2 + 1];
            v[j] = ri == 0 ? (ar * br - ai * bi) : (ar * bi + ai * br); }
        v4u o; o.x = pk2(v[0], v[1]); o.y = pk2(v[2], v[3]); o.z = pk2(v[4], v[5]); o.w = pk2(v[6], v[7]);
        *(GAS v4u*)(E + (size_t)n * 512 + k0) = o;
    }
    __syncthreads();
}

__device__ __forceinline__ void mod_item(Frame& F, const Inputs& I, int item) {
    LAS float* sl = (LAS float*)(F.lds);
    LAS float* part = (LAS float*)(F.lds + 16384);
    __syncthreads();
    for (int i = F.tid; i < 3 * 1024; i += 512) { const int w = i >> 10, k = i & 1023; const float v = w < 2 ? I.c[w * D + k] : I.c_ctx[k]; sl[i] = v / (1.f + expf(-v)); }
    __syncthreads();
    const int l = item / 96, cb = item % 96, col = cb * 64 + F.lane;
    const float* W = I.w_mod + (size_t)l * D * 6144;
    float a0 = 0.f, a1 = 0.f, a2 = 0.f;
#pragma unroll 16
    for (int kk = 0; kk < 128; ++kk) { const int k = F.wave * 128 + kk; const float wv = W[(size_t)k * 6144 + col]; a0 += sl[k] * wv; a1 += sl[1024 + k] * wv; a2 += sl[2048 + k] * wv; }
    part[(F.wave * 3 + 0) * 64 + F.lane] = a0; part[(F.wave * 3 + 1) * 64 + F.lane] = a1; part[(F.wave * 3 + 2) * 64 + F.lane] = a2;
    __syncthreads();
    if (F.tid < 192) { const int w = F.tid >> 6, c = F.tid & 63; float s = 0.f;
#pragma unroll
        for (int v = 0; v < 8; ++v) s += part[(v * 3 + w) * 64 + c];
        ((float*)(F.ws + SM_MOD))[(l * 3 + w) * 6144 + cb * 64 + c] = s + I.b_mod[l * 6144 + cb * 64 + c]; }
    __syncthreads();
}
__device__ __forceinline__ void p0_small(Frame& F, const Inputs& I) {
    const int b = F.vcu - 224;
    if (b < 0) return;
    const int t = b * 512 + F.tid, NT = 32 * 512;
    float* rope = (float*)(F.ws + SM_ROPE);
    for (int i = t; i < 128 * 16; i += NT) { const int pos = i >> 4, j = i & 15; const float freq = exp2f(-(float)j * (13.287712379549449f / 16.f)); const float ang = (float)pos * freq;
        const double x = (double)ang; const double k = __builtin_rint(x * 0.15915494309189535); const float r = (float)(x - k * 6.283185307179586);
        rope[i] = cosf(r); rope[2048 + i] = sinf(r); }
    float* wrt = (float*)(F.ws + SM_WRT);
    for (int i = t; i < 2 * 36 * 1024; i += NT) { const int k = i & 1023, j = (i >> 10) % 36, l = i / (36 * 1024);
        wrt[i] = j < 4 ? I.w_rg[((size_t)l * D + k) * 4 + j] : I.w_re[((size_t)l * D + k) * 32 + (j - 4)]; }
}
struct RowVec { f32x4 v[4]; };
__device__ __forceinline__ RowVec load_row_f32(const float* p, int lane) { RowVec r; const GAS f32x4* q = (const GAS f32x4*)p + lane;
#pragma unroll
    for (int j = 0; j < 4; ++j) r.v[j] = q[64 * j]; return r; }
__device__ __forceinline__ void store_row_f32(float* p, int lane, const RowVec& r) { GAS f32x4* q = (GAS f32x4*)p + lane;
#pragma unroll
    for (int j = 0; j < 4; ++j) q[64 * j] = r.v[j]; }
__device__ __forceinline__ RowVec load_row_bf16(const bf16* p, int lane) { RowVec r; const GAS v2u* q = (const GAS v2u*)p + lane;
#pragma unroll
    for (int j = 0; j < 4; ++j) { const v2u w = q[64 * j]; r.v[j] = (f32x4){bf_lo(w.x), bf_hi(w.x), bf_lo(w.y), bf_hi(w.y)}; } return r; }
__device__ __forceinline__ void store_row_bf16(bf16* p, int lane, const RowVec& r) { GAS v2u* q = (GAS v2u*)p + lane;
#pragma unroll
    for (int j = 0; j < 4; ++j) { v2u w; w.x = cvt_pk_bf16(r.v[j].x, r.v[j].y); w.y = cvt_pk_bf16(r.v[j].z, r.v[j].w); q[64 * j] = w; } }
__device__ __forceinline__ float row_rinv(const RowVec& r) { float s = 0.f;
#pragma unroll
    for (int j = 0; j < 4; ++j) s += (r.v[j].x * r.v[j].x + r.v[j].y * r.v[j].y) + (r.v[j].z * r.v[j].z + r.v[j].w * r.v[j].w);
    return rsqrtf(wave_sum(s) * (1.f / D) + 1e-6f); }
__device__ __forceinline__ RowVec norm_mod(const RowVec& x, float rinv, const float* g, const float* shift, const float* scale, int lane) {
    RowVec o; const GAS f32x4* gp = (const GAS f32x4*)g + lane; const GAS f32x4* sh = (const GAS f32x4*)shift + lane; const GAS f32x4* sc = (const GAS f32x4*)scale + lane;
#pragma unroll
    for (int j = 0; j < 4; ++j) o.v[j] = x.v[j] * rinv * gp[64 * j] * (1.f + sc[64 * j]) + sh[64 * j];
    return o; }
__device__ __forceinline__ void moe_combine(RowVec& x, const bf16* ye, const int* rdest, int row, const float* gate, int lane) {
    const int d0 = rdest[row * 2], d1 = rdest[row * 2 + 1];
    const RowVec a = load_row_bf16(ye + (size_t)d0 * D, lane), b = load_row_bf16(ye + (size_t)d1 * D, lane);
    const GAS f32x4* gp = (const GAS f32x4*)gate + lane;
#pragma unroll
    for (int j = 0; j < 4; ++j) x.v[j] = x.v[j] + gp[64 * j] * (a.v[j] + b.v[j]);
}
__device__ __forceinline__ void phase_norm1(Frame& F, const Inputs& I, int l) {
    const int gw = F.vcu * NWAVES + F.wave, NGW = F.G * NWAVES;
    const float* mod = (const float*)(F.ws + SM_MOD);
    float* XC = (float*)(F.ws + WS_XC); bf16* H = (bf16*)(F.ws + WS_H);
    for (int r = gw; r < NALL; r += NGW) {
        const int w = which_of_row(r);
        RowVec x;
        if (l == 0) x = load_row_f32(r < NTOK ? I.x + (size_t)r * D : I.ctx + (size_t)(r - NTOK) * D, F.lane);
        else { x = load_row_f32(XC + (size_t)r * D, F.lane);
               moe_combine(x, (const bf16*)(F.ws + B_YE), (const int*)(F.ws + SM_RDEST), r, mod + (0 * 3 + w) * 6144 + 5 * D, F.lane);
               store_row_f32(XC + (size_t)r * D, F.lane, x); }
        const float rinv = row_rinv(x);
        const float* ml = mod + (l * 3 + w) * 6144;
        const RowVec h = norm_mod(x, rinv, I.g1 + l * D, ml + 0 * D, ml + 1 * D, F.lane);
        store_row_bf16(H + (size_t)r * D, F.lane, h);
    }
}
__device__ __forceinline__ void phase_final(Frame& F, const Inputs& I) {
    const int gw = F.vcu * NWAVES + F.wave, NGW = F.G * NWAVES;
    const float* mod = (const float*)(F.ws + SM_MOD);
    const float* XC = (const float*)(F.ws + WS_XC);
    for (int r = gw; r < NTOK; r += NGW) {
        RowVec x = load_row_f32(XC + (size_t)r * D, F.lane);
        moe_combine(x, (const bf16*)(F.ws + B_YE), (const int*)(F.ws + SM_RDEST), r, mod + (1 * 3 + which_of_row(r)) * 6144 + 5 * D, F.lane);
        const float rinv = row_rinv(x);
        RowVec o; const GAS f32x4* gp = (const GAS f32x4*)I.g_final + F.lane;
#pragma unroll
        for (int j = 0; j < 4; ++j) o.v[j] = x.v[j] * rinv * gp[64 * j];
        store_row_f32(F.out + (size_t)r * D, F.lane, o);
    }
}

__device__ __forceinline__ void phase_norm2_route(Frame& F, const Inputs& I, int l) {
    const int nrows = l == 0 ? NALL : NTOK, nbatch = nrows / 8;
    const int gw = F.vcu * NWAVES + F.wave, NGW = F.G * NWAVES;
    const float* mod = (const float*)(F.ws + SM_MOD);
    const float* XC = (const float*)(F.ws + WS_XC); bf16* H = (bf16*)(F.ws + WS_H);
    const float* wrt = (const float*)(F.ws + SM_WRT) + (size_t)l * 36 * 1024;
    volatile LAS int* lcnt = (volatile LAS int*)(F.lds + L_WGCNT);
    LAS float* lg = (LAS float*)(F.lds + F.wave * 2048);
    int* RE = (int*)(F.ws + SM_RE); float* RW = (float*)(F.ws + SM_RW); int* RSLOT = (int*)(F.ws + SM_RSLOT);
    if (F.tid < 64) lcnt[F.tid] = 0;
    __syncthreads();
    int my_e[2][2], my_ls[2][2], my_row[2];
#pragma unroll
    for (int it = 0; it < 2; ++it) {
        const int batch = gw + it * NGW;
        my_row[it] = -1; my_e[it][0] = my_e[it][1] = 0; my_ls[it][0] = my_ls[it][1] = 0;
        if (batch < nbatch) {
#pragma unroll 1
            for (int half = 0; half < 2; ++half) {
                RowVec h[4];
#pragma unroll
                for (int rr = 0; rr < 4; ++rr) {
                    const int r = batch * 8 + half * 4 + rr, w = which_of_row(r);
                    const RowVec x = load_row_f32(XC + (size_t)r * D, F.lane);
                    const float rinv = row_rinv(x);
                    const float* ml = mod + (l * 3 + w) * 6144;
                    h[rr] = norm_mod(x, rinv, I.g2 + l * D, ml + 3 * D, ml + 4 * D, F.lane);
                    store_row_bf16(H + (size_t)r * D, F.lane, h[rr]);
                }
#pragma unroll 2
                for (int j = 0; j < 36; ++j) {
                    const GAS f32x4* wp = (const GAS f32x4*)(wrt + j * 1024) + F.lane;
                    f32x4 wv[4];
#pragma unroll
                    for (int q = 0; q < 4; ++q) wv[q] = wp[64 * q];
                    float a[4];
#pragma unroll
                    for (int rr = 0; rr < 4; ++rr) { float s = 0.f;
#pragma unroll
                        for (int q = 0; q < 4; ++q) s += (h[rr].v[q].x * wv[q].x + h[rr].v[q].y * wv[q].y) + (h[rr].v[q].z * wv[q].z + h[rr].v[q].w * wv[q].w);
                        a[rr] = s; }
                    const bool b5 = (F.lane & 32) != 0, b4 = (F.lane & 16) != 0;
                    float c2[2], c1;
#pragma unroll
                    for (int i = 0; i < 2; ++i) { const float snd = b5 ? a[i] : a[i + 2]; const float kp = b5 ? a[i + 2] : a[i]; c2[i] = kp + __shfl_xor(snd, 32); }
                    { const float snd = b4 ? c2[0] : c2[1]; const float kp = b4 ? c2[1] : c2[0]; c1 = kp + __shfl_xor(snd, 16); }
                    c1 += __shfl_xor(c1, 8); c1 += __shfl_xor(c1, 4); c1 += __shfl_xor(c1, 2); c1 += __shfl_xor(c1, 1);
                    if ((F.lane & 15) == 0) lg[(half * 4 + (F.lane >> 4)) * 36 + j] = c1;
                }
            }
            LDS_WAIT(); asm volatile("" ::: "memory");
            if (F.lane < 8) {
                const LAS float* q = lg + F.lane * 36;
                int gi = 0; float gm = q[0];
#pragma unroll
                for (int i = 1; i < 4; ++i) if (q[i] > gm) { gm = q[i]; gi = i; }
                float gs = 0.f;
#pragma unroll
                for (int i = 0; i < 4; ++i) gs += expf(q[i] - gm);
                const float gprob = 1.f / gs;
                const LAS float* el = q + 4 + gi * 8;
                int i1 = 0; float v1 = el[0];
#pragma unroll
                for (int i = 1; i < 8; ++i) if (el[i] > v1) { v1 = el[i]; i1 = i; }
                int i2 = 0; float v2 = -INFINITY;
#pragma unroll
                for (int i = 0; i < 8; ++i) if (i != i1 && el[i] > v2) { v2 = el[i]; i2 = i; }
                const float e2 = expf(v2 - v1), p1 = 1.f / (1.f + e2), p2 = e2 / (1.f + e2);
                const int r = batch * 8 + F.lane, e0 = gi * 8 + i1, e1 = gi * 8 + i2;
                RE[r * 2] = e0; RE[r * 2 + 1] = e1; RW[r * 2] = gprob * p1; RW[r * 2 + 1] = gprob * p2;
                my_row[it] = r; my_e[it][0] = e0; my_e[it][1] = e1;
                my_ls[it][0] = __hip_atomic_fetch_add((LAS int*)(F.lds + L_WGCNT) + e0, 1, __ATOMIC_RELAXED, __HIP_MEMORY_SCOPE_WORKGROUP);
                my_ls[it][1] = __hip_atomic_fetch_add((LAS int*)(F.lds + L_WGCNT) + e1, 1, __ATOMIC_RELAXED, __HIP_MEMORY_SCOPE_WORKGROUP);
            }
            LDS_WAIT(); asm volatile("" ::: "memory");
        }
    }
    __syncthreads();
    if (F.tid < 32) { const int c = lcnt[F.tid]; int base = 0; if (c > 0) base = (int)__hip_atomic_fetch_add(F.ctl + CW_CNT + 64 * l + F.tid, (unsigned)c, RLX_AGENT); lcnt[32 + F.tid] = base; }
    __syncthreads();
#pragma unroll
    for (int it = 0; it < 2; ++it) if (my_row[it] >= 0) { RSLOT[my_row[it] * 2] = lcnt[32 + my_e[it][0]] + my_ls[it][0]; RSLOT[my_row[it] * 2 + 1] = lcnt[32 + my_e[it][1]] + my_ls[it][1]; }
    __syncthreads();
}

__device__ __forceinline__ void moe_tables(Frame& F, int l) {
    volatile LAS int* tp = (volatile LAS int*)(F.lds + L_MOETAB);
    __syncthreads();
    if (F.tid == 0) { int acc = 0;
        for (int e = 0; e < NE; ++e) { tp[e] = acc; const int c = (int)__hip_atomic_load(F.ctl + CW_CNT + 64 * l + e, RLX_AGENT); acc += (c + 255) >> 8; }
        tp[NE] = acc; }
    __syncthreads();
}
__device__ __forceinline__ void phase_gather(Frame& F, int l) {
    moe_tables(F, l);
    const volatile LAS int* tp = (const volatile LAS int*)(F.lds + L_MOETAB);
    const int nrows = l == 0 ? NALL : NTOK;
    const int gw = F.vcu * NWAVES + F.wave, NGW = F.G * NWAVES;
    const bf16* H = (const bf16*)(F.ws + WS_H); bf16* HS = (bf16*)(F.ws + B_HS);
    const int* RE = (const int*)(F.ws + SM_RE); const float* RW = (const float*)(F.ws + SM_RW); const int* RSLOT = (const int*)(F.ws + SM_RSLOT);
    int* RDEST = (int*)(F.ws + SM_RDEST); float* RWS = (float*)(F.ws + SM_RWS);
    for (int r = gw; r < nrows; r += NGW) {
        const GAS v4u* src = (const GAS v4u*)(H + (size_t)r * D) + F.lane;
        const v4u a = src[0], b = src[64];
#pragma unroll
        for (int k = 0; k < 2; ++k) {
            const int e = RE[r * 2 + k], dest = 256 * tp[e] + RSLOT[r * 2 + k];
            GAS v4u* dst = (GAS v4u*)(HS + (size_t)dest * D) + F.lane;
            dst[0] = a; dst[64] = b;
            if (F.lane == 0) { RDEST[r * 2 + k] = dest; RWS[dest] = RW[r * 2 + k]; }
        }
    }
}
__device__ __forceinline__ int carry_cidx(int dir, int b, int v) { return dir == 0 ? (v < 8 ? 512 + b * 8 + v : b * 256 + (v - 8)) : (v < 8 ? 512 + b * 8 + (7 - v) : b * 256 + 255 - (v - 8)); }
__device__ __forceinline__ void phase_ssm_carry(Frame& F, int l) {
    if (F.vcu >= 128) return;
    const int g = F.vcu >> 2, b = (F.vcu >> 1) & 1, dir = F.vcu & 1, seg = F.tid >> 6, p = F.tid & 63;
    const float* tab = (const float*)(F.ws + SM_SSMTAB);
    const size_t ti = ((((size_t)l * NG + g) * 2 + dir) * 64 + p) * 2;
    const float a32r = tab[ti], a32i = tab[ti + 1], asr = tab[16384 + ti], asi = tab[16384 + ti + 1];
    const float* send = (const float*)(F.ws + B_SEND) + (size_t)g * NCH * 256 + dir * 128 + p;
    bf16* A3 = (bf16*)(F.ws + B_A3) + (size_t)g * NCH * 768 + 512 + dir * 128 + p;
    LAS float* segend = (LAS float*)(F.lds);
    float xr = 0.f, xi = 0.f;
#pragma unroll 1
    for (int k0 = 0; k0 < 33; k0 += 11) {
        float sr[11], si[11];
#pragma unroll
        for (int k = 0; k < 11; ++k) { const unsigned c = (unsigned)carry_cidx(dir, b, seg * 33 + k0 + k); sr[k] = send[c * 256u]; si[k] = send[c * 256u + 64u]; }
#pragma unroll
        for (int k = 0; k < 11; ++k) { const float nr = a32r * xr - a32i * xi + sr[k], ni = a32r * xi + a32i * xr + si[k]; xr = nr; xi = ni; }
    }
    __syncthreads();
    segend[(seg * 64 + p) * 2] = xr; segend[(seg * 64 + p) * 2 + 1] = xi;
    __syncthreads();
    float cr = 0.f, ci = 0.f;
    for (int k = 0; k < seg; ++k) { const float er = segend[(k * 64 + p) * 2], ei = segend[(k * 64 + p) * 2 + 1]; const float nr = asr * cr - asi * ci + er, ni = asr * ci + asi * cr + ei; cr = nr; ci = ni; }
    xr = cr; xi = ci;
#pragma unroll 1
    for (int k0 = 0; k0 < 33; k0 += 11) {
        float sr[11], si[11];
#pragma unroll
        for (int k = 0; k < 11; ++k) { const unsigned c = (unsigned)carry_cidx(dir, b, seg * 33 + k0 + k); sr[k] = send[c * 256u]; si[k] = send[c * 256u + 64u]; }
#pragma unroll
        for (int k = 0; k < 11; ++k) { const unsigned c = (unsigned)carry_cidx(dir, b, seg * 33 + k0 + k);
            A3[c * 768u] = (bf16)f2bf_rne(xr); A3[c * 768u + 64u] = (bf16)f2bf_rne(xi);
            const float nr = a32r * xr - a32i * xi + sr[k], ni = a32r * xi + a32i * xr + si[k]; xr = nr; xi = ni; }
    }
    __syncthreads();
}
struct AttnTask { const bf16* q; const bf16* kl; const bf16* vl; int nloc_first, nloc_tiles, mask_lo_tile, mask_hi_tile; const bf16* kc; const bf16* vc; float sink; bf16* o; };
__device__ __forceinline__ void attn_tile(f32x16 (&o)[2], float& m_run, float& l_run, const bf16x8 (&qf)[4], const bf16* kp  , const bf16* vp  , int vpitch,
                                          int mask_mode  , int lane) {
    const int r32 = lane & 31, hi = lane >> 5;
    f32x16 s = {};
#pragma unroll
    for (int d0 = 0; d0 < 4; ++d0) {
        const bf16x8 kf = *(const GAS bf16x8*)(kp + (size_t)r32 * 128 + d0 * 16 + hi * 8);
        s = __builtin_amdgcn_mfma_f32_32x32x16_bf16(kf, qf[d0], s, 0, 0, 0);
    }
    bf16x4 vlo[2][2], vhi[2][2];
#pragma unroll
    for (int db = 0; db < 2; ++db)
#pragma unroll
        for (int ks = 0; ks < 2; ++ks) {
            const bf16* vr = vp + (size_t)(32 * db + r32) * vpitch + 16 * ks + 4 * hi;
            vlo[db][ks] = *(const GAS bf16x4*)(vr); vhi[db][ks] = *(const GAS bf16x4*)(vr + 8);
        }
    if (mask_mode != 0) {
#pragma unroll
        for (int r = 0; r < 16; ++r) { const int kidx = (r & 3) + 8 * (r >> 2) + 4 * hi; const bool valid = mask_mode == 1 ? (kidx >= r32) : (kidx <= r32); if (!valid) s[r] = -INFINITY; }
    }
    float tm = s[0];
#pragma unroll
    for (int r = 1; r < 16; ++r) tm = fmaxf(tm, s[r]);
    tm = fmaxf(tm, __shfl_xor(tm, 32));
    const float m_new = fmaxf(m_run, tm);
    const float alpha = __builtin_amdgcn_exp2f(m_run - m_new);
    m_run = m_new;
    float ps = 0.f;
#pragma unroll
    for (int r = 0; r < 16; ++r) { s[r] = __builtin_amdgcn_exp2f(s[r] - m_new); ps += s[r]; }
    l_run = l_run * alpha + ps;
#pragma unroll
    for (int db = 0; db < 2; ++db)
#pragma unroll
        for (int r = 0; r < 16; ++r) o[db][r] *= alpha;
    bf16x8 pf[2];
#pragma unroll
    for (int ks = 0; ks < 2; ++ks) {
        v4u w; w.x = cvt_pk_bf16(s[8 * ks + 0], s[8 * ks + 1]); w.y = cvt_pk_bf16(s[8 * ks + 2], s[8 * ks + 3]); w.z = cvt_pk_bf16(s[8 * ks + 4], s[8 * ks + 5]); w.w = cvt_pk_bf16(s[8 * ks + 6], s[8 * ks + 7]);
        pf[ks] = __builtin_bit_cast(bf16x8, w);
    }
#pragma unroll
    for (int db = 0; db < 2; ++db)
#pragma unroll
        for (int ks = 0; ks < 2; ++ks) {
            const bf16x8 vf = (bf16x8){vlo[db][ks][0], vlo[db][ks][1], vlo[db][ks][2], vlo[db][ks][3], vhi[db][ks][0], vhi[db][ks][1], vhi[db][ks][2], vhi[db][ks][3]};
            o[db] = __builtin_amdgcn_mfma_f32_32x32x16_bf16(vf, pf[ks], o[db], 0, 0, 0);
        }
}
__device__ __forceinline__ void attn_wave(Frame& F, int qrow0, int h, int b, int p0  , float sink_logit) {
    const int lane = F.lane, r32 = lane & 31, hi = lane >> 5, kvh = h >> 2;
    const bf16* Q = (const bf16*)(F.ws + B_Q); const bf16* KB = (const bf16*)(F.ws + B_K); const bf16* VT = (const bf16*)(F.ws + B_VT);
    bf16x8 qf[4];
#pragma unroll
    for (int d0 = 0; d0 < 4; ++d0) qf[d0] = *(const GAS bf16x8*)(Q + (size_t)(qrow0 + r32) * 512 + h * 64 + d0 * 16 + hi * 8);
    f32x16 o[2]; o[0] = f32x16{}; o[1] = f32x16{};
    float m_run = sink_logit * LOG2E, l_run = hi == 0 ? 1.f : 0.f;
    if (p0 >= 0) {
        const bf16* kb = KB + (size_t)(b * S) * 128 + kvh * 64;
        const bf16* vb = VT + (size_t)((b * 2 + kvh) * 64) * S;
        for (int i = 0; i < 9; ++i) {
            const int kt = p0 - 128 + 32 * i;
            if (kt < 0 || kt >= S) continue;
            attn_tile(o, m_run, l_run, qf, kb + (size_t)kt * 128, vb + kt, S, i == 0 ? 1 : (i == 8 ? 2 : 0), lane);
        }
    }
    {
        const bf16* kb = KB + (size_t)(NTOK + b * CTX) * 128 + kvh * 64;
        const bf16* vb = VT + (size_t)NTOK * 128 + (size_t)((b * 2 + kvh) * 64) * CTX;
        for (int i = 0; i < 8; ++i) attn_tile(o, m_run, l_run, qf, kb + (size_t)(32 * i) * 128, vb + 32 * i, CTX, 0, lane);
    }
    const float l_tot = l_run + __shfl_xor(l_run, 32);
    const float inv = 1.f / l_tot;
    bf16* O = (bf16*)(F.ws + B_ATT) + (size_t)(qrow0 + r32) * 512 + h * 64;
#pragma unroll
    for (int db = 0; db < 2; ++db)
#pragma unroll
        for (int g4 = 0; g4 < 4; ++g4) {
            v2u w; w.x = cvt_pk_bf16(o[db][4 * g4 + 0] * inv, o[db][4 * g4 + 1] * inv); w.y = cvt_pk_bf16(o[db][4 * g4 + 2] * inv, o[db][4 * g4 + 3] * inv);
            *(GAS v2u*)(O + 32 * db + 8 * g4 + 4 * hi) = w;
        }
}
__device__ __forceinline__ void phase_attn_latent(Frame& F, const Inputs& I, int l) {
    for (int v = F.vcu; v < 256; v += F.G) {
        const int bk = v >> 6, b = bk >> 1, kvh = bk & 1, q128 = v & 63, h = kvh * 4 + (F.wave & 3);
        const float sk = I.sink[l * NH + h];
#pragma unroll 1
        for (int t = 0; t < 2; ++t) {
            const int p0 = q128 * 128 + ((F.wave >> 2) * 2 + t) * 32;
            attn_wave(F, b * S + p0, h, b, p0, sk);
        }
    }
}
__device__ __forceinline__ void phase_attn_ctx(Frame& F, const Inputs& I, int l, int first_wg) {
    const int wv = (F.vcu - first_wg) * NWAVES + F.wave;
    if (F.vcu < first_wg || wv >= 128) return;
    const int b = wv >> 6, h = (wv >> 3) & 7, qt = wv & 7;
    attn_wave(F, NTOK + b * CTX + qt * 32, h, b, -1, I.sink[l * NH + h]);
}
using pg8::Unit;
__device__ __forceinline__ v4u pack8(const f32x4& a, const f32x4& b) { v4u w; w.x = cvt_pk_bf16(a.x, a.y); w.y = cvt_pk_bf16(a.z, a.w); w.z = cvt_pk_bf16(b.x, b.y); w.w = cvt_pk_bf16(b.z, b.w); return w; }
__device__ __forceinline__ void unpack8(const v4u w, f32x4& a, f32x4& b) { a = (f32x4){bf_lo(w.x), bf_hi(w.x), bf_lo(w.y), bf_hi(w.y)}; b = (f32x4){bf_lo(w.z), bf_hi(w.z), bf_lo(w.w), bf_hi(w.w)}; }
__device__ __forceinline__ f32x4 sig4(const f32x4& v) { return (f32x4){sigmoid_f(v.x), sigmoid_f(v.y), sigmoid_f(v.z), sigmoid_f(v.w)}; }
__device__ __forceinline__ f32x4 gelu4(const f32x4& v) { return (f32x4){gelu_tanh_f(v.x), gelu_tanh_f(v.y), gelu_tanh_f(v.z), gelu_tanh_f(v.w)}; }

enum GemmKind { GK_INPROJ = 0, GK_S1, GK_S3, GK_GLU, GK_BR, GK_OUT, GK_MU, GK_MD };
struct GemmDesc { int kind, layer, G, c, vc, nM; unsigned char* ws; const float* xlat; const float* xctx; };

template <int KIND> struct EpiAll {
    static constexpr bool PERM = true;
    GemmDesc d;
    typedef const f32x4 (&Acc)[2][2][4][2];
    __device__ __forceinline__ void inproj(Acc acc, const Unit& u, int wr, int wc, int fr, int fq) const {
        unsigned char* ws = d.ws;
        const int pn = u.pn, pm = u.pm, r0 = pm * 256 + wr * 64 + fr;
        const bool latent = pm < 64;
        if (pn <= 2) {
            const float* rope = (const float*)(ws + SM_ROPE);
            bf16* Q = (bf16*)(ws + B_Q); bf16* KB = (bf16*)(ws + B_K); bf16* VT = (bf16*)(ws + B_VT);
            const int jb = 8 * (fq & 1); const float sgn = fq < 2 ? -1.f : 1.f;
#pragma unroll
            for (int ai = 0; ai < 2; ++ai)
#pragma unroll
                for (int m = 0; m < 4; ++m) {
                    const int r = r0 + ai * 128 + m * 16;
                    f32x4 c0 = {1.f, 1.f, 1.f, 1.f}, c1 = c0, s0 = {0.f, 0.f, 0.f, 0.f}, s1 = s0;
                    if (latent) { const int s = r & 8191, pos = (wc & 1) ? (s & 63) : (s >> 6); const float* rp = rope + pos * 16 + jb;
                        c0 = *(const GAS f32x4*)rp; c1 = *(const GAS f32x4*)(rp + 4); s0 = *(const GAS f32x4*)(rp + 2048); s1 = *(const GAS f32x4*)(rp + 2052); }
#pragma unroll
                    for (int bj = 0; bj < 2; ++bj) {
                        f32x4 v0 = acc[ai][bj][m][0], v1 = acc[ai][bj][m][1];
                        if (pn == 2 && bj == 1) {
                            const int dd = 32 * (wc & 1) + 8 * fq, kvh = wc >> 1; bf16* vt; size_t pitch;
                            if (latent) { const int b = r >> 13, key = r & 8191; vt = VT + (size_t)((b * 2 + kvh) * 64 + dd) * S + key; pitch = S; }
                            else { const int rc = r - NTOK, b = rc >> 8, key = rc & 255; vt = VT + (size_t)NTOK * 128 + (size_t)((b * 2 + kvh) * 64 + dd) * CTX + key; pitch = CTX; }
                            vt[0] = (bf16)f2bf_rne(v0.x); vt[pitch] = (bf16)f2bf_rne(v0.y); vt[2 * pitch] = (bf16)f2bf_rne(v0.z); vt[3 * pitch] = (bf16)f2bf_rne(v0.w);
                            vt[4 * pitch] = (bf16)f2bf_rne(v1.x); vt[5 * pitch] = (bf16)f2bf_rne(v1.y); vt[6 * pitch] = (bf16)f2bf_rne(v1.z); vt[7 * pitch] = (bf16)f2bf_rne(v1.w);
                            continue;
                        }
                        if (latent) {
                            f32x4 p0, p1;
                            p0.x = __shfl_xor(v0.x, 32); p0.y = __shfl_xor(v0.y, 32); p0.z = __shfl_xor(v0.z, 32); p0.w = __shfl_xor(v0.w, 32);
                            p1.x = __shfl_xor(v1.x, 32); p1.y = __shfl_xor(v1.y, 32); p1.z = __shfl_xor(v1.z, 32); p1.w = __shfl_xor(v1.w, 32);
                            v0 = v0 * c0 + (p0 * s0) * sgn; v1 = v1 * c1 + (p1 * s1) * sgn;
                        }
                        if (pn < 2) { v0 = v0 * C2; v1 = v1 * C2; *(GAS v4u*)(Q + (size_t)r * 512 + pn * 256 + bj * 128 + wc * 32 + 8 * fq) = pack8(v0, v1); }
                        else *(GAS v4u*)(KB + (size_t)r * 128 + wc * 32 + 8 * fq) = pack8(v0, v1);
                    }
                }
        } else if (pn <= 4) {
            bf16* A3 = (bf16*)(ws + B_A3);
#pragma unroll
            for (int ai = 0; ai < 2; ++ai)
#pragma unroll
                for (int m = 0; m < 4; ++m) {
                    const int r = r0 + ai * 128 + m * 16, cidx = r >> 5, s = r & 31;
#pragma unroll
                    for (int bj = 0; bj < 2; ++bj) { const int c = 256 * (pn - 3) + 128 * bj + 32 * wc + 8 * fq, g = c >> 4, mp0 = c & 15;
                        *(GAS v4u*)(A3 + ((size_t)(g * NCH + cidx) * 768 + s * 16 + mp0)) = pack8(acc[ai][bj][m][0], acc[ai][bj][m][1]); }
                }
        } else {
            bf16* Gt = (bf16*)(ws + (pn <= 8 ? B_GA : B_GS)); const int cb = 256 * (pn <= 8 ? pn - 5 : pn - 9);
#pragma unroll
            for (int ai = 0; ai < 2; ++ai)
#pragma unroll
                for (int m = 0; m < 4; ++m) {
                    const int r = r0 + ai * 128 + m * 16;
#pragma unroll
                    for (int bj = 0; bj < 2; ++bj) *(GAS v4u*)(Gt + (size_t)r * D + cb + 128 * bj + 32 * wc + 8 * fq) = pack8(sig4(acc[ai][bj][m][0]), sig4(acc[ai][bj][m][1]));
                }
        }
    }
    __device__ __forceinline__ void operator()(Acc acc, const Unit& u, int wr, int wc, int fr, int fq) const {
        unsigned char* ws = d.ws;
        if constexpr (KIND == GK_INPROJ) { inproj(acc, u, wr, wc, fr, fq); return; }
        const int r0 = u.pm * 256 + wr * 64 + fr, c0 = u.pn * 256 + wc * 32 + 8 * fq;
#pragma unroll
        for (int ai = 0; ai < 2; ++ai)
#pragma unroll
            for (int m = 0; m < 4; ++m) {
                const int r = r0 + ai * 128 + m * 16;
#pragma unroll
                for (int bj = 0; bj < 2; ++bj) {
                    const int c = c0 + bj * 128;
                    const f32x4 v0 = acc[ai][bj][m][0], v1 = acc[ai][bj][m][1];
                    switch (KIND) {
                    case GK_S1: {
                        float* p = (float*)(ws + B_SEND) + (size_t)(u.aux * NCH + r) * 256 + c; *(GAS f32x4*)p = v0; *(GAS f32x4*)(p + 4) = v1; } break;
                    case GK_S3: {
                        const int t = c >> 4, m0 = c & 15; *(GAS v4u*)((bf16*)(ws + B_Z) + (size_t)(r * 32 + t) * 512 + u.aux * 16 + m0) = pack8(gelu4(v0), gelu4(v1)); } break;
                    case GK_GLU: {
                        const size_t o = (size_t)r * 512 + c; f32x4 z0, z1; unpack8(*(const GAS v4u*)((const bf16*)(ws + B_Z) + o), z0, z1);
                        *(GAS v4u*)((bf16*)(ws + B_SG) + o) = pack8(z0 * sig4(v0), z1 * sig4(v1)); } break;
                    case GK_BR: {
                        const size_t o = (size_t)r * D + c;
                        if (u.aux == 0) { f32x4 g0, g1; unpack8(*(const GAS v4u*)((const bf16*)(ws + B_GA) + o), g0, g1); *(GAS v4u*)((bf16*)(ws + B_T1) + o) = pack8(g0 * v0, g1 * v1); }
                        else { f32x4 g0, g1, t0, t1; unpack8(*(const GAS v4u*)((const bf16*)(ws + B_GS) + o), g0, g1); unpack8(*(const GAS v4u*)((const bf16*)(ws + B_T1) + o), t0, t1);
                            *(GAS v4u*)((bf16*)(ws + B_MB) + o) = pack8(t0 + g0 * v0, t1 + g1 * v1); } } break;
                    case GK_OUT: {
                        const int w = u.pm < 64 ? (u.pm >> 5) : 2;
                        const float* gate = (const float*)(ws + SM_MOD) + (d.layer * 3 + w) * 6144 + 2 * D + c;
                        const float* xin = (r < NTOK ? d.xlat + (size_t)r * D : d.xctx + (size_t)(r - NTOK) * D) + c; float* xo = (float*)(ws + WS_XC) + (size_t)r * D + c;
                        *(GAS f32x4*)xo = *(const GAS f32x4*)xin + *(const GAS f32x4*)gate * v0; *(GAS f32x4*)(xo + 4) = *(const GAS f32x4*)(xin + 4) + *(const GAS f32x4*)(gate + 4) * v1; } break;
                    case GK_MU: {
                        const f32x4 a = v0 * sig4(v0) * v1; v2u w; w.x = cvt_pk_bf16(a.x, a.y); w.y = cvt_pk_bf16(a.z, a.w);
                        *(GAS v2u*)((bf16*)(ws + B_ACT) + (size_t)r * DE + (c >> 1)) = w; } break;
                    default: {
                        const float w = ((const float*)(ws + SM_RWS))[r]; *(GAS v4u*)((bf16*)(ws + B_YE) + (size_t)r * D + c) = pack8(v0 * w, v1 * w); } break;
                    }
                }
            }
    }
};
template <int KIND> struct SchedAll {
    GemmDesc d; const volatile LAS int* tp;
    __device__ __forceinline__ bool next(int i, Unit& u) const {
        unsigned char* ws = d.ws; int pm, pn, aux = 0; size_t ao, bo;
        switch (KIND) {
        case GK_INPROJ: { const int L = i * d.G + d.c;
            if (L < 64 * 13) pg8::tile_of(L, 64, 13, pm, pn);
            else { const int k = L - 64 * 13; if (d.layer == 0) { if (k >= 26) return false; pm = 64 + k / 13; pn = k % 13; } else { if (k >= 6) return false; pm = 64 + k / 3; pn = 2 + k % 3; } }
            ao = WS_H + (size_t)pm * 256 * D * 2; bo = W_IN + (size_t)pn * 256 * D * 2; } break;
        case GK_S1: { const int L = i * d.G + d.vc; if (L >= NG * 3) return false; aux = L / 3; pm = L % 3; pn = 0;
            ao = B_A3 + (size_t)(aux * NCH + pm * 256) * 768 * 2; bo = W_SE + (size_t)(aux * 256) * 512 * 2; } break;
        case GK_S3: { const int L = i * d.G + d.vc; if (L >= NG * 6) return false; aux = L / 6; const int rem = L % 6; pm = rem >> 1; pn = rem & 1;
            ao = B_A3 + (size_t)(aux * NCH + pm * 256) * 768 * 2; bo = W_S3 + (size_t)(aux * 512 + pn * 256) * 768 * 2; } break;
        case GK_GLU: { const int L = i * d.G + d.c; if (L >= d.nM * 2) return false; pg8::tile_of(L, d.nM, 2, pm, pn);
            ao = B_Z + (size_t)pm * 256 * 512 * 2; bo = W_GLU + (size_t)pn * 256 * 512 * 2; } break;
        case GK_BR: { const int Lp = (i >> 1) * d.G + d.c; aux = i & 1; if (Lp >= d.nM * 4) return false; pg8::tile_of(Lp, d.nM, 4, pm, pn);
            ao = (aux ? B_SG : B_ATT) + (size_t)pm * 256 * 512 * 2; bo = (aux ? W_BRS : W_BRA) + (size_t)pn * 256 * 512 * 2; } break;
        case GK_OUT: { const int L = i * d.G + d.c; if (L >= d.nM * 4) return false; pg8::tile_of(L, d.nM, 4, pm, pn);
            ao = B_MB + (size_t)pm * 256 * D * 2; bo = W_OUT + (size_t)pn * 256 * D * 2; } break;
        default: {
            const int L = i * d.G + d.vc, TT = tp[NE]; if (L >= TT * 4) return false; pm = L >> 2; pn = L & 3;
            int e = 0;
#pragma unroll 1
            for (int k = 1; k < NE; ++k) if (tp[k] <= pm) e = k;
            aux = e;
            if (KIND == GK_MU) { ao = B_HS + (size_t)pm * 256 * D * 2; bo = W_GU + (size_t)e * 1024 * 1024 * 2 + (size_t)pn * 256 * D * 2; }
            else { ao = B_ACT + (size_t)pm * 256 * DE * 2; bo = W_DN + (size_t)e * 1024 * 512 * 2 + (size_t)pn * 256 * DE * 2; } } break;
        }
        u.pm = pm; u.pn = pn; u.aux = aux; u.A = (const char*)ws + ao; u.B = (const char*)ws + bo; return true;
    }
};

#ifndef GEMM_ALIGN
#define GEMM_ALIGN true
#endif
#ifndef GEMM_SP2
#define GEMM_SP2 true
#endif
#ifndef PHMASK
#define PHMASK 0xFFFFFFFFu
#endif
#define PHON(b) (((PHMASK) >> (b)) & 1u)
struct Args { Inputs in; float* out; unsigned char* ws; int ph_lo, ph_hi; };
enum { T_P0 = 0, T_N1, T_G1, T_AT, T_S2, T_S3, T_GLU, T_BR, T_OUT, T_N2, T_MG, T_MU, T_MD, T_FINAL };
constexpr int PH_PER_LAYER = 12, PH_FINAL = 1 + 2 * PH_PER_LAYER, N_PHASES = PH_FINAL + 1;
__global__ void __launch_bounds__(NWAVES * 64, 2) mega_fwd(Args args) {
    extern __shared__ __attribute__((aligned(16))) unsigned char lds[];
    Frame F;
    F.lds = (LAS unsigned char*)lds;
    F.tid = threadIdx.x; F.lane = F.tid & 63; F.wave = __builtin_amdgcn_readfirstlane(F.tid >> 6);
    F.G = gridDim.x; { const int bx = blockIdx.x; F.vcu = (F.G % 8 == 0) ? (bx % 8) * (F.G / 8) + bx / 8 : bx; }
    F.ws = args.ws; F.ctl = (gu32*)(args.ws + WS_CTL); F.out = args.out;
    const Inputs& I = args.in;
    for (int u = F.tid; u < (LDS_BYTES - LDSCTL_OFF) / 4; u += NWAVES * 64) ((LAS unsigned*)(F.lds + LDSCTL_OFF))[u] = 0u;
    __syncthreads();
    const int lo = args.ph_lo, hi = args.ph_hi;
    XcdBarrier bar; bar.bar = (unsigned*)(F.ctl + CW_BAR); bar.x = 0; bar.st = nullptr;
    if (hi - lo > 1) bar = xcd_barrier_post((unsigned*)(F.ctl + CW_BAR), (volatile LAS unsigned*)(F.lds + L_BARST));
#pragma unroll 1
    for (int ph = lo; ph < hi; ++ph) {
        int t, l;
        { unsigned char* w_ = F.ws; gu32* c_ = F.ctl; float* o_ = F.out; LAS unsigned char* l_ = F.lds; int v_ = F.vcu, g_ = F.G;
          asm volatile("" : "+s"(w_), "+s"(c_), "+s"(o_), "+s"(l_), "+s"(v_), "+s"(g_)); F.ws = w_; F.ctl = c_; F.out = o_; F.lds = l_; F.vcu = v_; F.G = g_;
          int t_ = threadIdx.x; asm volatile("" : "+v"(t_)); F.tid = t_; F.lane = t_ & 63; F.wave = __builtin_amdgcn_readfirstlane(t_ >> 6); }
        if (ph == 0) { t = T_P0; l = 0; } else if (ph == PH_FINAL) { t = T_FINAL; l = 1; } else { l = (ph - 1) / PH_PER_LAYER; t = (ph - 1) % PH_PER_LAYER + 1; }
        if (t == T_P0 || (t == T_N1 && l == 1)) {
            if (PHON(0) && F.vcu < NG) ssmgen_job(F, I, l, F.vcu);
            if (t == T_P0) { if (PHON(1) && F.vcu >= NG && F.vcu < NG + 192) mod_item(F, I, F.vcu - NG); if (PHON(2)) p0_small(F, I); }
            if (PHON(3)) convert_weights(F, I, l);
        }
        if (t == T_N1) { if (PHON(4)) phase_norm1(F, I, l); }
        else if (t >= T_G1 && t <= T_MD && t != T_S2 && t != T_N2 && t != T_MG) {
            GemmDesc d; d.layer = l; d.G = F.G; d.c = (int)blockIdx.x; d.vc = F.vcu; d.nM = l == 0 ? 66 : 64; d.ws = F.ws;
            d.xlat = l == 0 ? I.x : (const float*)(F.ws + WS_XC); d.xctx = l == 0 ? I.ctx : (const float*)(F.ws + WS_XC) + (size_t)NTOK * D;
            if (t == T_MU || t == T_MD) moe_tables(F, l);
            const volatile LAS int* tp = (const volatile LAS int*)(F.lds + L_MOETAB);
#define RUN_GEMM(KIND_, K_, LDA_, LDB_) do { d.kind = KIND_; SchedAll<KIND_> Sc{d, tp}; EpiAll<KIND_> E{d}; pg8::gemm_phase<EpiAll<KIND_>, SchedAll<KIND_>, GEMM_ALIGN, GEMM_SP2>(F.lds, K_, LDA_, LDB_, Sc, E); } while (0)
            switch (t) {
            case T_G1: if (PHON(5)) RUN_GEMM(GK_INPROJ, D, D, D); break;
            case T_AT: if (PHON(6)) RUN_GEMM(GK_S1, 512, 768, 512); break;
            case T_S3: if (PHON(10)) RUN_GEMM(GK_S3, 768, 768, 768); break;
            case T_GLU: if (PHON(11)) RUN_GEMM(GK_GLU, 512, 512, 512); break;
            case T_BR: if (PHON(12)) RUN_GEMM(GK_BR, 512, 512, 512); break;
            case T_OUT: if (PHON(13)) RUN_GEMM(GK_OUT, D, D, D); break;
            case T_MU: if (PHON(16)) RUN_GEMM(GK_MU, D, D, D); break;
            default: if (PHON(17)) RUN_GEMM(GK_MD, DE, DE, DE); break;
            }
#undef RUN_GEMM
            if (t == T_AT && PHON(7)) phase_attn_latent(F, I, l);
        }
        else if (t == T_S2) { if (PHON(8)) phase_ssm_carry(F, l); if (PHON(9) && l == 0) phase_attn_ctx(F, I, l, 128); }
        else if (t == T_N2) { if (PHON(14)) phase_norm2_route(F, I, l); }
        else if (t == T_MG) { if (PHON(15)) phase_gather(F, l); }
        else if (t == T_FINAL) { if (PHON(18)) phase_final(F, I); }
        if (ph + 1 < hi) { bar.bar = (unsigned*)(F.ctl + CW_BAR); xcd_barrier(bar); }
    }
}

#ifdef DBG_STOP
__global__ void dbg_copy(const unsigned char* ws, float* out, size_t n) {
    for (size_t i = (size_t)blockIdx.x * blockDim.x + threadIdx.x; i < n; i += (size_t)gridDim.x * blockDim.x) {
        const size_t j = i % (size_t)(DBG_ELEMS);
#ifdef DBG_F32
        out[i] = ((const float*)(ws + (DBG_OFF)))[j];
#else
        out[i] = __uint_as_float((unsigned)((const unsigned short*)(ws + (DBG_OFF)))[j] << 16);
#endif
    }
}
#endif
extern "C" void kernel_launch(void* const* d_in, const int* in_sizes, int n_in, void* d_out, int out_size, void* d_ws, size_t ws_size, hipStream_t stream) {
    static int grid = 0;
    if (grid == 0) {
        int dev = 0, cus = 0, per_cu = 0;
        if (n_in != 28 || out_size != NTOK * D || ws_size < WS_END) { grid = -1; return; }
        if (hipGetDevice(&dev) != hipSuccess || hipDeviceGetAttribute(&cus, hipDeviceAttributeMultiprocessorCount, dev) != hipSuccess) { grid = -1; return; }
        if (hipFuncSetAttribute((const void*)mega_fwd, hipFuncAttributeMaxDynamicSharedMemorySize, LDS_BYTES) != hipSuccess) { grid = -1; return; }
        if (hipOccupancyMaxActiveBlocksPerMultiprocessor(&per_cu, (const void*)mega_fwd, NWAVES * 64, LDS_BYTES) != hipSuccess || per_cu < 1) { (void)hipGetLastError(); grid = -1; return; }
        (void)hipGetLastError();
        grid = cus;
    }
    if (grid < 0) return;
    (void)hipMemsetAsync((char*)d_ws + WS_CTL, 0, CTL_ZERO_BYTES, stream);
    Args a{};
    const float** ip = (const float**)&a.in;
    for (int i = 0; i < 28; ++i) ip[i] = (const float*)d_in[i];
    a.out = (float*)d_out; a.ws = (unsigned char*)d_ws;
#ifdef DBG_STOP
    for (int p = 0; p <= (DBG_STOP); ++p) { a.ph_lo = p; a.ph_hi = p + 1; hipLaunchKernelGGL(mega_fwd, dim3(grid), dim3(NWAVES * 64), LDS_BYTES, stream, a); }
    hipLaunchKernelGGL(dbg_copy, dim3(2048), dim3(256), 0, stream, (const unsigned char*)d_ws, (float*)d_out, (size_t)out_size);
#elif MK_PER_PHASE
    for (int p = 0; p < N_PHASES; ++p) { a.ph_lo = p; a.ph_hi = p + 1; hipLaunchKernelGGL(mega_fwd, dim3(grid), dim3(NWAVES * 64), LDS_BYTES, stream, a); }
#else
    a.ph_lo = 0; a.ph_hi = N_PHASES;
    hipLaunchKernelGGL(mega_fwd, dim3(grid), dim3(NWAVES * 64), LDS_BYTES, stream, a);
#endif
}
```

```cpp
#include <hip/hip_runtime.h>
#include <cstdint>
#include <cmath>
#ifndef MK_PER_PHASE
#define MK_PER_PHASE 0
#endif
namespace pg8 {
#define PG8_LAS __attribute__((address_space(3)))
typedef unsigned short bf16_t;
typedef short bf16x8 __attribute__((ext_vector_type(8)));
typedef float f32x4 __attribute__((ext_vector_type(4)));
typedef float f32x2 __attribute__((ext_vector_type(2)));
typedef unsigned u32x4 __attribute__((ext_vector_type(4)));
typedef unsigned u32x2 __attribute__((ext_vector_type(2)));
constexpr int BM = 256, BK = 64, HALF = 128, HTB = HALF * BK * 2, STAGE_BYTES = 8 * HTB, NXCD = 8, WGM = 8;

__host__ __device__ __forceinline__ int lds_byte(int r, int c) { const int st = (r >> 4) * 2 + (c >> 5), rr = r & 15, cc = c & 31, ob = rr * 64 + cc * 2; return st * 1024 + (ob ^ (((ob >> 9) & 1) << 5)); }
__host__ __device__ __forceinline__ void stage_rc(int b, int& R, int& C) { const int st = b / 1024, sb = b % 1024, swz = sb ^ (((sb >> 9) & 1) << 5); R = (st >> 1) * 16 + swz / 64; C = (st & 1) * 32 + (swz % 64) / 2; }
__host__ __device__ __forceinline__ int perm32(int rho) { const int n = rho >> 4, i = rho & 15; return 8 * (i >> 2) + 4 * n + (i & 3); }

struct Unit { const char* A; const char* B; int pm, pn, aux, k2; };
typedef __bf16 bf16x2_t __attribute__((ext_vector_type(2)));
__device__ __forceinline__ unsigned cvt_pk_bf16(float lo, float hi) { f32x2 v = {lo, hi}; bf16x2_t b = __builtin_convertvector(v, bf16x2_t); return __builtin_bit_cast(unsigned, b); }
__device__ __forceinline__ float bf_lo(unsigned w) { return __uint_as_float(w << 16); }
__device__ __forceinline__ float bf_hi(unsigned w) { return __uint_as_float(w & 0xffff0000u); }

__device__ __forceinline__ void tile_of(int L, int nM, int nN, int& pm, int& pn) {
    const int nwg = nM * nN; int wgid = L;
    { const int q = nwg / NXCD, r = nwg % NXCD, xcd = wgid % NXCD, off = wgid / NXCD; wgid = (xcd < r ? xcd * (q + 1) : r * (q + 1) + (xcd - r) * q) + off; }
    const int nig = WGM * nN, gid = wgid / nig, fm = gid * WGM, gsz = (nM - fm) < WGM ? (nM - fm) : WGM;
    pm = fm + ((wgid % nig) % gsz); pn = (wgid % nig) / gsz;
}

template <class Epi, class Sched, bool ALIGN_EPI, bool SP2>
__device__ __forceinline__ void gemm_phase(PG8_LAS unsigned char* lds, const int K, const int lda, const int ldb, const Sched& S, const Epi& E, const int K1 = 0, const int lda1 = 0, const int ldb1 = 0) {
    constexpr bool VARK = Sched::VARK;
    static_assert(!VARK || SP2, "variable-shape units use the SP2 loop");
    int tid_ = threadIdx.x; asm volatile("" : "+v"(tid_));
    const int tid = tid_, wid = __builtin_amdgcn_readfirstlane(tid >> 6), lane = tid & 63, wr = wid >> 2, wc = wid & 3, fr = lane & 15, fq = lane >> 4;
    unsigned voffA0[2], voffB0[2], voffA1[2], voffB1[2];
#pragma unroll
    for (int i = 0; i < 2; ++i) { int R, C; stage_rc(tid * 16 + i * 8192, R, C); const int Rb = Epi::PERM ? ((R & ~31) + perm32(R & 31)) : R;
        voffA0[i] = (unsigned)(R * lda + C) * 2u; voffB0[i] = (unsigned)(Rb * ldb + C) * 2u;
        voffA1[i] = VARK ? (unsigned)(R * lda1 + C) * 2u : 0u; voffB1[i] = VARK ? (unsigned)(Rb * ldb1 + C) * 2u : 0u; }
    const size_t kstep = (size_t)(BK * 2);
    const size_t hstepA0 = (size_t)HALF * lda * 2, hstepB0 = (size_t)HALF * ldb * 2, hstepA1 = (size_t)HALF * lda1 * 2, hstepB1 = (size_t)HALF * ldb1 * 2;
    const unsigned ldsw = (unsigned)wid * 1024u;
    const int aoff = lds_byte(wr * 64 + fr, fq * 8), boff = lds_byte(wc * 32 + fr, fq * 8);
#define PG8_SA(b, h) (((b) * 2 + (h)) * HTB)
#define PG8_SB(b, h) ((4 + (b) * 2 + (h)) * HTB)
#define PG8_STAGE(bufoff, gbase, voff) do { _Pragma("unroll") for (int _i = 0; _i < 2; ++_i) \
        __builtin_amdgcn_global_load_lds((const unsigned*)((const char*)(gbase) + (voff)[_i]), (PG8_LAS unsigned*)(lds + (bufoff) + ldsw + _i * 8192), 16, 0, 0); } while (0)
#define PG8_LDA(dst, b, h) do { _Pragma("unroll") for (int m = 0; m < 4; ++m) _Pragma("unroll") for (int k = 0; k < 2; ++k) dst[m][k] = *(const PG8_LAS bf16x8*)(lds + PG8_SA(b, h) + aoff + m * 2048 + k * 1024); } while (0)
#define PG8_LDB(dst, b, h) do { _Pragma("unroll") for (int n = 0; n < 2; ++n) _Pragma("unroll") for (int k = 0; k < 2; ++k) dst[n][k] = *(const PG8_LAS bf16x8*)(lds + PG8_SB(b, h) + boff + n * 2048 + k * 1024); } while (0)
#define PG8_MMA(ai, bj, At, Bt) do { __builtin_amdgcn_s_setprio(1); _Pragma("unroll") for (int m = 0; m < 4; ++m) _Pragma("unroll") for (int n = 0; n < 2; ++n) _Pragma("unroll") for (int k = 0; k < 2; ++k) \
        acc[ai][bj][m][n] = __builtin_amdgcn_mfma_f32_16x16x32_bf16(Bt[n][k], At[m][k], acc[ai][bj][m][n], 0, 0, 0); __builtin_amdgcn_s_setprio(0); } while (0)
#define PG8_WAIT_V(n) asm volatile("s_waitcnt vmcnt(" #n ")" ::: "memory")
#define PG8_WAIT_L(n) asm volatile("s_waitcnt lgkmcnt(" #n ")" ::: "memory")
#define PG8_BAR __builtin_amdgcn_s_barrier()
#define PG8_SCHED __builtin_amdgcn_sched_barrier(0)
    Unit cur, nxt; int ui = 0;
    if (!S.next(0, cur)) return;
    f32x4 acc[2][2][4][2];
#pragma unroll
    for (int a = 0; a < 2; ++a)
#pragma unroll
        for (int b = 0; b < 2; ++b)
#pragma unroll
            for (int m = 0; m < 4; ++m)
#pragma unroll
                for (int n = 0; n < 2; ++n) acc[a][b][m][n] = (f32x4){0.f, 0.f, 0.f, 0.f};
    bf16x8 At[4][2], B0[2][2], B1[2][2];
    const char* cA = cur.A; const char* cB = cur.B;
    S.a_ready(cur);
#define PG8_SEL(k2_, a0, a1) ((VARK && (k2_)) ? (a1) : (a0))
    unsigned voffA[2] = {PG8_SEL(cur.k2, voffA0[0], voffA1[0]), PG8_SEL(cur.k2, voffA0[1], voffA1[1])}, voffB[2] = {PG8_SEL(cur.k2, voffB0[0], voffB1[0]), PG8_SEL(cur.k2, voffB0[1], voffB1[1])};
    size_t hstepA = PG8_SEL(cur.k2, hstepA0, hstepA1), hstepB = PG8_SEL(cur.k2, hstepB0, hstepB1);
    int nt = PG8_SEL(cur.k2, K, K1) / BK;
    if constexpr (SP2) {
        PG8_STAGE(PG8_SB(0, 0), cB, voffB); PG8_STAGE(PG8_SB(0, 1), cB + hstepB, voffB); PG8_STAGE(PG8_SA(0, 0), cA, voffA); PG8_STAGE(PG8_SA(0, 1), cA + hstepA, voffA);
        if (wr == 1) PG8_BAR;
        PG8_WAIT_V(2); PG8_BAR;
        PG8_STAGE(PG8_SB(1, 0), cB + kstep, voffB); PG8_STAGE(PG8_SA(1, 0), cA + kstep, voffA); PG8_STAGE(PG8_SB(1, 1), cB + hstepB + kstep, voffB);
        PG8_WAIT_V(6); PG8_BAR;
    } else {
        PG8_STAGE(PG8_SB(0, 0), cB, voffB); PG8_STAGE(PG8_SA(0, 0), cA, voffA); PG8_STAGE(PG8_SB(0, 1), cB + hstepB, voffB); PG8_STAGE(PG8_SA(0, 1), cA + hstepA, voffA);
        if (wr == 1) PG8_BAR;
        PG8_WAIT_V(4); PG8_BAR;
        PG8_STAGE(PG8_SB(1, 0), cB + kstep, voffB); PG8_STAGE(PG8_SA(1, 0), cA + kstep, voffA); PG8_STAGE(PG8_SB(1, 1), cB + hstepB + kstep, voffB);
        PG8_WAIT_V(6); PG8_BAR;
    }
    for (;;) {
        const bool has_next = S.next(ui + 1, nxt);
        const char* nA = has_next ? nxt.A : cA; const char* nB = has_next ? nxt.B : cB;
        const int k2n = has_next ? nxt.k2 : cur.k2;
        for (int t = 0; t < nt; t += 2) {
            const bool last = (t == nt - 2);
            if (last && has_next) S.a_ready(nxt);
            unsigned voffAx[2], voffBx[2]; size_t hstepAx, hstepBx;
            if (VARK && last) { voffAx[0] = PG8_SEL(k2n, voffA0[0], voffA1[0]); voffAx[1] = PG8_SEL(k2n, voffA0[1], voffA1[1]); voffBx[0] = PG8_SEL(k2n, voffB0[0], voffB1[0]); voffBx[1] = PG8_SEL(k2n, voffB0[1], voffB1[1]);
                hstepAx = PG8_SEL(k2n, hstepA0, hstepA1); hstepBx = PG8_SEL(k2n, hstepB0, hstepB1); }
            else { voffAx[0] = voffA[0]; voffAx[1] = voffA[1]; voffBx[0] = voffB[0]; voffBx[1] = voffB[1]; hstepAx = hstepA; hstepBx = hstepB; }
            const char* a1 = cA + (size_t)(t + 1) * kstep;
            const char* a2 = last ? nA : cA + (size_t)(t + 2) * kstep; const char* b2 = last ? nB : cB + (size_t)(t + 2) * kstep;
            const char* a3 = a2 + kstep; const char* b3 = b2 + kstep;
            if constexpr (SP2) {
            PG8_LDB(B0, 0, 0); PG8_LDB(B1, 0, 1); PG8_SCHED; PG8_LDA(At, 0, 0); PG8_STAGE(PG8_SA(1, 1), a1 + hstepA, voffA);
            PG8_WAIT_V(8); PG8_WAIT_L(0); PG8_BAR; PG8_MMA(0, 0, At, B0); PG8_MMA(0, 1, At, B1); PG8_BAR; PG8_SCHED;
            PG8_LDA(At, 0, 1); PG8_STAGE(PG8_SB(0, 0), b2, voffBx); PG8_STAGE(PG8_SB(0, 1), b2 + hstepBx, voffBx); PG8_STAGE(PG8_SA(0, 0), a2, voffAx);
            PG8_WAIT_V(8); PG8_WAIT_L(0); PG8_BAR; PG8_MMA(1, 0, At, B0); PG8_MMA(1, 1, At, B1); PG8_BAR; PG8_SCHED;
            PG8_LDB(B0, 1, 0); PG8_LDB(B1, 1, 1); PG8_SCHED; PG8_LDA(At, 1, 0); PG8_STAGE(PG8_SA(0, 1), a2 + hstepAx, voffAx);
            PG8_WAIT_V(8); PG8_WAIT_L(0); PG8_BAR; PG8_MMA(0, 0, At, B0); PG8_MMA(0, 1, At, B1); PG8_BAR; PG8_SCHED;
            PG8_LDA(At, 1, 1); PG8_STAGE(PG8_SB(1, 0), b3, voffBx); PG8_STAGE(PG8_SB(1, 1), b3 + hstepBx, voffBx); PG8_STAGE(PG8_SA(1, 0), a3, voffAx);
            PG8_WAIT_V(8); PG8_WAIT_L(0); PG8_BAR; PG8_MMA(1, 0, At, B0); PG8_MMA(1, 1, At, B1); PG8_BAR; PG8_SCHED;
            } else {
            PG8_LDB(B0, 0, 0); PG8_SCHED; PG8_LDA(At, 0, 0); PG8_STAGE(PG8_SA(1, 1), a1 + hstepA, voffA);
            PG8_WAIT_L(8); PG8_BAR; PG8_WAIT_L(0); PG8_MMA(0, 0, At, B0); PG8_BAR; PG8_SCHED;
            PG8_LDB(B1, 0, 1); PG8_STAGE(PG8_SB(0, 0), b2, voffB);
            PG8_BAR; PG8_WAIT_L(0); PG8_MMA(0, 1, At, B1); PG8_BAR;
            PG8_LDA(At, 0, 1); PG8_STAGE(PG8_SA(0, 0), a2, voffA);
            PG8_BAR; PG8_WAIT_L(0); PG8_MMA(1, 0, At, B0); PG8_BAR; PG8_SCHED;
            PG8_STAGE(PG8_SB(0, 1), b2 + hstepB, voffB);
            PG8_WAIT_V(6); PG8_BAR; PG8_MMA(1, 1, At, B1); PG8_BAR;
            PG8_LDB(B0, 1, 0); PG8_SCHED; PG8_LDA(At, 1, 0); PG8_STAGE(PG8_SA(0, 1), a2 + hstepA, voffA);
            PG8_WAIT_L(8); PG8_BAR; PG8_WAIT_L(0); PG8_MMA(0, 0, At, B0); PG8_BAR; PG8_SCHED;
            PG8_LDB(B1, 1, 1); PG8_STAGE(PG8_SB(1, 0), b3, voffB);
            PG8_BAR; PG8_WAIT_L(0); PG8_MMA(0, 1, At, B1); PG8_BAR;
            PG8_LDA(At, 1, 1); PG8_STAGE(PG8_SA(1, 0), a3, voffA);
            PG8_BAR; PG8_WAIT_L(0); PG8_MMA(1, 0, At, B0); PG8_BAR; PG8_SCHED;
            PG8_STAGE(PG8_SB(1, 1), b3 + hstepB, voffB);
            PG8_WAIT_V(6); PG8_BAR; PG8_MMA(1, 1, At, B1); PG8_BAR;
            }
        }
        if constexpr (ALIGN_EPI) { if (wr == 0) PG8_BAR; }
        { int fr_ = fr, fq_ = fq, wr_ = wr, wc_ = wc; asm volatile("" : "+v"(fr_), "+v"(fq_), "+s"(wr_), "+s"(wc_));
          E(acc, cur, wr_, wc_, fr_, fq_); }
        S.done(cur);
        if (!has_next) break;
#pragma unroll
        for (int a = 0; a < 2; ++a)
#pragma unroll
            for (int b = 0; b < 2; ++b)
#pragma unroll
                for (int m = 0; m < 4; ++m)
#pragma unroll
                    for (int n = 0; n < 2; ++n) acc[a][b][m][n] = (f32x4){0.f, 0.f, 0.f, 0.f};
        cur = nxt; cA = nA; cB = nB; ++ui;
        if constexpr (VARK) { voffA[0] = PG8_SEL(cur.k2, voffA0[0], voffA1[0]); voffA[1] = PG8_SEL(cur.k2, voffA0[1], voffA1[1]); voffB[0] = PG8_SEL(cur.k2, voffB0[0], voffB1[0]); voffB[1] = PG8_SEL(cur.k2, voffB0[1], voffB1[1]);
            hstepA = PG8_SEL(cur.k2, hstepA0, hstepA1); hstepB = PG8_SEL(cur.k2, hstepB0, hstepB1); nt = PG8_SEL(cur.k2, K, K1) / BK; }
        if constexpr (ALIGN_EPI) { if (wr == 1) PG8_BAR; }
    }
    PG8_WAIT_V(0);
    if constexpr (!ALIGN_EPI) { if (wr == 0) PG8_BAR; }
    PG8_BAR;
#undef PG8_SEL
#undef PG8_SA
#undef PG8_SB
#undef PG8_STAGE
#undef PG8_LDA
#undef PG8_LDB
#undef PG8_MMA
#undef PG8_WAIT_V
#undef PG8_WAIT_L
#undef PG8_BAR
#undef PG8_SCHED
}
}
constexpr int D = 1024, NB = 2, S = 8192, CTX = 256, NTOK = NB * S, NCTX = NB * CTX, NALL = NTOK + NCTX;
constexpr int DIN = 3328;
constexpr int NH = 8, NKV = 2, HD = 64, DSSM = 512, NG = 32, GS = 16, NST = 64, TC = 32;
constexpr int NE = 32, DE = 512;
constexpr int NCH = 768;
constexpr int NCHV = 528;
constexpr float C2 = 0.125f * 1.4426950408889634f;
constexpr float LOG2E = 1.4426950408889634f;
constexpr int NWAVES = 8;
constexpr int MAXROWS = 41984;

constexpr size_t MiB = 1u << 20;
constexpr size_t WS_CTL = 0, CTL_ZERO_BYTES = 1 * MiB;
constexpr size_t WS_SMALL = 1 * MiB;
constexpr size_t SM_MOD = WS_SMALL + 0;
constexpr size_t SM_ROPE = WS_SMALL + 0x30000;
constexpr size_t SM_WRT = WS_SMALL + 0x40000;
constexpr size_t SM_SSMTAB = WS_SMALL + 0x90000;
constexpr size_t SM_RE = WS_SMALL + 0xC0000;
constexpr size_t SM_RW = SM_RE + (size_t)NALL * 8;
constexpr size_t SM_RSLOT = SM_RW + (size_t)NALL * 8;
constexpr size_t SM_RDEST = SM_RSLOT + (size_t)NALL * 8;
constexpr size_t SM_RWS = SM_RDEST + (size_t)NALL * 8;
static_assert(SM_RWS + (size_t)MAXROWS * 4 <= 8 * MiB, "small region");
constexpr size_t WS_W = 8 * MiB;
constexpr size_t W_IN = WS_W, W_GLU = W_IN + (size_t)DIN * D * 2, W_BRA = W_GLU + 512 * 512 * 2, W_BRS = W_BRA + 1024 * 512 * 2, W_OUT = W_BRS + 1024 * 512 * 2;
constexpr size_t W_S3 = W_OUT + 1024 * 1024 * 2, W_SE = W_S3 + (size_t)NG * 512 * 768 * 2, W_GU = W_SE + (size_t)NG * 256 * 512 * 2, W_DN = W_GU + (size_t)NE * 1024 * 1024 * 2;
constexpr size_t WS_XC = W_DN + (size_t)NE * 1024 * 512 * 2;
static_assert(WS_XC == 147 * MiB, "weights region");
constexpr size_t WS_H = WS_XC + (size_t)NALL * D * 4;
constexpr size_t WS_BIG = WS_H + (size_t)NALL * D * 2;
constexpr size_t B_Q = WS_BIG, B_K = B_Q + (size_t)NALL * 512 * 2, B_VT = B_K + (size_t)NALL * 128 * 2, B_A3 = B_VT + (size_t)NALL * 128 * 2;
constexpr size_t B_GA = B_A3 + (size_t)NG * NCH * 768 * 2, B_GS = B_GA + (size_t)NALL * D * 2, B_ATT = B_GS + (size_t)NALL * D * 2, B_SEND = B_ATT + (size_t)NALL * 512 * 2;
constexpr size_t B_Z = B_SEND + (size_t)NG * NCH * 256 * 4, B_SG = B_Z + (size_t)NALL * 512 * 2, B_T1 = B_SG + (size_t)NALL * 512 * 2, B_MB = B_T1 + (size_t)NALL * D * 2;
constexpr size_t B_END1 = B_MB + (size_t)NALL * D * 2;
constexpr size_t B_HS = WS_BIG, B_ACT = B_HS + (size_t)MAXROWS * D * 2, B_YE = B_ACT + (size_t)MAXROWS * DE * 2, B_END2 = B_YE + (size_t)MAXROWS * D * 2;
constexpr size_t WS_END = 544 * MiB;
static_assert(B_END1 <= WS_END && B_END2 <= WS_END, "d_ws map");
constexpr int CW_TMO = 0, CW_CODE = 1;
constexpr int CW_BAR = 4096;
constexpr int CW_CNT = 8192;
constexpr int CW_WORK = 8448;

constexpr int LDS_BYTES = 147456;
constexpr int LDSCTL_OFF = 143360;
constexpr int L_BARST = LDSCTL_OFF + 32;
constexpr int L_MOETAB = LDSCTL_OFF + 256;
constexpr int L_WGCNT = LDSCTL_OFF + 1024;
constexpr int L_MISC = LDSCTL_OFF + 2048;

#define GAS __attribute__((address_space(1)))
#define LAS __attribute__((address_space(3)))
typedef unsigned short bf16;
typedef unsigned v4u __attribute__((ext_vector_type(4)));
typedef unsigned v2u __attribute__((ext_vector_type(2)));
typedef float f32x4 __attribute__((ext_vector_type(4)));
typedef float f32x16 __attribute__((ext_vector_type(16)));
typedef short bf16x8 __attribute__((ext_vector_type(8)));
typedef short bf16x4 __attribute__((ext_vector_type(4)));
typedef GAS unsigned gu32;
#define RLX_AGENT __ATOMIC_RELAXED, __HIP_MEMORY_SCOPE_AGENT
#define LDS_WAIT() asm volatile("s_waitcnt lgkmcnt(0)" ::: "memory")
#define VM_WAIT() asm volatile("s_waitcnt vmcnt(0)" ::: "memory")
using pg8::cvt_pk_bf16; using pg8::bf_lo; using pg8::bf_hi;
__device__ __forceinline__ float sigmoid_f(float x) { return __builtin_amdgcn_rcpf(1.f + __expf(-x)); }
__device__ __forceinline__ float gelu_tanh_f(float x) {
    const float u = 0.7978845608028654f * (x + 0.044715f * x * x * x);
    return x * sigmoid_f(2.f * u);
}

#define XB_TMO      128
#define XB_XCNT(j)  (256  + 64 * (j))
#define XB_XSUB(j)  (1280 + 64 * (j))
#define XB_XGEN(j)  (2304 + 64 * (j))
#define XB_TOP      3328
#define XB_TOPGEN   3392
#define XCD_BAR_WORDS 3456
#define XB_SPIN_CAP (1u << 18)
__device__ __forceinline__ unsigned xb_ld(unsigned* p)              { return __hip_atomic_load(p, __ATOMIC_RELAXED, __HIP_MEMORY_SCOPE_AGENT); }
__device__ __forceinline__ unsigned xb_add(unsigned* p, unsigned v) { return __hip_atomic_fetch_add(p, v, __ATOMIC_RELAXED, __HIP_MEMORY_SCOPE_AGENT); }
__device__ __forceinline__ unsigned xb_xcc_id() { return (unsigned)__builtin_amdgcn_s_getreg((3 << 11) | 20) & 0xFu; }
#define XB_SPIN(cond, bar) do { unsigned _sp = 0; while (cond) { __builtin_amdgcn_s_sleep(1); \
    if ((++_sp & 255u) == 0u) { if (xb_ld(&(bar)[XB_TMO])) break; if (_sp > XB_SPIN_CAP) { atomicAdd(&(bar)[XB_TMO], 1u); break; } } } } while (0)
struct XcdBarrier { unsigned* bar; unsigned x; volatile LAS unsigned* st; };
__device__ __forceinline__ XcdBarrier xcd_barrier_post(unsigned* bar, volatile LAS unsigned* st) {
    XcdBarrier b; b.bar = bar; b.x = xb_xcc_id(); b.st = st;
    if (threadIdx.x == 0) (void)xb_add(&bar[XB_XCNT(b.x)], 1u);
    return b;
}
__device__ __forceinline__ void xcd_barrier_complete(unsigned* bar, unsigned x, unsigned& nloc, unsigned& nx) {
    const unsigned G = gridDim.x * gridDim.y * gridDim.z;
    unsigned sum, cnt, mine, sp = 0u;
    for (;;) {
        sum = 0u; cnt = 0u; mine = 0u;
#pragma unroll 1
        for (unsigned j = 0; j < 16; ++j) { const unsigned c = xb_ld(&bar[XB_XCNT(j)]); sum += c; cnt += (c > 0u) ? 1u : 0u; mine = (j == x) ? c : mine; }
        if (sum == G) break;
        __builtin_amdgcn_s_sleep(1);
        if ((++sp & 255u) == 0u) { if (xb_ld(&bar[XB_TMO])) break; if (sp > XB_SPIN_CAP) { atomicAdd(&bar[XB_TMO], 1u); break; } }
    }
    nloc = mine > 0u ? mine : 1u; nx = cnt > 0u ? cnt : 1u;
}
__device__ __forceinline__ void xcd_barrier(const XcdBarrier& b) {
    asm volatile("s_waitcnt vmcnt(0)" ::: "memory");
    __syncthreads();
    if (threadIdx.x == 0) {
        unsigned* bar = b.bar;
        __builtin_amdgcn_s_waitcnt(0);
        unsigned nloc = b.st[0], nx = b.st[1];
        if (nloc == 0u) { xcd_barrier_complete(bar, b.x, nloc, nx); b.st[0] = nloc; b.st[1] = nx; }
        const unsigned old = xb_add(&bar[XB_XSUB(b.x)], 1u);
        const unsigned gen = old / nloc;
        if (old + 1u == (gen + 1u) * nloc) {
            __builtin_amdgcn_fence(__ATOMIC_RELEASE, "agent");
            asm volatile("s_waitcnt vmcnt(0)" ::: "memory");
            const unsigned og = xb_add(&bar[XB_TOP], 1u);
            const unsigned tg = og / nx;
            if (og + 1u == (tg + 1u) * nx) xb_add(&bar[XB_TOPGEN], 1u);
            else XB_SPIN(xb_ld(&bar[XB_TOPGEN]) == tg, bar);
            __builtin_amdgcn_fence(__ATOMIC_ACQUIRE, "agent");
            xb_add(&bar[XB_XGEN(b.x)], 1u);
            asm volatile("s_waitcnt vmcnt(0)" ::: "memory");
        } else {
            XB_SPIN(xb_ld(&bar[XB_XGEN(b.x)]) == gen, bar);
            __builtin_amdgcn_fence(__ATOMIC_ACQUIRE, "agent");
            asm volatile("s_waitcnt vmcnt(0)" ::: "memory");
        }
    }
    __syncthreads();
}

struct Inputs {
    const float *x, *c, *ctx, *c_ctx, *w_mod, *b_mod, *g1, *g2, *w_in, *sink, *lam_re, *lam_im, *log_dt, *sb_re, *sb_im, *sc_re, *sc_im, *ssm_d,
        *w_glu, *w_bra, *w_brs, *w_out, *w_rg, *w_re, *w_eg, *w_eu, *w_ed, *g_final;
};
struct Frame {
    LAS unsigned char* lds;
    gu32* ctl;
    unsigned char* ws;
    int tid, lane, wave;
    int vcu, G;
    float* out;
};
__device__ __forceinline__ float row16_sum(float v) {
    v += __uint_as_float((unsigned)__builtin_amdgcn_update_dpp(0, (int)__float_as_uint(v), 0x128, 0xf, 0xf, false));
    v += __uint_as_float((unsigned)__builtin_amdgcn_update_dpp(0, (int)__float_as_uint(v), 0x124, 0xf, 0xf, false));
    v += __uint_as_float((unsigned)__builtin_amdgcn_update_dpp(0, (int)__float_as_uint(v), 0x122, 0xf, 0xf, false));
    v += __uint_as_float((unsigned)__builtin_amdgcn_update_dpp(0, (int)__float_as_uint(v), 0x121, 0xf, 0xf, false));
    return v; }
__device__ __forceinline__ float swap32_sum(float lo_keep, float hi_keep) {
    auto r = __builtin_amdgcn_permlane32_swap(__float_as_uint(lo_keep), __float_as_uint(hi_keep), false, false); return __uint_as_float(r[0]) + __uint_as_float(r[1]); }
__device__ __forceinline__ float swap16_sum(float even_keep, float odd_keep) {
    auto r = __builtin_amdgcn_permlane16_swap(__float_as_uint(even_keep), __float_as_uint(odd_keep), false, false); return __uint_as_float(r[0]) + __uint_as_float(r[1]); }
__device__ __forceinline__ float wave_sum(float v) { v = row16_sum(v); v = swap16_sum(v, v); return swap32_sum(v, v); }
__device__ __forceinline__ int which_of_row(int r) { return r < NTOK ? (r >> 13) : 2; }
__device__ __forceinline__ unsigned f2bf_rne(float f) { unsigned u = __builtin_bit_cast(unsigned, f); return (u + 0x7fffu + ((u >> 16) & 1u)) >> 16; }
__device__ __forceinline__ unsigned pk2(float lo, float hi) { return f2bf_rne(lo) | (f2bf_rne(hi) << 16); }
typedef float f32x2g __attribute__((ext_vector_type(2)));
__device__ __forceinline__ void transpose_item(const float* W, int K, int N, bf16* WT, int mode, int item, int lane) {
    const int nblk = N / 128, kb = item / nblk, nb = item % nblk, k0 = 64 * kb, n = 128 * nb + 2 * lane;
    const int row = mode == 0 ? n : (8 * (n >> 2) + (n & 3) + (mode == 2 ? 4 : 0));
    const float* wp = W + (size_t)k0 * N + n;
    f32x2g v[64];
#pragma unroll
    for (int j = 0; j < 64; ++j) v[j] = __builtin_nontemporal_load((const f32x2g*)(wp + (size_t)j * N));
    GAS v4u* op0 = (GAS v4u*)(WT + (size_t)row * K + k0); GAS v4u* op1 = (GAS v4u*)(WT + (size_t)(row + 1) * K + k0);
#pragma unroll
    for (int q = 0; q < 8; ++q) { v4u o; o.x = cvt_pk_bf16(v[8 * q].x, v[8 * q + 1].x); o.y = cvt_pk_bf16(v[8 * q + 2].x, v[8 * q + 3].x); o.z = cvt_pk_bf16(v[8 * q + 4].x, v[8 * q + 5].x); o.w = cvt_pk_bf16(v[8 * q + 6].x, v[8 * q + 7].x); op0[q] = o; }
#pragma unroll
    for (int q = 0; q < 8; ++q) { v4u o; o.x = cvt_pk_bf16(v[8 * q].y, v[8 * q + 1].y); o.y = cvt_pk_bf16(v[8 * q + 2].y, v[8 * q + 3].y); o.z = cvt_pk_bf16(v[8 * q + 4].y, v[8 * q + 5].y); o.w = cvt_pk_bf16(v[8 * q + 6].y, v[8 * q + 7].y); op1[q] = o; }
}
constexpr int CV_IN = (D / 64) * (DIN / 128), CV_GLU = 8 * 4, CV_BR = 8 * 8, CV_OUT = 16 * 8, CV_G1 = 16 * 4, CV_D1 = 8 * 8;
constexpr int CV_TOTAL = CV_IN + CV_GLU + 2 * CV_BR + CV_OUT + NE * (2 * CV_G1 + CV_D1);
__device__ __forceinline__ void convert_item(const Inputs& I, unsigned char* ws, int l, int it, int lane) {
    int r = it;
    if (r < NE * CV_G1) { const int e = r / CV_G1; transpose_item(I.w_eg + ((size_t)l * NE + e) * D * DE, D, DE, (bf16*)(ws + W_GU) + (size_t)e * 1024 * 1024, 1, r % CV_G1, lane); return; } r -= NE * CV_G1;
    if (r < NE * CV_G1) { const int e = r / CV_G1; transpose_item(I.w_eu + ((size_t)l * NE + e) * D * DE, D, DE, (bf16*)(ws + W_GU) + (size_t)e * 1024 * 1024, 2, r % CV_G1, lane); return; } r -= NE * CV_G1;
    if (r < NE * CV_D1) { const int e = r / CV_D1; transpose_item(I.w_ed + ((size_t)l * NE + e) * DE * D, DE, D, (bf16*)(ws + W_DN) + (size_t)e * 1024 * 512, 0, r % CV_D1, lane); return; } r -= NE * CV_D1;
    if (r < CV_IN) { transpose_item(I.w_in + (size_t)l * D * DIN, D, DIN, (bf16*)(ws + W_IN), 0, r, lane); return; } r -= CV_IN;
    if (r < CV_GLU) { transpose_item(I.w_glu + (size_t)l * 512 * 512, 512, 512, (bf16*)(ws + W_GLU), 0, r, lane); return; } r -= CV_GLU;
    if (r < CV_BR) { transpose_item(I.w_bra + (size_t)l * 512 * D, 512, D, (bf16*)(ws + W_BRA), 0, r, lane); return; } r -= CV_BR;
    if (r < CV_BR) { transpose_item(I.w_brs + (size_t)l * 512 * D, 512, D, (bf16*)(ws + W_BRS), 0, r, lane); return; } r -= CV_BR;
    transpose_item(I.w_out + (size_t)l * D * D, D, D, (bf16*)(ws + W_OUT), 0, r, lane);
}
__device__ __forceinline__ void convert_weights(Frame& F, const Inputs& I, int l) {
    if (F.vcu < NG) return;
    const int gw = (F.vcu - NG) * NWAVES + F.wave, NGW = (F.G - NG) * NWAVES;
    for (int r = 0, base = 0; base < CV_TOTAL; ++r, base += NGW) {
        const int it = base + ((r & 1) ? (NGW - 1 - gw) : gw);
        if (it < CV_TOTAL) convert_item(I, F.ws, l, it, F.lane);
    }
}

__device__ __forceinline__ void ssm_cs(float li, float dt, int tau, float& c, float& s) {
    const double x = (double)tau * ((double)li * (double)dt);
    const double k = __builtin_rint(x * 0.15915494309189535);
    const float r = (float)(x - k * 6.283185307179586);
    c = cosf(r); s = sinf(r);
}
constexpr int APS = 130;
__device__ __forceinline__ void ssmgen_job(Frame& F, const Inputs& I, int l, int g) {
    LAS float* Kt = (LAS float*)(F.lds);
    LAS float* apw = (LAS float*)(F.lds + 65536);
    LAS float* Bb = (LAS float*)(F.lds + 99872);
    LAS float* Ct = (LAS float*)(F.lds + 116256);
    const int tid = F.tid, lane = tid & 63, wave = tid >> 6;
    __syncthreads();
    if (tid < 128) {
        const int dir = tid >> 6, p = tid & 63, pg = (l * 2 + dir) * NG + g;
        const float lr = I.lam_re[pg * NST + p], li = I.lam_im[pg * NST + p], dt = expf(I.log_dt[pg]);
        float c1, s1; ssm_cs(li, dt, 1, c1, s1);
        const float mag = expf(lr * dt), sh = sinf(0.5f * li * dt);
        const float aim = mag * s1, nr = expm1f(lr * dt) * c1 - 2.f * sh * sh, den = lr * lr + li * li;
        const float fre = (nr * lr + aim * li) / den, fim = (aim * lr - nr * li) / den;
#pragma unroll 4
        for (int m = 0; m < 16; ++m) {
            const float br = I.sb_re[((size_t)pg * NST + p) * GS + m], bi = I.sb_im[((size_t)pg * NST + p) * GS + m];
            Bb[((dir * 64 + p) * 16 + m) * 2 + 0] = fre * br - fim * bi;
            Bb[((dir * 64 + p) * 16 + m) * 2 + 1] = fre * bi + fim * br;
            Ct[((dir * 64 + p) * 16 + m) * 2 + 0] = I.sc_re[((size_t)pg * GS + m) * NST + p];
            Ct[((dir * 64 + p) * 16 + m) * 2 + 1] = I.sc_im[((size_t)pg * GS + m) * NST + p];
        }
        float* tab = (float*)(F.ws + SM_SSMTAB);
        float c32, s32; ssm_cs(li, dt, 32, c32, s32);
        const float m32 = expf(32.f * lr * dt), a32r = m32 * c32, a32i = m32 * s32;
        float pr = a32r, pi = a32i;
#pragma unroll
        for (int q = 0; q < 5; ++q) { const float nr2 = pr * pr - pi * pi, ni2 = 2.f * pr * pi; pr = nr2; pi = ni2; }
        const float sr = pr * a32r - pi * a32i, si = pr * a32i + pi * a32r;
        const size_t ti = ((((size_t)l * NG + g) * 2 + dir) * 64 + p) * 2;
        tab[ti] = a32r; tab[ti + 1] = a32i; tab[16384 + ti] = sr; tab[16384 + ti + 1] = si;
    }
    for (int idx = tid; idx < 2 * 33 * 64; idx += 512) {
        const int p = idx & 63, tau = (idx >> 6) % 33, dir = idx / (33 * 64), pg = (l * 2 + dir) * NG + g;
        const float lr = I.lam_re[pg * NST + p], li = I.lam_im[pg * NST + p], dt = expf(I.log_dt[pg]);
        float c, sn; ssm_cs(li, dt, tau, c, sn);
        const float mg = expf((float)tau * lr * dt);
        apw[(dir * 33 + tau) * APS + p * 2] = mg * c; apw[(dir * 33 + tau) * APS + p * 2 + 1] = mg * sn;
    }
    __syncthreads();
    for (int idx = tid; idx < 1024; idx += 512) {
        const int dir = idx >> 9, tau = (idx >> 4) & 31, mp = idx & 15;
        float acc[16];
#pragma unroll
        for (int m = 0; m < 16; ++m) acc[m] = 0.f;
        for (int p = 0; p < 64; ++p) {
            const float ar = apw[(dir * 33 + tau) * APS + p * 2], ai = apw[(dir * 33 + tau) * APS + p * 2 + 1];
            const float br = Bb[((dir * 64 + p) * 16 + mp) * 2], bi = Bb[((dir * 64 + p) * 16 + mp) * 2 + 1];
            const float tr = ar * br - ai * bi, ti = ar * bi + ai * br;
            const LAS f32x4* cp = (const LAS f32x4*)(Ct + (dir * 64 + p) * 32);
#pragma unroll
            for (int q = 0; q < 8; ++q) { const f32x4 cv = cp[q]; acc[2 * q] += cv.x * tr - cv.y * ti; acc[2 * q + 1] += cv.z * tr - cv.w * ti; }
        }
#pragma unroll
        for (int m = 0; m < 16; ++m) Kt[((dir * 16 + m) * 32 + tau) * 16 + mp] = acc[m];
    }
    __syncthreads();
    bf16* W3 = (bf16*)(F.ws + W_S3) + (size_t)g * 512 * 768;
    const float* dsk = I.ssm_d + l * DSSM + g * 16;
    for (int n = wave; n < 512; n += 8) {
        const int t = n >> 4, m = n & 15;
        {
            const int s_ = lane >> 1, mp0 = (lane & 1) * 8;
            float v[8];
            if (s_ != t) { const int dir = s_ < t ? 0 : 1, tau = s_ < t ? t - s_ : s_ - t; const LAS f32x4* kp = (const LAS f32x4*)(Kt + ((dir * 16 + m) * 32 + tau) * 16 + mp0);
                const f32x4 a = kp[0], b = kp[1]; v[0] = a.x; v[1] = a.y; v[2] = a.z; v[3] = a.w; v[4] = b.x; v[5] = b.y; v[6] = b.z; v[7] = b.w; }
            else { const LAS f32x4* k0p = (const LAS f32x4*)(Kt + ((0 * 16 + m) * 32 + 0) * 16 + mp0); const LAS f32x4* k1p = (const LAS f32x4*)(Kt + ((1 * 16 + m) * 32 + 0) * 16 + mp0); const float dv = dsk[m];
                const f32x4 a = k0p[0] + k1p[0], b = k0p[1] + k1p[1]; v[0] = a.x; v[1] = a.y; v[2] = a.z; v[3] = a.w; v[4] = b.x; v[5] = b.y; v[6] = b.z; v[7] = b.w;
#pragma unroll
                for (int j = 0; j < 8; ++j) v[j] += (mp0 + j) == m ? dv : 0.f; }
            v4u o; o.x = cvt_pk_bf16(v[0], v[1]); o.y = cvt_pk_bf16(v[2], v[3]); o.z = cvt_pk_bf16(v[4], v[5]); o.w = cvt_pk_bf16(v[6], v[7]);
            *(GAS v4u*)(W3 + (size_t)n * 768 + lane * 8) = o;
        }
        if (lane < 32) {
            const int dir = lane >> 4, ri = (lane >> 3) & 1, p0 = (lane & 7) * 8, tw = dir == 0 ? t + 1 : 32 - t, pg = (l * 2 + dir) * NG + g;
            const GAS f32x4* crp = (const GAS f32x4*)(I.sc_re + ((size_t)pg * GS + m) * NST + p0); const GAS f32x4* cip = (const GAS f32x4*)(I.sc_im + ((size_t)pg * GS + m) * NST + p0);
            const f32x4 cr0 = crp[0], cr1 = crp[1], ci0 = cip[0], ci1 = cip[1];
            const float crv[8] = {cr0.x, cr0.y, cr0.z, cr0.w, cr1.x, cr1.y, cr1.z, cr1.w}, civ[8] = {ci0.x, ci0.y, ci0.z, ci0.w, ci1.x, ci1.y, ci1.z, ci1.w};
            float v[8];
#pragma unroll
            for (int j = 0; j < 8; ++j) { const float ar = apw[(dir * 33 + tw) * APS + (p0 + j) * 2], ai = apw[(dir * 33 + tw) * APS + (p0 + j) * 2 + 1];
                v[j] = ri == 0 ? (crv[j] * ar - civ[j] * ai) : -(crv[j] * ai + civ[j] * ar); }
            v4u o; o.x = cvt_pk_bf16(v[0], v[1]); o.y = cvt_pk_bf16(v[2], v[3]); o.z = cvt_pk_bf16(v[4], v[5]); o.w = cvt_pk_bf16(v[6], v[7]);
            *(GAS v4u*)(W3 + (size_t)n * 768 + 512 + lane * 8) = o;
        }
    }
    bf16* E = (bf16*)(F.ws + W_SE) + (size_t)g * 256 * 512;
    for (int n = wave; n < 256; n += 8) {
        const int dir = n >> 7, ri = (n >> 6) & 1, p = n & 63, s_ = lane >> 1, mp0 = (lane & 1) * 8, te = dir == 0 ? 31 - s_ : s_;
        const float ar = apw[(dir * 33 + te) * APS + p * 2], ai = apw[(dir * 33 + te) * APS + p * 2 + 1];
        float v[8];
#pragma unroll
        for (int j = 0; j < 8; ++j) { const float br = Bb[((dir * 64 + p) * 16 + mp0 + j) * 2], bi = Bb[((dir * 64 + p) * 16 + mp0 + j) * 2 + 1];
            v[j] = ri == 0 ? (ar * br - ai * bi) : (ar * bi + ai * br); }
        v4u o; o.x = cvt_pk_bf16(v[0], v[1]); o.y = cvt_pk_bf16(v[2], v[3]); o.z = cvt_pk_bf16(v[4], v[5]); o.w = cvt_pk_bf16(v[6], v[7]);
        *(GAS v4u*)(E + (size_t)n * 512 + lane * 8) = o;
    }
    __syncthreads();
}

__device__ __forceinline__ void mod_item(Frame& F, const Inputs& I, int item) {
    LAS float* sl = (LAS float*)(F.lds);
    LAS float* part = (LAS float*)(F.lds + 16384);
    __syncthreads();
    for (int i = F.tid; i < 3 * 1024; i += 512) { const int w = i >> 10, k = i & 1023; const float v = w < 2 ? I.c[w * D + k] : I.c_ctx[k]; sl[i] = v / (1.f + expf(-v)); }
    __syncthreads();
    const int l = item / 96, cb = item % 96, col = cb * 64 + F.lane;
    const float* W = I.w_mod + (size_t)l * D * 6144;
    float a0 = 0.f, a1 = 0.f, a2 = 0.f;
#pragma unroll 16
    for (int kk = 0; kk < 128; ++kk) { const int k = F.wave * 128 + kk; const float wv = W[(size_t)k * 6144 + col]; a0 += sl[k] * wv; a1 += sl[1024 + k] * wv; a2 += sl[2048 + k] * wv; }
    part[(F.wave * 3 + 0) * 64 + F.lane] = a0; part[(F.wave * 3 + 1) * 64 + F.lane] = a1; part[(F.wave * 3 + 2) * 64 + F.lane] = a2;
    __syncthreads();
    if (F.tid < 192) { const int w = F.tid >> 6, c = F.tid & 63; float s = 0.f;
#pragma unroll
        for (int v = 0; v < 8; ++v) s += part[(v * 3 + w) * 64 + c];
        ((float*)(F.ws + SM_MOD))[(l * 3 + w) * 6144 + cb * 64 + c] = s + I.b_mod[l * 6144 + cb * 64 + c]; }
    __syncthreads();
}
__device__ __forceinline__ void p0_small(Frame& F, const Inputs& I) {
    const int b = F.vcu - 224;
    if (b < 0) return;
    const int t = b * 512 + F.tid, NT = 32 * 512;
    float* rope = (float*)(F.ws + SM_ROPE);
    for (int i = t; i < 128 * 16; i += NT) { const int pos = i >> 4, j = i & 15; const float freq = exp2f(-(float)j * (13.287712379549449f / 16.f)); const float ang = (float)pos * freq;
        const double x = (double)ang; const double k = __builtin_rint(x * 0.15915494309189535); const float r = (float)(x - k * 6.283185307179586);
        rope[i] = cosf(r); rope[2048 + i] = sinf(r); }
    float* wrt = (float*)(F.ws + SM_WRT);
    for (int i = t; i < 2 * 36 * 1024; i += NT) { const int k = i & 1023, j = (i >> 10) % 36, l = i / (36 * 1024);
        wrt[i] = j < 4 ? I.w_rg[((size_t)l * D + k) * 4 + j] : I.w_re[((size_t)l * D + k) * 32 + (j - 4)]; }
}
struct RowVec { f32x4 v[4]; };
__device__ __forceinline__ RowVec load_row_f32(const float* p, int lane) { RowVec r; const GAS f32x4* q = (const GAS f32x4*)p + lane;
#pragma unroll
    for (int j = 0; j < 4; ++j) r.v[j] = q[64 * j]; return r; }
__device__ __forceinline__ void store_row_f32(float* p, int lane, const RowVec& r) { GAS f32x4* q = (GAS f32x4*)p + lane;
#pragma unroll
    for (int j = 0; j < 4; ++j) q[64 * j] = r.v[j]; }
__device__ __forceinline__ RowVec load_row_bf16(const bf16* p, int lane) { RowVec r; const GAS v2u* q = (const GAS v2u*)p + lane;
#pragma unroll
    for (int j = 0; j < 4; ++j) { const v2u w = q[64 * j]; r.v[j] = (f32x4){bf_lo(w.x), bf_hi(w.x), bf_lo(w.y), bf_hi(w.y)}; } return r; }
__device__ __forceinline__ void store_row_bf16(bf16* p, int lane, const RowVec& r) { GAS v2u* q = (GAS v2u*)p + lane;
#pragma unroll
    for (int j = 0; j < 4; ++j) { v2u w; w.x = cvt_pk_bf16(r.v[j].x, r.v[j].y); w.y = cvt_pk_bf16(r.v[j].z, r.v[j].w); q[64 * j] = w; } }
__device__ __forceinline__ float row_rinv(const RowVec& r) { float s = 0.f;
#pragma unroll
    for (int j = 0; j < 4; ++j) s += (r.v[j].x * r.v[j].x + r.v[j].y * r.v[j].y) + (r.v[j].z * r.v[j].z + r.v[j].w * r.v[j].w);
    return rsqrtf(wave_sum(s) * (1.f / D) + 1e-6f); }
__device__ __forceinline__ RowVec norm_mod(const RowVec& x, float rinv, const float* g, const float* shift, const float* scale, int lane) {
    RowVec o; const GAS f32x4* gp = (const GAS f32x4*)g + lane; const GAS f32x4* sh = (const GAS f32x4*)shift + lane; const GAS f32x4* sc = (const GAS f32x4*)scale + lane;
#pragma unroll
    for (int j = 0; j < 4; ++j) o.v[j] = x.v[j] * rinv * gp[64 * j] * (1.f + sc[64 * j]) + sh[64 * j];
    return o; }
__device__ __forceinline__ void moe_combine(RowVec& x, const bf16* ye, const int* rdest, int row, const float* gate, int lane) {
    const int d0 = rdest[row * 2], d1 = rdest[row * 2 + 1];
    const RowVec a = load_row_bf16(ye + (size_t)d0 * D, lane), b = load_row_bf16(ye + (size_t)d1 * D, lane);
    const GAS f32x4* gp = (const GAS f32x4*)gate + lane;
#pragma unroll
    for (int j = 0; j < 4; ++j) x.v[j] = x.v[j] + gp[64 * j] * (a.v[j] + b.v[j]);
}
__device__ __forceinline__ void phase_norm1(Frame& F, const Inputs& I, int l) {
    const int gw = F.vcu * NWAVES + F.wave, NGW = F.G * NWAVES;
    const float* mod = (const float*)(F.ws + SM_MOD);
    float* XC = (float*)(F.ws + WS_XC); bf16* H = (bf16*)(F.ws + WS_H);
    const bf16* YE = (const bf16*)(F.ws + B_YE); const int* RD = (const int*)(F.ws + SM_RDEST);
    for (int r0 = gw; r0 < NALL; r0 += 2 * NGW) {
        const int r1 = r0 + NGW; const bool two = r1 < NALL; const int r1c = two ? r1 : r0;
        RowVec x0, x1;
        if (l == 0) { x0 = load_row_f32(r0 < NTOK ? I.x + (size_t)r0 * D : I.ctx + (size_t)(r0 - NTOK) * D, F.lane); x1 = load_row_f32(r1c < NTOK ? I.x + (size_t)r1c * D : I.ctx + (size_t)(r1c - NTOK) * D, F.lane); }
        else {
            const int d00 = RD[r0 * 2], d01 = RD[r0 * 2 + 1], d10 = RD[r1c * 2], d11 = RD[r1c * 2 + 1];
            x0 = load_row_f32(XC + (size_t)r0 * D, F.lane); x1 = load_row_f32(XC + (size_t)r1c * D, F.lane);
            const RowVec a0 = load_row_bf16(YE + (size_t)d00 * D, F.lane), b0 = load_row_bf16(YE + (size_t)d01 * D, F.lane), a1 = load_row_bf16(YE + (size_t)d10 * D, F.lane), b1 = load_row_bf16(YE + (size_t)d11 * D, F.lane);
            const GAS f32x4* g0 = (const GAS f32x4*)(mod + (0 * 3 + which_of_row(r0)) * 6144 + 5 * D) + F.lane; const GAS f32x4* g1p = (const GAS f32x4*)(mod + (0 * 3 + which_of_row(r1c)) * 6144 + 5 * D) + F.lane;
#pragma unroll
            for (int j = 0; j < 4; ++j) { x0.v[j] = x0.v[j] + g0[64 * j] * (a0.v[j] + b0.v[j]); x1.v[j] = x1.v[j] + g1p[64 * j] * (a1.v[j] + b1.v[j]); }
            store_row_f32(XC + (size_t)r0 * D, F.lane, x0); if (two) store_row_f32(XC + (size_t)r1 * D, F.lane, x1);
        }
        const float ri0 = row_rinv(x0), ri1 = row_rinv(x1);
        const float* m0 = mod + (l * 3 + which_of_row(r0)) * 6144; const float* m1 = mod + (l * 3 + which_of_row(r1c)) * 6144;
        const RowVec h0 = norm_mod(x0, ri0, I.g1 + l * D, m0 + 0 * D, m0 + 1 * D, F.lane), h1 = norm_mod(x1, ri1, I.g1 + l * D, m1 + 0 * D, m1 + 1 * D, F.lane);
        store_row_bf16(H + (size_t)r0 * D, F.lane, h0); if (two) store_row_bf16(H + (size_t)r1 * D, F.lane, h1);
    }
}
__device__ __forceinline__ void phase_final(Frame& F, const Inputs& I) {
    const int gw = F.vcu * NWAVES + F.wave, NGW = F.G * NWAVES;
    const float* mod = (const float*)(F.ws + SM_MOD);
    const float* XC = (const float*)(F.ws + WS_XC);
    const bf16* YE = (const bf16*)(F.ws + B_YE); const int* RD = (const int*)(F.ws + SM_RDEST);
    for (int r0 = gw; r0 < NTOK; r0 += 2 * NGW) {
        const int r1 = r0 + NGW; const bool two = r1 < NTOK; const int r1c = two ? r1 : r0;
        const int d00 = RD[r0 * 2], d01 = RD[r0 * 2 + 1], d10 = RD[r1c * 2], d11 = RD[r1c * 2 + 1];
        RowVec x0 = load_row_f32(XC + (size_t)r0 * D, F.lane), x1 = load_row_f32(XC + (size_t)r1c * D, F.lane);
        const RowVec a0 = load_row_bf16(YE + (size_t)d00 * D, F.lane), b0 = load_row_bf16(YE + (size_t)d01 * D, F.lane), a1 = load_row_bf16(YE + (size_t)d10 * D, F.lane), b1 = load_row_bf16(YE + (size_t)d11 * D, F.lane);
        const GAS f32x4* g0 = (const GAS f32x4*)(mod + (1 * 3 + which_of_row(r0)) * 6144 + 5 * D) + F.lane; const GAS f32x4* g1p = (const GAS f32x4*)(mod + (1 * 3 + which_of_row(r1c)) * 6144 + 5 * D) + F.lane;
#pragma unroll
        for (int j = 0; j < 4; ++j) { x0.v[j] = x0.v[j] + g0[64 * j] * (a0.v[j] + b0.v[j]); x1.v[j] = x1.v[j] + g1p[64 * j] * (a1.v[j] + b1.v[j]); }
        const float ri0 = row_rinv(x0), ri1 = row_rinv(x1);
        RowVec o0, o1; const GAS f32x4* gp = (const GAS f32x4*)I.g_final + F.lane;
#pragma unroll
        for (int j = 0; j < 4; ++j) { o0.v[j] = x0.v[j] * ri0 * gp[64 * j]; o1.v[j] = x1.v[j] * ri1 * gp[64 * j]; }
        store_row_f32(F.out + (size_t)r0 * D, F.lane, o0); if (two) store_row_f32(F.out + (size_t)r1 * D, F.lane, o1);
    }
}

__device__ __forceinline__ void phase_norm2_route(Frame& F, const Inputs& I, int l, int dbgf = 0) {
    const int nrows = l == 0 ? NALL : NTOK, R = nrows / 256, row_base = F.vcu * R, nextra = R - 64;
    const float* mod = (const float*)(F.ws + SM_MOD);
    const float* XC = (const float*)(F.ws + WS_XC); bf16* H = (bf16*)(F.ws + WS_H);
    const float* wrt = (const float*)(F.ws + SM_WRT) + (size_t)l * 36 * 1024;
    volatile LAS int* lcnt = (volatile LAS int*)(F.lds + L_WGCNT);
    LAS float* wt = (LAS float*)(F.lds);
    LAS float* lg = (LAS float*)(F.lds + 131072 + F.wave * 1296);
    int* RE = (int*)(F.ws + SM_RE); float* RW = (float*)(F.ws + SM_RW); int* RSLOT = (int*)(F.ws + SM_RSLOT);
    __syncthreads();
    if (F.tid < 64) lcnt[F.tid] = 0;
    { const GAS f32x4* src = (const GAS f32x4*)(wrt + 4 * 1024); LAS f32x4* dst = (LAS f32x4*)wt;
#pragma unroll 8
      for (int i = F.tid; i < 32 * 256; i += 512) dst[i] = src[i]; }
    __syncthreads();
    const int ngroups = F.wave < nextra ? 3 : 2;
#pragma unroll 1
    for (int grp = 0; grp < ngroups; ++grp) {
        RowVec h[4];
        const int rfirst = row_base + (grp < 2 ? F.wave * 8 + grp * 4 : 64 + F.wave), rstep = grp < 2 ? 1 : 0;
#pragma unroll
        for (int rr = 0; rr < 4; ++rr) h[rr] = load_row_f32(XC + (size_t)(rfirst + rr * rstep) * D, F.lane);
        const float* ml = mod + (l * 3 + which_of_row(rfirst)) * 6144;
        RowVec gsc, gsh;
        { const GAS f32x4* gp = (const GAS f32x4*)(I.g2 + l * D) + F.lane; const GAS f32x4* sc = (const GAS f32x4*)(ml + 4 * D) + F.lane; const GAS f32x4* sh = (const GAS f32x4*)(ml + 3 * D) + F.lane;
#pragma unroll
          for (int j = 0; j < 4; ++j) { gsc.v[j] = gp[64 * j] * (1.f + sc[64 * j]); gsh.v[j] = sh[64 * j]; } }
#pragma unroll
        for (int rr = 0; rr < 4; ++rr) {
            const int r = rfirst + rr * rstep;
            const float rinv = row_rinv(h[rr]);
            if (which_of_row(r) == which_of_row(rfirst)) {
#pragma unroll
                for (int j = 0; j < 4; ++j) h[rr].v[j] = h[rr].v[j] * rinv * gsc.v[j] + gsh.v[j];
            } else { const float* m2 = mod + (l * 3 + which_of_row(r)) * 6144; h[rr] = norm_mod(h[rr], rinv, I.g2 + l * D, m2 + 3 * D, m2 + 4 * D, F.lane); }
            if (grp < 2 || rr == 0) store_row_bf16(H + (size_t)r * D, F.lane, h[rr]);
        }
#pragma unroll
        for (int j = 0; j < 4; ++j) { const GAS f32x4* wp = (const GAS f32x4*)(wrt + j * 1024) + F.lane; f32x4 wv[4];
#pragma unroll
            for (int q = 0; q < 4; ++q) wv[q] = wp[64 * q];
            float a_[4];
#pragma unroll
            for (int rr = 0; rr < 4; ++rr) { f32x4 s4 = h[rr].v[0] * wv[0]; s4 = s4 + h[rr].v[1] * wv[1]; s4 = s4 + h[rr].v[2] * wv[2]; s4 = s4 + h[rr].v[3] * wv[3]; a_[rr] = (s4.x + s4.y) + (s4.z + s4.w); }
            const float c20 = swap32_sum(a_[0], a_[2]), c21 = swap32_sum(a_[1], a_[3]); float c1 = swap16_sum(c20, c21); c1 = row16_sum(c1);
            if ((F.lane & 15) == 0) { const int rr = F.lane >> 4; if (grp < 2) lg[(grp * 4 + rr) * 36 + j] = c1; else if (rr == 0) lg[8 * 36 + j] = c1; } }
        LDS_WAIT(); asm volatile("" ::: "memory");
#pragma unroll
        for (int rr = 0; rr < 4; ++rr) {
            if (grp == 2 && rr > 0) break;
            const int lrow = grp < 2 ? grp * 4 + rr : 8;
            const LAS float* q = lg + lrow * 36;
            int gi = 0; float gm = q[0];
#pragma unroll
            for (int i = 1; i < 4; ++i) { const float v = q[i]; if (v > gm) { gm = v; gi = i; } }
            gi = __builtin_amdgcn_readfirstlane(gi);
            float a_[8];
#pragma unroll
            for (int e = 0; e < 8; ++e) { const LAS f32x4* wp = (const LAS f32x4*)(wt + (gi * 8 + e) * 1024) + F.lane;
                f32x4 s4 = h[rr].v[0] * wp[0]; s4 = s4 + h[rr].v[1] * wp[64]; s4 = s4 + h[rr].v[2] * wp[128]; s4 = s4 + h[rr].v[3] * wp[192]; a_[e] = (s4.x + s4.y) + (s4.z + s4.w); }
            const float c40 = swap32_sum(a_[0], a_[4]), c41 = swap32_sum(a_[1], a_[5]), c42 = swap32_sum(a_[2], a_[6]), c43 = swap32_sum(a_[3], a_[7]);
            float c20 = swap16_sum(c40, c42), c21 = swap16_sum(c41, c43);
            c20 = row16_sum(c20); c21 = row16_sum(c21);
            if ((F.lane & 15) == 0) { const int e0 = (F.lane >> 4) * 2; lg[lrow * 36 + 4 + e0] = c20; lg[lrow * 36 + 4 + e0 + 1] = c21; }
        }
    }
    LDS_WAIT(); asm volatile("" ::: "memory");
    int my_e0 = 0, my_e1 = 0, my_l0 = 0, my_l1 = 0, my_row = -1;
    if (F.lane < 8 || (F.lane == 8 && F.wave < nextra)) {
        const LAS float* q = lg + F.lane * 36;
        int gi = 0; float gm = q[0];
#pragma unroll
        for (int i = 1; i < 4; ++i) if (q[i] > gm) { gm = q[i]; gi = i; }
        float gs = 0.f;
#pragma unroll
        for (int i = 0; i < 4; ++i) gs += expf(q[i] - gm);
        const float gprob = 1.f / gs;
        const LAS float* el = q + 4;
        int i1 = 0; float v1 = el[0];
#pragma unroll
        for (int i = 1; i < 8; ++i) if (el[i] > v1) { v1 = el[i]; i1 = i; }
        int i2 = 0; float v2 = -INFINITY;
#pragma unroll
        for (int i = 0; i < 8; ++i) if (i != i1 && el[i] > v2) { v2 = el[i]; i2 = i; }
        const float e2 = expf(v2 - v1), p1 = 1.f / (1.f + e2), p2 = e2 / (1.f + e2);
        const int r = row_base + (F.lane < 8 ? F.wave * 8 + F.lane : 64 + F.wave), e0 = gi * 8 + i1, e1 = gi * 8 + i2;
        RE[r * 2] = e0; RE[r * 2 + 1] = e1; RW[r * 2] = gprob * p1; RW[r * 2 + 1] = gprob * p2;
        my_row = r; my_e0 = e0; my_e1 = e1;
        my_l0 = __hip_atomic_fetch_add((LAS int*)(F.lds + L_WGCNT) + e0, 1, __ATOMIC_RELAXED, __HIP_MEMORY_SCOPE_WORKGROUP);
        my_l1 = __hip_atomic_fetch_add((LAS int*)(F.lds + L_WGCNT) + e1, 1, __ATOMIC_RELAXED, __HIP_MEMORY_SCOPE_WORKGROUP);
    }
    __syncthreads();
    if (F.tid < 32) { const int c = lcnt[F.tid]; int base = 0; if (c > 0) base = (int)__hip_atomic_fetch_add(F.ctl + CW_CNT + 64 * l + F.tid, (unsigned)c, RLX_AGENT); lcnt[32 + F.tid] = base; }
    __syncthreads();
    if (my_row >= 0) { RSLOT[my_row * 2] = lcnt[32 + my_e0] + my_l0; RSLOT[my_row * 2 + 1] = lcnt[32 + my_e1] + my_l1; }
    __syncthreads();
}

__device__ __forceinline__ void moe_tables(Frame& F, int l) {
    volatile LAS int* tp = (volatile LAS int*)(F.lds + L_MOETAB);
    __syncthreads();
    if (F.tid == 0) { int acc = 0;
        for (int e = 0; e < NE; ++e) { tp[e] = acc; const int c = (int)__hip_atomic_load(F.ctl + CW_CNT + 64 * l + e, RLX_AGENT); acc += (c + 255) >> 8; }
        tp[NE] = acc; }
    __syncthreads();
}
__device__ __forceinline__ void phase_gather(Frame& F, int l) {
    moe_tables(F, l);
    const volatile LAS int* tp = (const volatile LAS int*)(F.lds + L_MOETAB);
    const int nrows = l == 0 ? NALL : NTOK;
    const int gw = F.vcu * NWAVES + F.wave, NGW = F.G * NWAVES;
    const bf16* H = (const bf16*)(F.ws + WS_H); bf16* HS = (bf16*)(F.ws + B_HS);
    const int* RE = (const int*)(F.ws + SM_RE); const float* RW = (const float*)(F.ws + SM_RW); const int* RSLOT = (const int*)(F.ws + SM_RSLOT);
    int* RDEST = (int*)(F.ws + SM_RDEST); float* RWS = (float*)(F.ws + SM_RWS);
    for (int r0 = gw; r0 < nrows; r0 += 2 * NGW) {
        const int r1 = r0 + NGW; const bool two = r1 < nrows; const int r1c = two ? r1 : r0;
        const GAS v4u* s0 = (const GAS v4u*)(H + (size_t)r0 * D) + F.lane; const GAS v4u* s1 = (const GAS v4u*)(H + (size_t)r1c * D) + F.lane;
        const v4u a0 = s0[0], b0 = s0[64], a1 = s1[0], b1 = s1[64];
        const int e00 = RE[r0 * 2], e01 = RE[r0 * 2 + 1], e10 = RE[r1c * 2], e11 = RE[r1c * 2 + 1];
        const int dd[4] = {256 * tp[e00] + RSLOT[r0 * 2], 256 * tp[e01] + RSLOT[r0 * 2 + 1], 256 * tp[e10] + RSLOT[r1c * 2], 256 * tp[e11] + RSLOT[r1c * 2 + 1]};
#pragma unroll
        for (int k = 0; k < 4; ++k) {
            if (k >= 2 && !two) break;
            GAS v4u* dst = (GAS v4u*)(HS + (size_t)dd[k] * D) + F.lane;
            dst[0] = k < 2 ? a0 : a1; dst[64] = k < 2 ? b0 : b1;
            const int r = k < 2 ? r0 : r1;
            if (F.lane == 0) { RDEST[r * 2 + (k & 1)] = dd[k]; RWS[dd[k]] = RW[r * 2 + (k & 1)]; }
        }
    }
}
__device__ __forceinline__ int carry_cidx(int dir, int b, int v) { return dir == 0 ? (v < 8 ? 512 + b * 8 + v : b * 256 + (v - 8)) : (v < 8 ? 512 + b * 8 + (7 - v) : b * 256 + 255 - (v - 8)); }
__device__ __forceinline__ void phase_ssm_carry(Frame& F, int l) {
    if (F.vcu >= 128) return;
    const int g = F.vcu >> 2, b = (F.vcu >> 1) & 1, dir = F.vcu & 1, seg = F.tid >> 6, p = F.tid & 63;
    const float* tab = (const float*)(F.ws + SM_SSMTAB);
    const size_t ti = ((((size_t)l * NG + g) * 2 + dir) * 64 + p) * 2;
    const float a32r = tab[ti], a32i = tab[ti + 1], asr = tab[16384 + ti], asi = tab[16384 + ti + 1];
    const float* send = (const float*)(F.ws + B_SEND) + (size_t)g * NCH * 256 + dir * 128 + p;
    bf16* A3 = (bf16*)(F.ws + B_A3) + (size_t)g * NCH * 768 + 512 + dir * 128 + p;
    LAS float* segend = (LAS float*)(F.lds);
    float xr = 0.f, xi = 0.f;
#pragma unroll 1
    for (int k0 = 0; k0 < 33; k0 += 11) {
        float sr[11], si[11];
#pragma unroll
        for (int k = 0; k < 11; ++k) { const unsigned c = (unsigned)carry_cidx(dir, b, seg * 33 + k0 + k); sr[k] = send[c * 256u]; si[k] = send[c * 256u + 64u]; }
#pragma unroll
        for (int k = 0; k < 11; ++k) { const float nr = a32r * xr - a32i * xi + sr[k], ni = a32r * xi + a32i * xr + si[k]; xr = nr; xi = ni; }
    }
    __syncthreads();
    segend[(seg * 64 + p) * 2] = xr; segend[(seg * 64 + p) * 2 + 1] = xi;
    __syncthreads();
    float cr = 0.f, ci = 0.f;
    for (int k = 0; k < seg; ++k) { const float er = segend[(k * 64 + p) * 2], ei = segend[(k * 64 + p) * 2 + 1]; const float nr = asr * cr - asi * ci + er, ni = asr * ci + asi * cr + ei; cr = nr; ci = ni; }
    xr = cr; xi = ci;
#pragma unroll 1
    for (int k0 = 0; k0 < 33; k0 += 11) {
        float sr[11], si[11];
#pragma unroll
        for (int k = 0; k < 11; ++k) { const unsigned c = (unsigned)carry_cidx(dir, b, seg * 33 + k0 + k); sr[k] = send[c * 256u]; si[k] = send[c * 256u + 64u]; }
#pragma unroll
        for (int k = 0; k < 11; ++k) { const unsigned c = (unsigned)carry_cidx(dir, b, seg * 33 + k0 + k);
            A3[c * 768u] = (bf16)f2bf_rne(xr); A3[c * 768u + 64u] = (bf16)f2bf_rne(xi);
            const float nr = a32r * xr - a32i * xi + sr[k], ni = a32r * xi + a32i * xr + si[k]; xr = nr; xi = ni; }
    }
    __syncthreads();
}
struct KFrag { bf16x8 k[4]; };
struct VFrag { bf16x8 v[2][2]; };
__device__ __forceinline__ void k_load(KFrag& f, const bf16* kp  , int lane) {
    const int r32 = lane & 31, hi = lane >> 5;
#pragma unroll
    for (int d0 = 0; d0 < 4; ++d0) f.k[d0] = *(const GAS bf16x8*)(kp + (size_t)r32 * 128 + d0 * 16 + hi * 8);
}
__device__ __forceinline__ void v_load(VFrag& f, const bf16* vp  , int vpitch, int lane) {
    const int r32 = lane & 31, hi = lane >> 5;
#pragma unroll
    for (int db = 0; db < 2; ++db)
#pragma unroll
        for (int ks = 0; ks < 2; ++ks) f.v[db][ks] = *(const GAS bf16x8*)(vp + (size_t)(32 * db + r32) * vpitch + 16 * ks + 8 * hi);
}
__device__ __forceinline__ void attn_tile(f32x16 (&o)[2], float& m_run, float& l_run, const bf16x8 (&qf)[4], const KFrag& fk, const VFrag& f, int mask_mode  , int lane) {
    const int r32 = lane & 31, hi = lane >> 5;
    f32x16 s = {};
#pragma unroll
    for (int d0 = 0; d0 < 4; ++d0) s = __builtin_amdgcn_mfma_f32_32x32x16_bf16(fk.k[d0], qf[d0], s, 0, 0, 0);
    __builtin_amdgcn_sched_barrier(0);
    if (mask_mode != 0) {
#pragma unroll
        for (int r = 0; r < 16; ++r) { const int kidx = (r & 3) + 8 * (r >> 2) + 4 * hi; const bool valid = mask_mode == 1 ? (kidx >= r32) : (kidx <= r32); if (!valid) s[r] = -INFINITY; }
    }
    float tm = s[0];
#pragma unroll
    for (int r = 1; r < 16; ++r) tm = fmaxf(tm, s[r]);
    { auto rr = __builtin_amdgcn_permlane32_swap(__float_as_uint(tm), __float_as_uint(tm), false, false); tm = fmaxf(__uint_as_float(rr[0]), __uint_as_float(rr[1])); }
    const float m_new = fmaxf(m_run, tm);
    const float alpha = __builtin_amdgcn_exp2f(m_run - m_new);
    m_run = m_new;
    float ps = 0.f;
#pragma unroll
    for (int r = 0; r < 16; ++r) { s[r] = __builtin_amdgcn_exp2f(s[r] - m_new); ps += s[r]; }
    l_run = l_run * alpha + ps;
    __builtin_amdgcn_sched_barrier(0);
#pragma unroll
    for (int db = 0; db < 2; ++db)
#pragma unroll
        for (int r = 0; r < 16; ++r) o[db][r] *= alpha;
    __builtin_amdgcn_sched_barrier(0);
    bf16x8 pf[2];
#pragma unroll
    for (int ks = 0; ks < 2; ++ks) {
        v4u w; w.x = cvt_pk_bf16(s[8 * ks + 0], s[8 * ks + 1]); w.y = cvt_pk_bf16(s[8 * ks + 2], s[8 * ks + 3]); w.z = cvt_pk_bf16(s[8 * ks + 4], s[8 * ks + 5]); w.w = cvt_pk_bf16(s[8 * ks + 6], s[8 * ks + 7]);
        pf[ks] = __builtin_bit_cast(bf16x8, w);
    }
#pragma unroll
    for (int db = 0; db < 2; ++db)
#pragma unroll
        for (int ks = 0; ks < 2; ++ks) o[db] = __builtin_amdgcn_mfma_f32_32x32x16_bf16(f.v[db][ks], pf[ks], o[db], 0, 0, 0);
}
__device__ __forceinline__ void tile_ptrs(int t, int nloc, int i_lo, int p0, const bf16* kl, const bf16* vl, const bf16* kc, const bf16* vc, const bf16*& kp, const bf16*& vp, int& vpitch, int& mm) {
    if (t < nloc) { const int i = i_lo + t, kt = p0 - 128 + 32 * i; kp = kl + (size_t)kt * 128; vp = vl + kt; vpitch = S; mm = i == 0 ? 1 : (i == 8 ? 2 : 0); }
    else { const int c = t - nloc; kp = kc + (size_t)(32 * c) * 128; vp = vc + 32 * c; vpitch = CTX; mm = 0; }
}
__device__ __forceinline__ void attn_wave(Frame& F, int qrow0, int h0, int b, int p0, float sink0, float sink1) {
    const int lane = F.lane, r32 = lane & 31, hi = lane >> 5, kvh = h0 >> 2;
    const bf16* Q = (const bf16*)(F.ws + B_Q); const bf16* KB = (const bf16*)(F.ws + B_K); const bf16* VT = (const bf16*)(F.ws + B_VT);
    bf16x8 qa[4], qb[4];
#pragma unroll
    for (int d0 = 0; d0 < 4; ++d0) { qa[d0] = *(const GAS bf16x8*)(Q + (size_t)(qrow0 + r32) * 512 + h0 * 64 + d0 * 16 + hi * 8); qb[d0] = *(const GAS bf16x8*)(Q + (size_t)(qrow0 + r32) * 512 + (h0 + 1) * 64 + d0 * 16 + hi * 8); }
    f32x16 oa[2], ob[2]; oa[0] = f32x16{}; oa[1] = f32x16{}; ob[0] = f32x16{}; ob[1] = f32x16{};
    float ma = sink0 * LOG2E, mb = sink1 * LOG2E, la = hi == 0 ? 1.f : 0.f, lb = la;
    const bf16* kl = KB + (size_t)(b * S) * 128 + kvh * 64; const bf16* vl = VT + (size_t)((b * 2 + kvh) * 64) * S;
    const bf16* kc = KB + (size_t)(NTOK + b * CTX) * 128 + kvh * 64; const bf16* vc = VT + (size_t)NTOK * 128 + (size_t)((b * 2 + kvh) * 64) * CTX;
    int i_lo = 0, nloc = 0;
    if (p0 >= 0) { i_lo = 4 - (p0 >> 5); if (i_lo < 0) i_lo = 0; int i_hi = (S + 128 - p0) >> 5; if (i_hi > 9) i_hi = 9; nloc = i_hi - i_lo; }
    const int nt = nloc + 8;
    KFrag ka, kb; VFrag vv;
    { const bf16* kp; const bf16* vp; int vpitch, mm; tile_ptrs(0, nloc, i_lo, p0, kl, vl, kc, vc, kp, vp, vpitch, mm); k_load(ka, kp, lane); }
#pragma unroll 1
    for (int t = 0; t < nt; t += 2) {
        const bf16* kp; const bf16* vp; int vpitch, mm0, mm1 = 0, mmx;
        tile_ptrs(t, nloc, i_lo, p0, kl, vl, kc, vc, kp, vp, vpitch, mm0); v_load(vv, vp, vpitch, lane);
        if (t + 1 < nt) { tile_ptrs(t + 1, nloc, i_lo, p0, kl, vl, kc, vc, kp, vp, vpitch, mm1); k_load(kb, kp, lane); }
        attn_tile(oa, ma, la, qa, ka, vv, mm0, lane); attn_tile(ob, mb, lb, qb, ka, vv, mm0, lane);
        if (t + 1 < nt) {
            v_load(vv, vp, vpitch, lane);
            if (t + 2 < nt) { tile_ptrs(t + 2, nloc, i_lo, p0, kl, vl, kc, vc, kp, vp, vpitch, mmx); k_load(ka, kp, lane); }
            attn_tile(oa, ma, la, qa, kb, vv, mm1, lane); attn_tile(ob, mb, lb, qb, kb, vv, mm1, lane);
        }
    }
    bf16* O = (bf16*)(F.ws + B_ATT) + (size_t)(qrow0 + r32) * 512 + h0 * 64;
    { const float inv = 1.f / (la + __shfl_xor(la, 32));
#pragma unroll
      for (int db = 0; db < 2; ++db)
#pragma unroll
        for (int g4 = 0; g4 < 4; ++g4) { v2u w; w.x = cvt_pk_bf16(oa[db][4 * g4 + 0] * inv, oa[db][4 * g4 + 1] * inv); w.y = cvt_pk_bf16(oa[db][4 * g4 + 2] * inv, oa[db][4 * g4 + 3] * inv); *(GAS v2u*)(O + 32 * db + 8 * g4 + 4 * hi) = w; } }
    { const float inv = 1.f / (lb + __shfl_xor(lb, 32));
#pragma unroll
      for (int db = 0; db < 2; ++db)
#pragma unroll
        for (int g4 = 0; g4 < 4; ++g4) { v2u w; w.x = cvt_pk_bf16(ob[db][4 * g4 + 0] * inv, ob[db][4 * g4 + 1] * inv); w.y = cvt_pk_bf16(ob[db][4 * g4 + 2] * inv, ob[db][4 * g4 + 3] * inv); *(GAS v2u*)(O + 64 + 32 * db + 8 * g4 + 4 * hi) = w; } }
}
constexpr int ATT_V_OFF = 49152;
__device__ __forceinline__ void lds_frag_load(KFrag& kf, VFrag& vf, const LAS unsigned char* kt, const LAS unsigned char* vt, int lane) {
    const int r32 = lane & 31, hi = lane >> 5;
#pragma unroll
    for (int d0 = 0; d0 < 4; ++d0) kf.k[d0] = *(const LAS bf16x8*)(kt + r32 * 128 + (((2 * d0 + hi) ^ ((r32 >> 1) & 7)) * 16));
#pragma unroll
    for (int db = 0; db < 2; ++db)
#pragma unroll
        for (int ks = 0; ks < 2; ++ks) { const int d = 32 * db + r32; vf.v[db][ks] = *(const LAS bf16x8*)(vt + d * 64 + (((2 * ks + hi) ^ ((d >> 2) & 3)) * 16)); }
}
__device__ __forceinline__ void attn_wg_task(Frame& F, const Inputs& I, int l, int v) {
    int lane_ = F.lane, wave_ = F.wave; asm volatile("" : "+v"(lane_), "+s"(wave_));
    const int lane = lane_, wave = wave_, r32 = lane & 31, hi = lane >> 5;
    const int bk = v >> 6, b = bk >> 1, kvh = bk & 1, q0 = (v & 63) * 128, h0 = kvh * 4 + 2 * (wave & 1), qt = wave >> 1, p0 = q0 + 32 * qt, kb0 = q0 - 128;
    const bf16* Q = (const bf16*)(F.ws + B_Q); const bf16* KB = (const bf16*)(F.ws + B_K); const bf16* VT = (const bf16*)(F.ws + B_VT);
    const bf16* kl = KB + (size_t)(b * S) * 128 + kvh * 64; const bf16* vl = VT + (size_t)((b * 2 + kvh) * 64) * S;
    const bf16* kc = KB + (size_t)(NTOK + b * CTX) * 128 + kvh * 64; const bf16* vc = VT + (size_t)NTOK * 128 + (size_t)((b * 2 + kvh) * 64) * CTX;
    LAS unsigned char* L = F.lds;
    {
        v4u kr[6], vr[6];
#pragma unroll
        for (int j = 0; j < 6; ++j) { const int slot = wave * 6 + j, T = slot >> 2, part = slot & 3, kt = kb0 + 32 * T; const bool ok = kt >= 0 && kt < S;
            kr[j] = (v4u){0u, 0u, 0u, 0u}; vr[j] = kr[j];
            if (ok) { kr[j] = *(const GAS v4u*)(kl + (unsigned)((kt + 8 * part + (lane >> 3)) * 128 + (lane & 7) * 8)); vr[j] = *(const GAS v4u*)(vl + (unsigned)((16 * part + (lane >> 2)) * S + kt + (lane & 3) * 8)); } }
#pragma unroll
        for (int j = 0; j < 6; ++j) { const int slot = wave * 6 + j, T = slot >> 2, part = slot & 3, kq = 8 * part + (lane >> 3), d = 16 * part + (lane >> 2);
            *(LAS v4u*)(L + T * 4096 + kq * 128 + (((lane & 7) ^ ((kq >> 1) & 7)) * 16)) = kr[j];
            *(LAS v4u*)(L + ATT_V_OFF + T * 4096 + d * 64 + (((lane & 3) ^ ((d >> 2) & 3)) * 16)) = vr[j]; }
    }
    asm volatile("" ::: "memory");
    {
        v4u ckr[4];
#pragma unroll
        for (int j = 0; j < 4; ++j) { const int slot = wave * 4 + j, T = slot >> 2, part = slot & 3; ckr[j] = *(const GAS v4u*)(kc + (unsigned)((32 * T + 8 * part + (lane >> 3)) * 128 + (lane & 7) * 8)); }
#pragma unroll
        for (int j = 0; j < 4; ++j) { const int slot = wave * 4 + j, T = slot >> 2, part = slot & 3, kq = 8 * part + (lane >> 3);
            *(LAS v4u*)(L + 98304 + T * 4096 + kq * 128 + (((lane & 7) ^ ((kq >> 1) & 7)) * 16)) = ckr[j]; }
    }
    asm volatile("" ::: "memory");
    bf16x8 qa[4], qb[4];
#pragma unroll
    for (int d0 = 0; d0 < 4; ++d0) { qa[d0] = *(const GAS bf16x8*)(Q + (size_t)(b * S + p0 + r32) * 512 + h0 * 64 + d0 * 16 + hi * 8); qb[d0] = *(const GAS bf16x8*)(Q + (size_t)(b * S + p0 + r32) * 512 + (h0 + 1) * 64 + d0 * 16 + hi * 8); }
    __syncthreads();
    f32x16 oa[2], ob[2]; oa[0] = f32x16{}; oa[1] = f32x16{}; ob[0] = f32x16{}; ob[1] = f32x16{};
    float ma = I.sink[l * NH + h0] * LOG2E, mb = I.sink[l * NH + h0 + 1] * LOG2E, la = hi == 0 ? 1.f : 0.f, lb = la;
#pragma unroll 1
    for (int i = 0; i < 9; ++i) {
        const int kt = p0 - 128 + 32 * i; if (kt < 0 || kt >= S) continue;
        const int T = qt + i; KFrag kf; VFrag vf;
        lds_frag_load(kf, vf, L + T * 4096, L + ATT_V_OFF + T * 4096, lane);
        const int mm = i == 0 ? 1 : (i == 8 ? 2 : 0);
        attn_tile(oa, ma, la, qa, kf, vf, mm, lane); __builtin_amdgcn_sched_barrier(0); attn_tile(ob, mb, lb, qb, kf, vf, mm, lane); __builtin_amdgcn_sched_barrier(0);
    }
    { v4u cvr[4];
#pragma unroll
      for (int j = 0; j < 4; ++j) { const int slot = wave * 4 + j, T = slot >> 2, part = slot & 3; cvr[j] = *(const GAS v4u*)(vc + (unsigned)((16 * part + (lane >> 2)) * CTX + 32 * T + (lane & 3) * 8)); }
      __syncthreads();
#pragma unroll
      for (int j = 0; j < 4; ++j) { const int slot = wave * 4 + j, T = slot >> 2, part = slot & 3, d = 16 * part + (lane >> 2);
        *(LAS v4u*)(L + T * 4096 + d * 64 + (((lane & 3) ^ ((d >> 2) & 3)) * 16)) = cvr[j]; } }
    __syncthreads();
#pragma unroll 1
    for (int T = 0; T < 8; ++T) { KFrag kf; VFrag vf; lds_frag_load(kf, vf, L + 98304 + T * 4096, L + T * 4096, lane);
        attn_tile(oa, ma, la, qa, kf, vf, 0, lane); __builtin_amdgcn_sched_barrier(0); attn_tile(ob, mb, lb, qb, kf, vf, 0, lane); __builtin_amdgcn_sched_barrier(0); }
    __syncthreads();
    bf16* O = (bf16*)(F.ws + B_ATT) + (size_t)(b * S + p0 + r32) * 512 + h0 * 64;
    { const float inv = 1.f / (la + __shfl_xor(la, 32));
#pragma unroll
      for (int db = 0; db < 2; ++db)
#pragma unroll
        for (int g4 = 0; g4 < 4; ++g4) { v2u w; w.x = cvt_pk_bf16(oa[db][4 * g4 + 0] * inv, oa[db][4 * g4 + 1] * inv); w.y = cvt_pk_bf16(oa[db][4 * g4 + 2] * inv, oa[db][4 * g4 + 3] * inv); *(GAS v2u*)(O + 32 * db + 8 * g4 + 4 * hi) = w; } }
    { const float inv = 1.f / (lb + __shfl_xor(lb, 32));
#pragma unroll
      for (int db = 0; db < 2; ++db)
#pragma unroll
        for (int g4 = 0; g4 < 4; ++g4) { v2u w; w.x = cvt_pk_bf16(ob[db][4 * g4 + 0] * inv, ob[db][4 * g4 + 1] * inv); w.y = cvt_pk_bf16(ob[db][4 * g4 + 2] * inv, ob[db][4 * g4 + 3] * inv); *(GAS v2u*)(O + 64 + 32 * db + 8 * g4 + 4 * hi) = w; } }
}
__device__ __forceinline__ void phase_attn_latent(Frame& F, const Inputs& I, int l) {
    __syncthreads();
    for (int v = F.vcu; v < 256; v += F.G) attn_wg_task(F, I, l, v);
}
__device__ __forceinline__ void phase_attn_ctx(Frame& F, const Inputs& I, int l, int first_wg) {
    const int wv = (F.vcu - first_wg) * NWAVES + F.wave;
    if (F.vcu < first_wg || wv >= 64) return;
    const int b = wv >> 5, h0 = ((wv >> 3) & 3) * 2, qt = wv & 7;
    attn_wave(F, NTOK + b * CTX + qt * 32, h0, b, -1, I.sink[l * NH + h0], I.sink[l * NH + h0 + 1]);
}
__device__ __forceinline__ f32x16 small_prod(const bf16* A, int lda, const bf16* Bt, int ldb, int kbeg, int ksteps, int lane) {
    const int r32 = lane & 31, hi = lane >> 5;
    const bf16* ap = A + (size_t)r32 * lda + kbeg + hi * 8; const bf16* bp = Bt + (size_t)r32 * ldb + kbeg + hi * 8;
    f32x16 acc = {};
#pragma unroll 1
    for (int k0 = 0; k0 < ksteps; k0 += 8) {
        bf16x8 af[8], bf_[8];
#pragma unroll
        for (int j = 0; j < 8; ++j) { af[j] = *(const GAS bf16x8*)(ap + (k0 + j) * 16); bf_[j] = *(const GAS bf16x8*)(bp + (k0 + j) * 16); }
#pragma unroll
        for (int j = 0; j < 8; ++j) acc = __builtin_amdgcn_mfma_f32_32x32x16_bf16(af[j], bf_[j], acc, 0, 0, 0);
    }
    return acc;
}
__device__ __forceinline__ void ctx_small_gemm(Frame& F, const Inputs& I, int kind) {
    if (F.vcu >= 256) return;
    const int tm = F.vcu >> 4, tn = F.vcu & 15, nb = F.wave & 1, kq = F.wave >> 1, lane = F.lane, r32 = lane & 31, hi = lane >> 5;
    const int row0 = NTOK + 32 * tm, col0 = 64 * tn + 32 * nb;
    LAS float* red = (LAS float*)(F.lds);
    f32x16 p1, p2 = {};
    if (kind == 0) {
        p1 = small_prod((const bf16*)(F.ws + B_ATT) + (size_t)row0 * 512, 512, (const bf16*)(F.ws + W_BRA) + (size_t)col0 * 512, 512, kq * 128, 8, lane);
        p2 = small_prod((const bf16*)(F.ws + B_SG) + (size_t)row0 * 512, 512, (const bf16*)(F.ws + W_BRS) + (size_t)col0 * 512, 512, kq * 128, 8, lane);
    } else p1 = small_prod((const bf16*)(F.ws + B_MB) + (size_t)row0 * D, D, (const bf16*)(F.ws + W_OUT) + (size_t)col0 * D, D, kq * 256, 16, lane);
    __syncthreads();
#pragma unroll
    for (int r = 0; r < 16; ++r) { red[((0 * 8 + F.wave) * 16 + r) * 64 + lane] = p1[r]; if (kind == 0) red[((1 * 8 + F.wave) * 16 + r) * 64 + lane] = p2[r]; }
    __syncthreads();
    if (F.wave < 2) {
        const int col = col0 + r32;
#pragma unroll
        for (int r = 0; r < 16; ++r) {
            const int row = row0 + (r & 3) + 8 * (r >> 2) + 4 * hi;
            float s1 = 0.f, s2 = 0.f;
#pragma unroll
            for (int q = 0; q < 4; ++q) { s1 += red[((0 * 8 + 2 * q + nb) * 16 + r) * 64 + lane]; if (kind == 0) s2 += red[((1 * 8 + 2 * q + nb) * 16 + r) * 64 + lane]; }
            if (kind == 0) {
                const float ga = bf_lo((unsigned)((const bf16*)(F.ws + B_GA))[(size_t)row * D + col]), gs = bf_lo((unsigned)((const bf16*)(F.ws + B_GS))[(size_t)row * D + col]);
                __hip_atomic_store((GAS unsigned short*)((bf16*)(F.ws + B_MB) + (size_t)row * D + col), (unsigned short)f2bf_rne(ga * s1 + gs * s2), __ATOMIC_RELAXED, __HIP_MEMORY_SCOPE_AGENT);
            } else {
                const float gate = ((const float*)(F.ws + SM_MOD))[(0 * 3 + 2) * 6144 + 2 * D + col];
                ((float*)(F.ws + WS_XC))[(size_t)row * D + col] = I.ctx[(size_t)(row - NTOK) * D + col] + gate * s1;
            }
        }
        if (kind == 0) { asm volatile("s_waitcnt vmcnt(0)" ::: "memory"); if (lane == 0) __hip_atomic_fetch_add((gu32*)(F.ws + WS_CTL) + 49152 + 64 * (0 * 160 + 130 + tm), 1u, RLX_AGENT); }
    }
    __syncthreads();
}
using pg8::Unit;
#ifndef GEMM_ALIGN
#define GEMM_ALIGN true
#endif
#ifndef MOE_FUSED
#define MOE_FUSED 1
#endif
#ifndef E2_FUSED
#define E2_FUSED 0
#endif
#ifndef S2_FUSED
#define S2_FUSED 1
#endif
constexpr int CW_S1 = 90112;
#ifndef GEMM_SP2
#define GEMM_SP2 true
#endif
__device__ __forceinline__ v4u pack8(const f32x4& a, const f32x4& b) { v4u w; w.x = cvt_pk_bf16(a.x, a.y); w.y = cvt_pk_bf16(a.z, a.w); w.z = cvt_pk_bf16(b.x, b.y); w.w = cvt_pk_bf16(b.z, b.w); return w; }
__device__ __forceinline__ void unpack8(const v4u w, f32x4& a, f32x4& b) { a = (f32x4){bf_lo(w.x), bf_hi(w.x), bf_lo(w.y), bf_hi(w.y)}; b = (f32x4){bf_lo(w.z), bf_hi(w.z), bf_lo(w.w), bf_hi(w.w)}; }
__device__ __forceinline__ f32x4 sig4(const f32x4& v) { return (f32x4){sigmoid_f(v.x), sigmoid_f(v.y), sigmoid_f(v.z), sigmoid_f(v.w)}; }
__device__ __forceinline__ f32x4 gelu4(const f32x4& v) { return (f32x4){gelu_tanh_f(v.x), gelu_tanh_f(v.y), gelu_tanh_f(v.z), gelu_tanh_f(v.w)}; }

enum GemmKind { GK_INPROJ = 0, GK_S1, GK_S3, GK_GLU, GK_BR, GK_OUT, GK_MU, GK_MD, GK_MOE, GK_E2A, GK_E2B };
constexpr int CW_E2 = 49152;
__device__ __forceinline__ void store16_wt(unsigned char* ws, size_t byte_off, const v4u w) {
    const __amdgpu_buffer_rsrc_t rs = __builtin_amdgcn_make_buffer_rsrc(ws, 0, (int)WS_END, 0x00020000);
    __builtin_amdgcn_raw_buffer_store_b128(w, rs, (int)byte_off, 0, 16); }
__device__ __forceinline__ void wg_wait_count(unsigned char* ws, int word, unsigned need) {
    if (threadIdx.x < 64) { gu32* w = (gu32*)(ws + WS_CTL) + word; unsigned sp = 0;
        while ((unsigned)__builtin_amdgcn_readfirstlane((int)__hip_atomic_load(w, RLX_AGENT)) < need) { __builtin_amdgcn_s_sleep(2);
            if (++sp > (1u << 20)) { if (threadIdx.x == 0) __hip_atomic_store((gu32*)(ws + WS_CTL) + CW_TMO, 1u, RLX_AGENT); break; } }
        __builtin_amdgcn_fence(__ATOMIC_ACQUIRE, "agent"); asm volatile("s_waitcnt vmcnt(0)" ::: "memory"); }
    asm volatile("" ::: "memory"); __builtin_amdgcn_s_barrier(); asm volatile("" ::: "memory"); }
__device__ __forceinline__ void wave_arrive(unsigned char* ws, int word) { asm volatile("s_waitcnt vmcnt(0)" ::: "memory"); if ((threadIdx.x & 63) == 0) __hip_atomic_fetch_add((gu32*)(ws + WS_CTL) + word, 1u, RLX_AGENT); }
constexpr int CW_RDY = 16384;
struct GemmDesc { int kind, layer, G, c, vc, nM; unsigned char* ws; const float* xlat; const float* xctx; };

template <int KIND> struct EpiAll {
    static constexpr bool PERM = true;
    GemmDesc d;
    typedef const f32x4 (&Acc)[2][2][4][2];
    __device__ __forceinline__ void inproj(Acc acc, const Unit& u, int wr, int wc, int fr, int fq) const {
        unsigned char* ws = d.ws;
        const int pn = u.pn, pm = u.pm, r0 = pm * 256 + wr * 64 + fr;
        const bool latent = pm < 64;
        if (pn <= 2) {
            const float* rope = (const float*)(ws + SM_ROPE);
            bf16* Q = (bf16*)(ws + B_Q); bf16* KB = (bf16*)(ws + B_K); bf16* VT = (bf16*)(ws + B_VT);
            const int jb = 8 * (fq & 1); const float sgn = fq < 2 ? -1.f : 1.f;
#pragma unroll
            for (int ai = 0; ai < 2; ++ai)
#pragma unroll
                for (int m = 0; m < 4; ++m) {
                    const int r = r0 + ai * 128 + m * 16;
                    f32x4 c0 = {1.f, 1.f, 1.f, 1.f}, c1 = c0, s0 = {0.f, 0.f, 0.f, 0.f}, s1 = s0;
                    if (latent) { const int s = r & 8191, pos = (wc & 1) ? (s & 63) : (s >> 6); const float* rp = rope + pos * 16 + jb;
                        c0 = *(const GAS f32x4*)rp; c1 = *(const GAS f32x4*)(rp + 4); s0 = *(const GAS f32x4*)(rp + 2048); s1 = *(const GAS f32x4*)(rp + 2052); }
#pragma unroll
                    for (int bj = 0; bj < 2; ++bj) {
                        f32x4 v0 = acc[ai][bj][m][0], v1 = acc[ai][bj][m][1];
                        if (pn == 2 && bj == 1) {
                            const int dd = 32 * (wc & 1) + 8 * fq, kvh = wc >> 1; bf16* vt; size_t pitch;
                            if (latent) { const int b = r >> 13, k_ = r & 8191, key = (k_ & ~12) | ((k_ & 4) << 1) | ((k_ & 8) >> 1); vt = VT + (size_t)((b * 2 + kvh) * 64 + dd) * S + key; pitch = S; }
                            else { const int rc = r - NTOK, b = rc >> 8, k_ = rc & 255, key = (k_ & ~12) | ((k_ & 4) << 1) | ((k_ & 8) >> 1); vt = VT + (size_t)NTOK * 128 + (size_t)((b * 2 + kvh) * 64 + dd) * CTX + key; pitch = CTX; }
                            vt[0] = (bf16)f2bf_rne(v0.x); vt[pitch] = (bf16)f2bf_rne(v0.y); vt[2 * pitch] = (bf16)f2bf_rne(v0.z); vt[3 * pitch] = (bf16)f2bf_rne(v0.w);
                            vt[4 * pitch] = (bf16)f2bf_rne(v1.x); vt[5 * pitch] = (bf16)f2bf_rne(v1.y); vt[6 * pitch] = (bf16)f2bf_rne(v1.z); vt[7 * pitch] = (bf16)f2bf_rne(v1.w);
                            continue;
                        }
                        if (latent) {
                            f32x4 p0, p1;
                            p0.x = __shfl_xor(v0.x, 32); p0.y = __shfl_xor(v0.y, 32); p0.z = __shfl_xor(v0.z, 32); p0.w = __shfl_xor(v0.w, 32);
                            p1.x = __shfl_xor(v1.x, 32); p1.y = __shfl_xor(v1.y, 32); p1.z = __shfl_xor(v1.z, 32); p1.w = __shfl_xor(v1.w, 32);
                            v0 = v0 * c0 + (p0 * s0) * sgn; v1 = v1 * c1 + (p1 * s1) * sgn;
                        }
                        if (pn < 2) { v0 = v0 * C2; v1 = v1 * C2; *(GAS v4u*)(Q + (size_t)r * 512 + pn * 256 + bj * 128 + wc * 32 + 8 * fq) = pack8(v0, v1); }
                        else *(GAS v4u*)(KB + (size_t)r * 128 + wc * 32 + 8 * fq) = pack8(v0, v1);
                    }
                }
        } else if (pn <= 4) {
            bf16* A3 = (bf16*)(ws + B_A3);
#pragma unroll
            for (int ai = 0; ai < 2; ++ai)
#pragma unroll
                for (int m = 0; m < 4; ++m) {
                    const int r = r0 + ai * 128 + m * 16, cidx = r >> 5, s = r & 31;
#pragma unroll
                    for (int bj = 0; bj < 2; ++bj) { const int c = 256 * (pn - 3) + 128 * bj + 32 * wc + 8 * fq, g = c >> 4, mp0 = c & 15;
                        *(GAS v4u*)(A3 + ((size_t)(g * NCH + cidx) * 768 + s * 16 + mp0)) = pack8(acc[ai][bj][m][0], acc[ai][bj][m][1]); }
                }
        } else {
            bf16* Gt = (bf16*)(ws + (pn <= 8 ? B_GA : B_GS)); const int cb = 256 * (pn <= 8 ? pn - 5 : pn - 9);
#pragma unroll
            for (int ai = 0; ai < 2; ++ai)
#pragma unroll
                for (int m = 0; m < 4; ++m) {
                    const int r = r0 + ai * 128 + m * 16;
#pragma unroll
                    for (int bj = 0; bj < 2; ++bj) *(GAS v4u*)(Gt + (size_t)r * D + cb + 128 * bj + 32 * wc + 8 * fq) = pack8(sig4(acc[ai][bj][m][0]), sig4(acc[ai][bj][m][1]));
                }
        }
    }
    __device__ __forceinline__ void operator()(Acc acc, const Unit& u, int wr, int wc, int fr, int fq) const {
        unsigned char* ws = d.ws;
        if constexpr (KIND == GK_INPROJ) { inproj(acc, u, wr, wc, fr, fq); return; }
        const int r0 = u.pm * 256 + wr * 64 + fr, c0 = u.pn * 256 + wc * 32 + 8 * fq;
        f32x4 og[2][2] = {};
        if constexpr (KIND == GK_OUT || KIND == GK_E2B) { const int w = u.pm < 64 ? (u.pm >> 5) : 2; const float* gate = (const float*)(ws + SM_MOD) + (d.layer * 3 + w) * 6144 + 2 * D + c0;
#pragma unroll
            for (int bj = 0; bj < 2; ++bj) { og[bj][0] = *(const GAS f32x4*)(gate + bj * 128); og[bj][1] = *(const GAS f32x4*)(gate + bj * 128 + 4); } }
#pragma unroll
        for (int aq = 0; aq < 4; ++aq) { const int ai = aq >> 1, mb = (aq & 1) * 2;
            v4u LA[4][2] = {}, LB[4][2] = {}; float LW[4] = {};
#pragma unroll
            for (int m = mb; m < mb + 2; ++m) {
                const int r = r0 + ai * 128 + m * 16;
                if constexpr (KIND == GK_MD) LW[m] = ((const float*)(ws + SM_RWS))[r];
                if constexpr (KIND == GK_MOE) { if (u.k2 == 1) LW[m] = ((const float*)(ws + SM_RWS))[r]; }
#pragma unroll
                for (int bj = 0; bj < 2; ++bj) { const int c = c0 + bj * 128;
                    if constexpr (KIND == GK_GLU) LA[m][bj] = *(const GAS v4u*)((const bf16*)(ws + B_Z) + (size_t)r * 512 + c);
                    if constexpr (KIND == GK_BR) { const size_t o = (size_t)r * D + c; if (u.aux == 0) LA[m][bj] = *(const GAS v4u*)((const bf16*)(ws + B_GA) + o); else { LA[m][bj] = *(const GAS v4u*)((const bf16*)(ws + B_GS) + o); LB[m][bj] = *(const GAS v4u*)((const bf16*)(ws + B_T1) + o); } }
                    if constexpr (KIND == GK_OUT || KIND == GK_E2B) { const float* xin = (r < NTOK ? d.xlat + (size_t)r * D : d.xctx + (size_t)(r - NTOK) * D) + c; LA[m][bj] = *(const GAS v4u*)xin; LB[m][bj] = *(const GAS v4u*)(xin + 4); }
                }
            }
#pragma unroll
            for (int m = mb; m < mb + 2; ++m) {
                const int r = r0 + ai * 128 + m * 16;
#pragma unroll
                for (int bj = 0; bj < 2; ++bj) {
                    const int c = c0 + bj * 128;
                    const f32x4 v0 = acc[ai][bj][m][0], v1 = acc[ai][bj][m][1];
                    switch (KIND) {
                    case GK_S1: {
                        const size_t o = B_SEND + ((size_t)(u.aux * NCH + r) * 256 + c) * 4;
#if S2_FUSED
                        store16_wt(ws, o, __builtin_bit_cast(v4u, v0)); store16_wt(ws, o + 16, __builtin_bit_cast(v4u, v1));
#else
                        *(GAS f32x4*)(ws + o) = v0; *(GAS f32x4*)(ws + o + 16) = v1;
#endif
                        } break;
                    case GK_S3: {
                        const int t = c >> 4, m0 = c & 15; *(GAS v4u*)((bf16*)(ws + B_Z) + (size_t)(r * 32 + t) * 512 + u.aux * 16 + m0) = pack8(gelu4(v0), gelu4(v1)); } break;
                    case GK_GLU: {
                        const size_t o = (size_t)r * 512 + c; f32x4 z0, z1; unpack8(LA[m][bj], z0, z1);
                        *(GAS v4u*)((bf16*)(ws + B_SG) + o) = pack8(z0 * sig4(v0), z1 * sig4(v1)); } break;
                    case GK_BR: {
                        const size_t o = (size_t)r * D + c;
                        if (u.aux == 0) { f32x4 g0, g1; unpack8(LA[m][bj], g0, g1); *(GAS v4u*)((bf16*)(ws + B_T1) + o) = pack8(g0 * v0, g1 * v1); }
                        else { f32x4 g0, g1, t0, t1; unpack8(LA[m][bj], g0, g1); unpack8(LB[m][bj], t0, t1);
                            *(GAS v4u*)((bf16*)(ws + B_MB) + o) = pack8(t0 + g0 * v0, t1 + g1 * v1); } } break;
                    case GK_E2B:
                    case GK_OUT: {
                        float* xo = (float*)(ws + WS_XC) + (size_t)r * D + c;
                        *(GAS f32x4*)xo = __builtin_bit_cast(f32x4, LA[m][bj]) + og[bj][0] * v0; *(GAS f32x4*)(xo + 4) = __builtin_bit_cast(f32x4, LB[m][bj]) + og[bj][1] * v1; } break;
                    case GK_MU: {
                        const f32x4 a = v0 * sig4(v0) * v1; v2u w; w.x = cvt_pk_bf16(a.x, a.y); w.y = cvt_pk_bf16(a.z, a.w);
                        *(GAS v2u*)((bf16*)(ws + B_ACT) + (size_t)r * DE + (c >> 1)) = w; } break;
                    case GK_E2A: {
                        if (u.aux == 0) { const size_t o = (size_t)r * 512 + c; f32x4 z0, z1; unpack8(*(const GAS v4u*)((const bf16*)(ws + B_Z) + o), z0, z1); store16_wt(ws, B_SG + o * 2, pack8(z0 * sig4(v0), z1 * sig4(v1))); }
                        else { const size_t o = (size_t)r * D + c;
                            if (u.aux == 1) { f32x4 g0, g1; unpack8(*(const GAS v4u*)((const bf16*)(ws + B_GA) + o), g0, g1); *(GAS v4u*)((bf16*)(ws + B_T1) + o) = pack8(g0 * v0, g1 * v1); }
                            else { f32x4 g0, g1, t0, t1; unpack8(*(const GAS v4u*)((const bf16*)(ws + B_GS) + o), g0, g1); unpack8(*(const GAS v4u*)((const bf16*)(ws + B_T1) + o), t0, t1); store16_wt(ws, B_MB + o * 2, pack8(t0 + g0 * v0, t1 + g1 * v1)); } } } break;
                    case GK_MOE: {
                        if (u.k2 == 0) { const f32x4 a = v0 * sig4(v0) * v1; const unsigned long long w = (unsigned long long)cvt_pk_bf16(a.x, a.y) | ((unsigned long long)cvt_pk_bf16(a.z, a.w) << 32);
                            __hip_atomic_store((GAS unsigned long long*)((bf16*)(ws + B_ACT) + (size_t)r * DE + (c >> 1)), w, __ATOMIC_RELAXED, __HIP_MEMORY_SCOPE_AGENT); }
                        else { const float w = LW[m]; *(GAS v4u*)((bf16*)(ws + B_YE) + (size_t)r * D + c) = pack8(v0 * w, v1 * w); } } break;
                    default: {
                        const float w = LW[m]; *(GAS v4u*)((bf16*)(ws + B_YE) + (size_t)r * D + c) = pack8(v0 * w, v1 * w); } break;
                    }
                }
            }
        }
    }
};
template <int KIND> struct SchedAll {
    static constexpr bool VARK = (KIND == GK_MOE);
    GemmDesc d; const volatile LAS int* tp;
    __device__ __forceinline__ void a_ready(const Unit& u) const {
        if constexpr (KIND == GK_E2A) { if (u.aux == 2) wg_wait_count(d.ws, CW_E2 + 64 * (d.layer * 160 + u.pm), 16u); }
        if constexpr (KIND == GK_E2B) wg_wait_count(d.ws, CW_E2 + 64 * (d.layer * 160 + 66 + u.pm), 32u);
        if constexpr (KIND == GK_MOE) {
            if (u.k2 == 1) {
                if (threadIdx.x < 64) {
                    gu32* w = (gu32*)(d.ws + WS_CTL) + CW_RDY + 64 * (d.layer * 256 + u.pm); unsigned sp = 0;
                    while ((unsigned)__builtin_amdgcn_readfirstlane((int)__hip_atomic_load(w, RLX_AGENT)) < 32u) {
                        __builtin_amdgcn_s_sleep(2);
                        if (++sp > (1u << 20)) { if (threadIdx.x == 0) __hip_atomic_store((gu32*)(d.ws + WS_CTL) + CW_TMO, 1u, RLX_AGENT); break; } }
                    __builtin_amdgcn_fence(__ATOMIC_ACQUIRE, "agent");
                    asm volatile("s_waitcnt vmcnt(0)" ::: "memory");
                }
                asm volatile("" ::: "memory"); __builtin_amdgcn_s_barrier(); asm volatile("" ::: "memory");
            }
        }
    }
    __device__ __forceinline__ void done(const Unit& u) const {
        if constexpr (KIND == GK_S1 && S2_FUSED) wave_arrive(d.ws, CW_S1 + 64 * (d.layer * 32 + u.aux));
        if constexpr (KIND == GK_E2A) { if (u.aux == 0) wave_arrive(d.ws, CW_E2 + 64 * (d.layer * 160 + u.pm)); else if (u.aux == 2) wave_arrive(d.ws, CW_E2 + 64 * (d.layer * 160 + 66 + u.pm)); }
        if constexpr (KIND == GK_MOE) {
            if (u.k2 == 0) {
                asm volatile("s_waitcnt vmcnt(0)" ::: "memory");
                if ((threadIdx.x & 63) == 0) __hip_atomic_fetch_add((gu32*)(d.ws + WS_CTL) + CW_RDY + 64 * (d.layer * 256 + u.pm), 1u, RLX_AGENT);
            }
        }
    }
    __device__ __forceinline__ bool next(int i, Unit& u) const {
        unsigned char* ws = d.ws; int pm, pn, aux = 0; size_t ao, bo;
        switch (KIND) {
        case GK_INPROJ: { const int L = i * d.G + d.c;
            if (L < 64 * 13) pg8::tile_of(L, 64, 13, pm, pn);
            else { const int k = L - 64 * 13; if (d.layer == 0) { if (k >= 26) return false; pm = 64 + k / 13; pn = k % 13; } else { if (k >= 6) return false; pm = 64 + k / 3; pn = 2 + k % 3; } }
            ao = WS_H + (size_t)pm * 256 * D * 2; bo = W_IN + (size_t)pn * 256 * D * 2; } break;
        case GK_S1: { const int L = i * d.G + (S2_FUSED ? (d.G - 1 - d.vc) : d.vc); if (L >= NG * 3) return false; aux = L / 3; pm = L % 3; pn = 0;
            ao = B_A3 + (size_t)(aux * NCH + pm * 256) * 768 * 2; bo = W_SE + (size_t)(aux * 256) * 512 * 2; } break;
        case GK_S3: { const int L = i * d.G + d.vc; if (L >= NG * 6) return false; aux = L / 6; const int rem = L % 6; pm = rem >> 1; pn = rem & 1;
            ao = B_A3 + (size_t)(aux * NCH + pm * 256) * 768 * 2; bo = W_S3 + (size_t)(aux * 512 + pn * 256) * 768 * 2; } break;
        case GK_GLU: { const int L = i * d.G + d.c; if (L >= d.nM * 2) return false; pg8::tile_of(L, d.nM, 2, pm, pn);
            ao = B_Z + (size_t)pm * 256 * 512 * 2; bo = W_GLU + (size_t)pn * 256 * 512 * 2; } break;
        case GK_BR: { const int Lp = (i >> 1) * d.G + d.c; aux = i & 1; if (Lp >= d.nM * 4) return false; pg8::tile_of(Lp, d.nM, 4, pm, pn);
            ao = (aux ? B_SG : B_ATT) + (size_t)pm * 256 * 512 * 2; bo = (aux ? W_BRS : W_BRA) + (size_t)pn * 256 * 512 * 2; } break;
        case GK_OUT: { const int L = i * d.G + d.c; if (L >= d.nM * 4) return false; pg8::tile_of(L, d.nM, 4, pm, pn);
            ao = B_MB + (size_t)pm * 256 * D * 2; bo = W_OUT + (size_t)pn * 256 * D * 2; } break;
        case GK_E2A: {
            const int G = d.G, c = d.c, NGL = d.nM * 2, nglu = c < NGL ? (NGL - 1 - c) / G + 1 : 0;
            if (i < nglu) { const int L = i * G + c; pg8::tile_of(L, d.nM, 2, pm, pn); aux = 0; ao = B_Z + (size_t)pm * 256 * 512 * 2; bo = W_GLU + (size_t)pn * 256 * 512 * 2; }
            else { const int k = i - nglu, Lp = (k >> 1) * G + c; if (Lp >= 256) return false; aux = 1 + (k & 1); pg8::tile_of(Lp, 64, 4, pm, pn);
                ao = (aux == 2 ? B_SG : B_ATT) + (size_t)pm * 256 * 512 * 2; bo = (aux == 2 ? W_BRS : W_BRA) + (size_t)pn * 256 * 512 * 2; } } break;
        case GK_E2B: { const int L = i * d.G + d.c; if (L >= 256) return false; pg8::tile_of(L, 64, 4, pm, pn);
            ao = B_MB + (size_t)pm * 256 * D * 2; bo = W_OUT + (size_t)pn * 256 * D * 2; } break;
        case GK_MOE: {
            const int G = d.G, vc = d.vc, U = tp[NE] * 4, q = U / G, r = U % G, nmu = q + (vc < r ? 1 : 0);
            int L, k2;
            if (i < nmu) { L = i * G + vc; k2 = 0; }
            else { const int k = i - nmu; int first = 2 * (G - r); if (first > U) first = U; k2 = 1;
                if (vc >= r && k < 2) { L = k * (G - r) + (vc - r); if (L >= first) return false; }
                else { const int kb = vc >= r ? k - 2 : k; L = first + kb * G + vc; if (L >= U) return false; } }
            pm = L >> 2; pn = L & 3;
            int e = 0;
#pragma unroll 1
            for (int kk = 1; kk < NE; ++kk) if (tp[kk] <= pm) e = kk;
            aux = e;
            if (k2 == 0) { ao = B_HS + (size_t)pm * 256 * D * 2; bo = W_GU + (size_t)e * 1024 * 1024 * 2 + (size_t)pn * 256 * D * 2; }
            else { ao = B_ACT + (size_t)pm * 256 * DE * 2; bo = W_DN + (size_t)e * 1024 * 512 * 2 + (size_t)pn * 256 * DE * 2; }
            u.pm = pm; u.pn = pn; u.aux = aux; u.k2 = k2; u.A = (const char*)ws + ao; u.B = (const char*)ws + bo; return true; }
        default: {
            const int L = i * d.G + d.vc, TT = tp[NE]; if (L >= TT * 4) return false; pm = L >> 2; pn = L & 3;
            int e = 0;
#pragma unroll 1
            for (int k = 1; k < NE; ++k) if (tp[k] <= pm) e = k;
            aux = e;
            if (KIND == GK_MU) { ao = B_HS + (size_t)pm * 256 * D * 2; bo = W_GU + (size_t)e * 1024 * 1024 * 2 + (size_t)pn * 256 * D * 2; }
            else { ao = B_ACT + (size_t)pm * 256 * DE * 2; bo = W_DN + (size_t)e * 1024 * 512 * 2 + (size_t)pn * 256 * DE * 2; } } break;
        }
        u.pm = pm; u.pn = pn; u.aux = aux; u.k2 = 0; u.A = (const char*)ws + ao; u.B = (const char*)ws + bo; return true;
    }
};

#ifndef PHMASK
#define PHMASK 0xFFFFFFFFu
#endif
#define PHON(b) (((PHMASK) >> (b)) & 1u)
struct Args { Inputs in; float* out; unsigned char* ws; int ph_lo, ph_hi; };
enum { T_P0 = 0, T_N1, T_G1, T_AT, T_S2, T_S3, T_GLU, T_BR, T_OUT, T_N2, T_MG, T_MU, T_MD, T_FINAL };
constexpr int PH_PER_LAYER = 12, PH_FINAL = 1 + 2 * PH_PER_LAYER, N_PHASES = PH_FINAL + 1;
__global__ void __launch_bounds__(NWAVES * 64, 2) mega_fwd(Args args) {
    extern __shared__ __attribute__((aligned(16))) unsigned char lds[];
    Frame F;
    F.lds = (LAS unsigned char*)lds;
    F.tid = threadIdx.x; F.lane = F.tid & 63; F.wave = __builtin_amdgcn_readfirstlane(F.tid >> 6);
    F.G = gridDim.x; { const int bx = blockIdx.x; F.vcu = (F.G % 8 == 0) ? (bx % 8) * (F.G / 8) + bx / 8 : bx; }
    F.ws = args.ws; F.ctl = (gu32*)(args.ws + WS_CTL); F.out = args.out;
    const Inputs& I = args.in;
    for (int u = F.tid; u < (LDS_BYTES - LDSCTL_OFF) / 4; u += NWAVES * 64) ((LAS unsigned*)(F.lds + LDSCTL_OFF))[u] = 0u;
    __syncthreads();
    const int lo = args.ph_lo & 0xff, hi = args.ph_hi, dbgf = args.ph_lo >> 8;
    XcdBarrier bar; bar.bar = (unsigned*)(F.ctl + CW_BAR); bar.x = 0; bar.st = nullptr;
    if (hi - lo > 1) bar = xcd_barrier_post((unsigned*)(F.ctl + CW_BAR), (volatile LAS unsigned*)(F.lds + L_BARST));
#ifdef TSTAMP
    if (blockIdx.x == 0 && threadIdx.x == 0) ((unsigned long long*)(F.ws + 131072))[0] = __builtin_amdgcn_s_memrealtime();
#endif
#pragma unroll 1
    for (int ph = lo; ph < hi; ++ph) {
        int t, l;
        { unsigned char* w_ = F.ws; gu32* c_ = F.ctl; float* o_ = F.out; LAS unsigned char* l_ = F.lds; int v_ = F.vcu, g_ = F.G;
          asm volatile("" : "+s"(w_), "+s"(c_), "+s"(o_), "+s"(l_), "+s"(v_), "+s"(g_)); F.ws = w_; F.ctl = c_; F.out = o_; F.lds = l_; F.vcu = v_; F.G = g_;
          int t_ = threadIdx.x; asm volatile("" : "+v"(t_)); F.tid = t_; F.lane = t_ & 63; F.wave = __builtin_amdgcn_readfirstlane(t_ >> 6); }
        if (ph == 0) { t = T_P0; l = 0; } else if (ph == PH_FINAL) { t = T_FINAL; l = 1; } else { l = (ph - 1) / PH_PER_LAYER; t = (ph - 1) % PH_PER_LAYER + 1; }
        if (t == T_P0 || (t == T_N1 && l == 1)) {
            if (PHON(0) && !(dbgf & 1) && F.vcu < NG) ssmgen_job(F, I, l, F.vcu);
            if (t == T_P0 && !(dbgf & 4)) { if (PHON(1) && F.vcu >= NG && F.vcu < NG + 192) mod_item(F, I, F.vcu - NG); if (PHON(2)) p0_small(F, I); }
            if (PHON(3) && !(dbgf & 2)) convert_weights(F, I, l);
        }
        if (t == T_N1) { if (PHON(4)) phase_norm1(F, I, l); }
        else if (t >= T_G1 && t <= T_MD && t != T_S2 && t != T_N2 && t != T_MG) {
            GemmDesc d; d.layer = l; d.G = F.G; d.c = (int)blockIdx.x; d.vc = F.vcu; d.nM = l == 0 ? 66 : 64; d.ws = F.ws;
            d.xlat = l == 0 ? I.x : (const float*)(F.ws + WS_XC); d.xctx = l == 0 ? I.ctx : (const float*)(F.ws + WS_XC) + (size_t)NTOK * D;
            if (t == T_MU || (t == T_MD && !MOE_FUSED)) moe_tables(F, l);
            const volatile LAS int* tp = (const volatile LAS int*)(F.lds + L_MOETAB);
#define RUN_GEMM(KIND_, K_, LDA_, LDB_) do { d.kind = KIND_; SchedAll<KIND_> Sc{d, tp}; EpiAll<KIND_> E{d}; pg8::gemm_phase<EpiAll<KIND_>, SchedAll<KIND_>, GEMM_ALIGN, GEMM_SP2>(F.lds, K_, LDA_, LDB_, Sc, E); } while (0)
            switch (t) {
            case T_G1: if (PHON(5)) RUN_GEMM(GK_INPROJ, D, D, D); break;
            case T_AT: if (PHON(6)) RUN_GEMM(GK_S1, 512, 768, 512); break;
            case T_S3: if (PHON(10)) RUN_GEMM(GK_S3, 768, 768, 768); break;
#if E2_FUSED
            case T_GLU: if (PHON(11)) { RUN_GEMM(GK_E2A, 512, 512, 512);
                    if (l == 0) { wg_wait_count(F.ws, CW_E2 + 64 * (0 * 160 + 64 + (F.vcu >> 7)), 16u); ctx_small_gemm(F, I, 0); }
                    RUN_GEMM(GK_E2B, D, D, D);
                    if (l == 0) { wg_wait_count(F.ws, CW_E2 + 64 * (0 * 160 + 130 + (F.vcu >> 4)), 32u); ctx_small_gemm(F, I, 1); } } break;
            case T_BR: case T_OUT: break;
#else
            case T_GLU: if (PHON(11)) RUN_GEMM(GK_GLU, 512, 512, 512); break;
            case T_BR: d.nM = 64; if (PHON(12)) RUN_GEMM(GK_BR, 512, 512, 512); if (l == 0) ctx_small_gemm(F, I, 0); break;
            case T_OUT: d.nM = 64; if (PHON(13)) RUN_GEMM(GK_OUT, D, D, D); if (l == 0) ctx_small_gemm(F, I, 1); break;
#endif
#if MOE_FUSED
            case T_MU: if (PHON(16)) { d.kind = GK_MOE; SchedAll<GK_MOE> Sc{d, tp}; EpiAll<GK_MOE> E{d}; pg8::gemm_phase<EpiAll<GK_MOE>, SchedAll<GK_MOE>, GEMM_ALIGN, true>(F.lds, D, D, D, Sc, E, DE, DE, DE); } break;
            default: break;
#else
            case T_MU: if (PHON(16)) RUN_GEMM(GK_MU, D, D, D); break;
            default: if (PHON(17)) RUN_GEMM(GK_MD, DE, DE, DE); break;
#endif
            }
#undef RUN_GEMM
            if (t == T_AT && PHON(7)) phase_attn_latent(F, I, l);
#if S2_FUSED
            if (t == T_AT) { if (F.vcu < 128) { wg_wait_count(F.ws, CW_S1 + 64 * (l * 32 + (F.vcu >> 2)), 24u); if (PHON(8)) phase_ssm_carry(F, l); } if (PHON(9) && l == 0) phase_attn_ctx(F, I, l, 128); }
#endif
        }
        else if (t == T_S2) {
#if !S2_FUSED
            if (PHON(8)) phase_ssm_carry(F, l); if (PHON(9) && l == 0) phase_attn_ctx(F, I, l, 128);
#endif
        }
        else if (t == T_N2) { if (PHON(14)) phase_norm2_route(F, I, l, dbgf); }
        else if (t == T_MG) { if (PHON(15)) phase_gather(F, l); }
        else if (t == T_FINAL) { if (PHON(18)) phase_final(F, I); }
        if (ph + 1 < hi && !(MOE_FUSED && t == T_MD) && !(E2_FUSED && (t == T_BR || t == T_OUT)) && !(S2_FUSED && t == T_S2)) { bar.bar = (unsigned*)(F.ctl + CW_BAR); xcd_barrier(bar);
#ifdef DOUBLE_BAR
            xcd_barrier(bar); xcd_barrier(bar);
#endif
        }
#ifdef TSTAMP
        if (blockIdx.x == 0 && threadIdx.x == 0) ((unsigned long long*)(F.ws + 131072))[1 + ph] = __builtin_amdgcn_s_memrealtime();
#endif
    }
}

#ifdef DBG_STOP
__global__ void dbg_copy(const unsigned char* ws, float* out, size_t n) {
    for (size_t i = (size_t)blockIdx.x * blockDim.x + threadIdx.x; i < n; i += (size_t)gridDim.x * blockDim.x) {
        const size_t j = i % (size_t)(DBG_ELEMS);
#ifdef DBG_F32
        out[i] = ((const float*)(ws + (DBG_OFF)))[j];
#else
        out[i] = __uint_as_float((unsigned)((const unsigned short*)(ws + (DBG_OFF)))[j] << 16);
#endif
    }
}
#endif
#ifdef TSTAMP
__global__ void dbg_times(const unsigned char* ws, float* out, size_t n, unsigned set1, unsigned set2) {
    const unsigned long long* ts = (const unsigned long long*)(ws + 131072);
    unsigned long long s1 = 0, s2 = 0;
    for (int p = 0; p < N_PHASES; ++p) { const unsigned long long d = ts[1 + p] - ts[p]; if ((set1 >> p) & 1) s1 += d; if ((set2 >> p) & 1) s2 += d; }
    const float v1 = sqrtf((float)s1), v2 = (float)s2;
    for (size_t i = (size_t)blockIdx.x * blockDim.x + threadIdx.x; i < n; i += (size_t)gridDim.x * blockDim.x) out[i] = i == 0 ? v2 : v1;
}
#endif
#if defined(REP_SET) && defined(REP_FLUSH)
__global__ void dbg_flush(const float* p, size_t n, float* sink) {
    float a = 0.f;
    for (size_t i = (size_t)blockIdx.x * blockDim.x + threadIdx.x; i < n; i += (size_t)gridDim.x * blockDim.x) a += p[i];
    if (a == 12345.678f) sink[0] = a;
}
#endif
extern "C" void kernel_launch(void* const* d_in, const int* in_sizes, int n_in, void* d_out, int out_size, void* d_ws, size_t ws_size, hipStream_t stream) {
    static int grid = 0;
    if (grid == 0) {
        int dev = 0, cus = 0, per_cu = 0;
        if (n_in != 28 || out_size != NTOK * D || ws_size < WS_END) { grid = -1; return; }
        if (hipGetDevice(&dev) != hipSuccess || hipDeviceGetAttribute(&cus, hipDeviceAttributeMultiprocessorCount, dev) != hipSuccess) { grid = -1; return; }
        if (hipFuncSetAttribute((const void*)mega_fwd, hipFuncAttributeMaxDynamicSharedMemorySize, LDS_BYTES) != hipSuccess) { grid = -1; return; }
        if (hipOccupancyMaxActiveBlocksPerMultiprocessor(&per_cu, (const void*)mega_fwd, NWAVES * 64, LDS_BYTES) != hipSuccess || per_cu < 1) { (void)hipGetLastError(); grid = -1; return; }
        (void)hipGetLastError();
        grid = cus;
    }
    if (grid < 0) return;
    (void)hipMemsetAsync((char*)d_ws + WS_CTL, 0, CTL_ZERO_BYTES, stream);
    Args a{};
    const float** ip = (const float**)&a.in;
    for (int i = 0; i < 28; ++i) ip[i] = (const float*)d_in[i];
    a.out = (float*)d_out; a.ws = (unsigned char*)d_ws;
#ifdef DBG_STOP
    for (int p = 0; p <= (DBG_STOP); ++p) { a.ph_lo = p; a.ph_hi = p + 1; hipLaunchKernelGGL(mega_fwd, dim3(grid), dim3(NWAVES * 64), LDS_BYTES, stream, a); }
    hipLaunchKernelGGL(dbg_copy, dim3(2048), dim3(256), 0, stream, (const unsigned char*)d_ws, (float*)d_out, (size_t)out_size);
#elif defined(REP_SET)
#ifndef REP_FLAGS
#define REP_FLAGS 0
#endif
    for (int p = 0; p < N_PHASES; ++p) {
        const int n = (((unsigned long long)(REP_SET) >> p) & 1ull) ? 1 + (REP_N) : 1;
        for (int k = 0; k < n; ++k) {
            if (k > 0 && p == 0) (void)hipMemsetAsync((char*)d_ws + (CW_WORK) * 4, 0, 256, stream);
            if (k > 0 && (p == 9 || p == 21)) (void)hipMemsetAsync((char*)d_ws + (CW_CNT + 64 * (p == 21)) * 4, 0, 128, stream);
#ifdef REP_FLUSH
            if (n > 1 || (REP_FLUSH) == 2) for (int f_ = 24; f_ <= 26; ++f_) hipLaunchKernelGGL(dbg_flush, dim3(2048), dim3(256), 0, stream, (const float*)d_in[f_], (size_t)32 * 1024 * 1024, (float*)d_ws + 1000);
#endif
            a.ph_lo = p | (k > 0 ? ((REP_FLAGS) << 8) : 0); a.ph_hi = p + 1; hipLaunchKernelGGL(mega_fwd, dim3(grid), dim3(NWAVES * 64), LDS_BYTES, stream, a);
        }
    }
#elif MK_PER_PHASE
    for (int p = 0; p < N_PHASES; ++p) { a.ph_lo = p; a.ph_hi = p + 1; hipLaunchKernelGGL(mega_fwd, dim3(grid), dim3(NWAVES * 64), LDS_BYTES, stream, a); }
#else
    a.ph_lo = 0; a.ph_hi = N_PHASES;
    hipLaunchKernelGGL(mega_fwd, dim3(grid), dim3(NWAVES * 64), LDS_BYTES, stream, a);
#ifdef TSTAMP
    hipLaunchKernelGGL(dbg_times, dim3(1024), dim3(256), 0, stream, (const unsigned char*)d_ws, (float*)d_out, (size_t)out_size, (unsigned)(TS_SET1), (unsigned)(TS_SET2));
#endif
#endif
}
```

```cpp
#include <hip/hip_runtime.h>
#include <cstdint>
#include <cmath>
#ifndef MK_PER_PHASE
#define MK_PER_PHASE 0
#endif
namespace pg8 {
#define PG8_LAS __attribute__((address_space(3)))
typedef unsigned short bf16_t;
typedef short bf16x8 __attribute__((ext_vector_type(8)));
typedef float f32x4 __attribute__((ext_vector_type(4)));
typedef float f32x2 __attribute__((ext_vector_type(2)));
typedef unsigned u32x4 __attribute__((ext_vector_type(4)));
typedef unsigned u32x2 __attribute__((ext_vector_type(2)));
constexpr int BM = 256, BK = 64, HALF = 128, HTB = HALF * BK * 2, STAGE_BYTES = 8 * HTB, NXCD = 8, WGM = 8;

__host__ __device__ __forceinline__ int lds_byte(int r, int c) { const int st = (r >> 4) * 2 + (c >> 5), rr = r & 15, cc = c & 31, ob = rr * 64 + cc * 2; return st * 1024 + (ob ^ (((ob >> 9) & 1) << 5)); }
__host__ __device__ __forceinline__ void stage_rc(int b, int& R, int& C) { const int st = b / 1024, sb = b % 1024, swz = sb ^ (((sb >> 9) & 1) << 5); R = (st >> 1) * 16 + swz / 64; C = (st & 1) * 32 + (swz % 64) / 2; }
__host__ __device__ __forceinline__ int perm32(int rho) { const int n = rho >> 4, i = rho & 15; return 8 * (i >> 2) + 4 * n + (i & 3); }

struct Unit { const char* A; const char* B; int pm, pn, aux, k2; };
typedef __bf16 bf16x2_t __attribute__((ext_vector_type(2)));
__device__ __forceinline__ unsigned cvt_pk_bf16(float lo, float hi) { f32x2 v = {lo, hi}; bf16x2_t b = __builtin_convertvector(v, bf16x2_t); return __builtin_bit_cast(unsigned, b); }
__device__ __forceinline__ float bf_lo(unsigned w) { return __uint_as_float(w << 16); }
__device__ __forceinline__ float bf_hi(unsigned w) { return __uint_as_float(w & 0xffff0000u); }

__device__ __forceinline__ void tile_of(int L, int nM, int nN, int& pm, int& pn) {
    const int nwg = nM * nN; int wgid = L;
    { const int q = nwg / NXCD, r = nwg % NXCD, xcd = wgid % NXCD, off = wgid / NXCD; wgid = (xcd < r ? xcd * (q + 1) : r * (q + 1) + (xcd - r) * q) + off; }
    const int nig = WGM * nN, gid = wgid / nig, fm = gid * WGM, gsz = (nM - fm) < WGM ? (nM - fm) : WGM;
    pm = fm + ((wgid % nig) % gsz); pn = (wgid % nig) / gsz;
}

template <class Epi, class Sched, bool ALIGN_EPI, bool SP2>
__device__ __forceinline__ void gemm_phase(PG8_LAS unsigned char* lds, const int K, const int lda, const int ldb, const Sched& S, const Epi& E, const int K1 = 0, const int lda1 = 0, const int ldb1 = 0) {
    constexpr bool VARK = Sched::VARK;
    static_assert(!VARK || SP2, "variable-shape units use the SP2 loop");
    int tid_ = threadIdx.x; asm volatile("" : "+v"(tid_));
    const int tid = tid_, wid = __builtin_amdgcn_readfirstlane(tid >> 6), lane = tid & 63, wr = wid >> 2, wc = wid & 3, fr = lane & 15, fq = lane >> 4;
    unsigned voffA0[2], voffB0[2], voffA1[2], voffB1[2];
#pragma unroll
    for (int i = 0; i < 2; ++i) { int R, C; stage_rc(tid * 16 + i * 8192, R, C); const int Rb = Epi::PERM ? ((R & ~31) + perm32(R & 31)) : R;
        voffA0[i] = (unsigned)(R * lda + C) * 2u; voffB0[i] = (unsigned)(Rb * ldb + C) * 2u;
        voffA1[i] = VARK ? (unsigned)(R * lda1 + C) * 2u : 0u; voffB1[i] = VARK ? (unsigned)(Rb * ldb1 + C) * 2u : 0u; }
    const size_t kstep = (size_t)(BK * 2);
    const size_t hstepA0 = (size_t)HALF * lda * 2, hstepB0 = (size_t)HALF * ldb * 2, hstepA1 = (size_t)HALF * lda1 * 2, hstepB1 = (size_t)HALF * ldb1 * 2;
    const unsigned ldsw = (unsigned)wid * 1024u;
    const int aoff = lds_byte(wr * 64 + fr, fq * 8), boff = lds_byte(wc * 32 + fr, fq * 8);
#define PG8_SA(b, h) (((b) * 2 + (h)) * HTB)
#define PG8_SB(b, h) ((4 + (b) * 2 + (h)) * HTB)
#define PG8_STAGE(bufoff, gbase, voff) do { _Pragma("unroll") for (int _i = 0; _i < 2; ++_i) \
        __builtin_amdgcn_global_load_lds((const unsigned*)((const char*)(gbase) + (voff)[_i]), (PG8_LAS unsigned*)(lds + (bufoff) + ldsw + _i * 8192), 16, 0, 0); } while (0)
#define PG8_LDA(dst, b, h) do { _Pragma("unroll") for (int m = 0; m < 4; ++m) _Pragma("unroll") for (int k = 0; k < 2; ++k) dst[m][k] = *(const PG8_LAS bf16x8*)(lds + PG8_SA(b, h) + aoff + m * 2048 + k * 1024); } while (0)
#define PG8_LDB(dst, b, h) do { _Pragma("unroll") for (int n = 0; n < 2; ++n) _Pragma("unroll") for (int k = 0; k < 2; ++k) dst[n][k] = *(const PG8_LAS bf16x8*)(lds + PG8_SB(b, h) + boff + n * 2048 + k * 1024); } while (0)
#define PG8_MMA(ai, bj, At, Bt) do { __builtin_amdgcn_s_setprio(1); _Pragma("unroll") for (int m = 0; m < 4; ++m) _Pragma("unroll") for (int n = 0; n < 2; ++n) _Pragma("unroll") for (int k = 0; k < 2; ++k) \
        acc[ai][bj][m][n] = __builtin_amdgcn_mfma_f32_16x16x32_bf16(Bt[n][k], At[m][k], acc[ai][bj][m][n], 0, 0, 0); __builtin_amdgcn_s_setprio(0); } while (0)
#define PG8_WAIT_V(n) asm volatile("s_waitcnt vmcnt(" #n ")" ::: "memory")
#define PG8_WAIT_L(n) asm volatile("s_waitcnt lgkmcnt(" #n ")" ::: "memory")
#define PG8_BAR __builtin_amdgcn_s_barrier()
#define PG8_SCHED __builtin_amdgcn_sched_barrier(0)
    Unit cur, nxt; int ui = 0;
    if (!S.next(0, cur)) return;
    f32x4 acc[2][2][4][2];
#pragma unroll
    for (int a = 0; a < 2; ++a)
#pragma unroll
        for (int b = 0; b < 2; ++b)
#pragma unroll
            for (int m = 0; m < 4; ++m)
#pragma unroll
                for (int n = 0; n < 2; ++n) acc[a][b][m][n] = (f32x4){0.f, 0.f, 0.f, 0.f};
    bf16x8 At[4][2], B0[2][2], B1[2][2];
    const char* cA = cur.A; const char* cB = cur.B;
    S.a_ready(cur);
#define PG8_SEL(k2_, a0, a1) ((VARK && (k2_)) ? (a1) : (a0))
    unsigned voffA[2] = {PG8_SEL(cur.k2, voffA0[0], voffA1[0]), PG8_SEL(cur.k2, voffA0[1], voffA1[1])}, voffB[2] = {PG8_SEL(cur.k2, voffB0[0], voffB1[0]), PG8_SEL(cur.k2, voffB0[1], voffB1[1])};
    size_t hstepA = PG8_SEL(cur.k2, hstepA0, hstepA1), hstepB = PG8_SEL(cur.k2, hstepB0, hstepB1);
    int nt = PG8_SEL(cur.k2, K, K1) / BK;
    if constexpr (SP2) {
        PG8_STAGE(PG8_SB(0, 0), cB, voffB); PG8_STAGE(PG8_SB(0, 1), cB + hstepB, voffB); PG8_STAGE(PG8_SA(0, 0), cA, voffA); PG8_STAGE(PG8_SA(0, 1), cA + hstepA, voffA);
        if (wr == 1) PG8_BAR;
        PG8_WAIT_V(2); PG8_BAR;
        PG8_STAGE(PG8_SB(1, 0), cB + kstep, voffB); PG8_STAGE(PG8_SA(1, 0), cA + kstep, voffA); PG8_STAGE(PG8_SB(1, 1), cB + hstepB + kstep, voffB);
        PG8_WAIT_V(6); PG8_BAR;
    } else {
        PG8_STAGE(PG8_SB(0, 0), cB, voffB); PG8_STAGE(PG8_SA(0, 0), cA, voffA); PG8_STAGE(PG8_SB(0, 1), cB + hstepB, voffB); PG8_STAGE(PG8_SA(0, 1), cA + hstepA, voffA);
        if (wr == 1) PG8_BAR;
        PG8_WAIT_V(4); PG8_BAR;
        PG8_STAGE(PG8_SB(1, 0), cB + kstep, voffB); PG8_STAGE(PG8_SA(1, 0), cA + kstep, voffA); PG8_STAGE(PG8_SB(1, 1), cB + hstepB + kstep, voffB);
        PG8_WAIT_V(6); PG8_BAR;
    }
    for (;;) {
        const bool has_next = S.next(ui + 1, nxt);
        const char* nA = has_next ? nxt.A : cA; const char* nB = has_next ? nxt.B : cB;
        const int k2n = has_next ? nxt.k2 : cur.k2;
        for (int t = 0; t < nt; t += 2) {
            const bool last = (t == nt - 2);
            if (last && has_next) S.a_ready(nxt);
            unsigned voffAx[2], voffBx[2]; size_t hstepAx, hstepBx;
            if (VARK && last) { voffAx[0] = PG8_SEL(k2n, voffA0[0], voffA1[0]); voffAx[1] = PG8_SEL(k2n, voffA0[1], voffA1[1]); voffBx[0] = PG8_SEL(k2n, voffB0[0], voffB1[0]); voffBx[1] = PG8_SEL(k2n, voffB0[1], voffB1[1]);
                hstepAx = PG8_SEL(k2n, hstepA0, hstepA1); hstepBx = PG8_SEL(k2n, hstepB0, hstepB1); }
            else { voffAx[0] = voffA[0]; voffAx[1] = voffA[1]; voffBx[0] = voffB[0]; voffBx[1] = voffB[1]; hstepAx = hstepA; hstepBx = hstepB; }
            const char* a1 = cA + (size_t)(t + 1) * kstep;
            const char* a2 = last ? nA : cA + (size_t)(t + 2) * kstep; const char* b2 = last ? nB : cB + (size_t)(t + 2) * kstep;
            const char* a3 = a2 + kstep; const char* b3 = b2 + kstep;
            if constexpr (SP2) {
            PG8_LDB(B0, 0, 0); PG8_LDB(B1, 0, 1); PG8_SCHED; PG8_LDA(At, 0, 0); PG8_STAGE(PG8_SA(1, 1), a1 + hstepA, voffA);
            PG8_WAIT_V(8); PG8_WAIT_L(0); PG8_BAR; PG8_MMA(0, 0, At, B0); PG8_MMA(0, 1, At, B1); PG8_BAR; PG8_SCHED;
            PG8_LDA(At, 0, 1); PG8_STAGE(PG8_SB(0, 0), b2, voffBx); PG8_STAGE(PG8_SB(0, 1), b2 + hstepBx, voffBx); PG8_STAGE(PG8_SA(0, 0), a2, voffAx);
            PG8_WAIT_V(8); PG8_WAIT_L(0); PG8_BAR; PG8_MMA(1, 0, At, B0); PG8_MMA(1, 1, At, B1); PG8_BAR; PG8_SCHED;
            PG8_LDB(B0, 1, 0); PG8_LDB(B1, 1, 1); PG8_SCHED; PG8_LDA(At, 1, 0); PG8_STAGE(PG8_SA(0, 1), a2 + hstepAx, voffAx);
            PG8_WAIT_V(8); PG8_WAIT_L(0); PG8_BAR; PG8_MMA(0, 0, At, B0); PG8_MMA(0, 1, At, B1); PG8_BAR; PG8_SCHED;
            PG8_LDA(At, 1, 1); PG8_STAGE(PG8_SB(1, 0), b3, voffBx); PG8_STAGE(PG8_SB(1, 1), b3 + hstepBx, voffBx); PG8_STAGE(PG8_SA(1, 0), a3, voffAx);
            PG8_WAIT_V(8); PG8_WAIT_L(0); PG8_BAR; PG8_MMA(1, 0, At, B0); PG8_MMA(1, 1, At, B1); PG8_BAR; PG8_SCHED;
            } else {
            PG8_LDB(B0, 0, 0); PG8_SCHED; PG8_LDA(At, 0, 0); PG8_STAGE(PG8_SA(1, 1), a1 + hstepA, voffA);
            PG8_WAIT_L(8); PG8_BAR; PG8_WAIT_L(0); PG8_MMA(0, 0, At, B0); PG8_BAR; PG8_SCHED;
            PG8_LDB(B1, 0, 1); PG8_STAGE(PG8_SB(0, 0), b2, voffB);
            PG8_BAR; PG8_WAIT_L(0); PG8_MMA(0, 1, At, B1); PG8_BAR;
            PG8_LDA(At, 0, 1); PG8_STAGE(PG8_SA(0, 0), a2, voffA);
            PG8_BAR; PG8_WAIT_L(0); PG8_MMA(1, 0, At, B0); PG8_BAR; PG8_SCHED;
            PG8_STAGE(PG8_SB(0, 1), b2 + hstepB, voffB);
            PG8_WAIT_V(6); PG8_BAR; PG8_MMA(1, 1, At, B1); PG8_BAR;
            PG8_LDB(B0, 1, 0); PG8_SCHED; PG8_LDA(At, 1, 0); PG8_STAGE(PG8_SA(0, 1), a2 + hstepA, voffA);
            PG8_WAIT_L(8); PG8_BAR; PG8_WAIT_L(0); PG8_MMA(0, 0, At, B0); PG8_BAR; PG8_SCHED;
            PG8_LDB(B1, 1, 1); PG8_STAGE(PG8_SB(1, 0), b3, voffB);
            PG8_BAR; PG8_WAIT_L(0); PG8_MMA(0, 1, At, B1); PG8_BAR;
            PG8_LDA(At, 1, 1); PG8_STAGE(PG8_SA(1, 0), a3, voffA);
            PG8_BAR; PG8_WAIT_L(0); PG8_MMA(1, 0, At, B0); PG8_BAR; PG8_SCHED;
            PG8_STAGE(PG8_SB(1, 1), b3 + hstepB, voffB);
            PG8_WAIT_V(6); PG8_BAR; PG8_MMA(1, 1, At, B1); PG8_BAR;
            }
        }
        if constexpr (ALIGN_EPI) { if (wr == 0) PG8_BAR; }
        { int fr_ = fr, fq_ = fq, wr_ = wr, wc_ = wc; asm volatile("" : "+v"(fr_), "+v"(fq_), "+s"(wr_), "+s"(wc_));
          E(acc, cur, wr_, wc_, fr_, fq_); }
        S.done(cur);
        if (!has_next) break;
#pragma unroll
        for (int a = 0; a < 2; ++a)
#pragma unroll
            for (int b = 0; b < 2; ++b)
#pragma unroll
                for (int m = 0; m < 4; ++m)
#pragma unroll
                    for (int n = 0; n < 2; ++n) acc[a][b][m][n] = (f32x4){0.f, 0.f, 0.f, 0.f};
        cur = nxt; cA = nA; cB = nB; ++ui;
        if constexpr (VARK) { voffA[0] = PG8_SEL(cur.k2, voffA0[0], voffA1[0]); voffA[1] = PG8_SEL(cur.k2, voffA0[1], voffA1[1]); voffB[0] = PG8_SEL(cur.k2, voffB0[0], voffB1[0]); voffB[1] = PG8_SEL(cur.k2, voffB0[1], voffB1[1]);
            hstepA = PG8_SEL(cur.k2, hstepA0, hstepA1); hstepB = PG8_SEL(cur.k2, hstepB0, hstepB1); nt = PG8_SEL(cur.k2, K, K1) / BK; }
        if constexpr (ALIGN_EPI) { if (wr == 1) PG8_BAR; }
    }
    PG8_WAIT_V(0);
    if constexpr (!ALIGN_EPI) { if (wr == 0) PG8_BAR; }
    PG8_BAR;
#undef PG8_SEL
#undef PG8_SA
#undef PG8_SB
#undef PG8_STAGE
#undef PG8_LDA
#undef PG8_LDB
#undef PG8_MMA
#undef PG8_WAIT_V
#undef PG8_WAIT_L
#undef PG8_BAR
#undef PG8_SCHED
}
}
constexpr int D = 1024, NB = 2, S = 8192, CTX = 256, NTOK = NB * S, NCTX = NB * CTX, NALL = NTOK + NCTX;
constexpr int DIN = 3328;
constexpr int NH = 8, NKV = 2, HD = 64, DSSM = 512, NG = 32, GS = 16, NST = 64, TC = 32;
constexpr int NE = 32, DE = 512;
constexpr int NCH = 768;
constexpr int NCHV = 528;
constexpr float C2 = 0.125f * 1.4426950408889634f;
constexpr float LOG2E = 1.4426950408889634f;
constexpr int NWAVES = 8;
constexpr int MAXROWS = 41984;

constexpr size_t MiB = 1u << 20;
constexpr size_t WS_CTL = 0, CTL_ZERO_BYTES = 1 * MiB;
constexpr size_t WS_SMALL = 1 * MiB;
constexpr size_t SM_MOD = WS_SMALL + 0;
constexpr size_t SM_ROPE = WS_SMALL + 0x30000;
constexpr size_t SM_WRT = WS_SMALL + 0x40000;
constexpr size_t SM_SSMTAB = WS_SMALL + 0x90000;
constexpr size_t SM_RE = WS_SMALL + 0xC0000;
constexpr size_t SM_RW = SM_RE + (size_t)NALL * 8;
constexpr size_t SM_RSLOT = SM_RW + (size_t)NALL * 8;
constexpr size_t SM_RDEST = SM_RSLOT + (size_t)NALL * 8;
constexpr size_t SM_RWS = SM_RDEST + (size_t)NALL * 8;
static_assert(SM_RWS + (size_t)MAXROWS * 4 <= 8 * MiB, "small region");
constexpr size_t WS_W = 8 * MiB;
constexpr size_t W_IN = WS_W, W_GLU = W_IN + (size_t)DIN * D * 2, W_BRA = W_GLU + 512 * 512 * 2, W_BRS = W_BRA + 1024 * 512 * 2, W_OUT = W_BRS + 1024 * 512 * 2;
constexpr size_t W_S3 = W_OUT + 1024 * 1024 * 2, W_SE = W_S3 + (size_t)NG * 512 * 768 * 2, W_GU = W_SE + (size_t)NG * 256 * 512 * 2, W_DN = W_GU + (size_t)NE * 1024 * 1024 * 2;
constexpr size_t WS_XC = W_DN + (size_t)NE * 1024 * 512 * 2;
static_assert(WS_XC == 147 * MiB, "weights region");
constexpr size_t WS_H = WS_XC + (size_t)NALL * D * 4;
constexpr size_t WS_BIG = WS_H + (size_t)NALL * D * 2;
constexpr size_t B_Q = WS_BIG, B_K = B_Q + (size_t)NALL * 512 * 2, B_VT = B_K + (size_t)NALL * 128 * 2, B_A3 = B_VT + (size_t)NALL * 128 * 2;
constexpr size_t B_GA = B_A3 + (size_t)NG * NCH * 768 * 2, B_GS = B_GA + (size_t)NALL * D * 2, B_ATT = B_GS + (size_t)NALL * D * 2, B_SEND = B_ATT + (size_t)NALL * 512 * 2;
constexpr size_t B_Z = B_SEND + (size_t)NG * NCH * 256 * 4, B_SG = B_Z + (size_t)NALL * 512 * 2, B_T1 = B_SG + (size_t)NALL * 512 * 2, B_MB = B_T1 + (size_t)NALL * D * 2;
constexpr size_t B_END1 = B_MB + (size_t)NALL * D * 2;
constexpr size_t B_HS = WS_BIG, B_ACT = B_HS + (size_t)MAXROWS * D * 2, B_YE = B_ACT + (size_t)MAXROWS * DE * 2, B_END2 = B_YE + (size_t)MAXROWS * D * 2;
constexpr size_t WS_END = 544 * MiB;
static_assert(B_END1 <= WS_END && B_END2 <= WS_END, "d_ws map");
constexpr int CW_TMO = 0, CW_CODE = 1;
constexpr int CW_BAR = 4096;
constexpr int CW_CNT = 8192;
constexpr int CW_WORK = 8448;

constexpr int LDS_BYTES = 147456;
constexpr int LDSCTL_OFF = 143360;
constexpr int L_BARST = LDSCTL_OFF + 32;
constexpr int L_MOETAB = LDSCTL_OFF + 256;
constexpr int L_WGCNT = LDSCTL_OFF + 1024;
constexpr int L_MISC = LDSCTL_OFF + 2048;

#define GAS __attribute__((address_space(1)))
#define LAS __attribute__((address_space(3)))
typedef unsigned short bf16;
typedef unsigned v4u __attribute__((ext_vector_type(4)));
typedef unsigned v2u __attribute__((ext_vector_type(2)));
typedef float f32x4 __attribute__((ext_vector_type(4)));
typedef float f32x16 __attribute__((ext_vector_type(16)));
typedef short bf16x8 __attribute__((ext_vector_type(8)));
typedef short bf16x4 __attribute__((ext_vector_type(4)));
typedef GAS unsigned gu32;
#define RLX_AGENT __ATOMIC_RELAXED, __HIP_MEMORY_SCOPE_AGENT
#define LDS_WAIT() asm volatile("s_waitcnt lgkmcnt(0)" ::: "memory")
#define VM_WAIT() asm volatile("s_waitcnt vmcnt(0)" ::: "memory")
using pg8::cvt_pk_bf16; using pg8::bf_lo; using pg8::bf_hi;
__device__ __forceinline__ float sigmoid_f(float x) { return __builtin_amdgcn_rcpf(1.f + __expf(-x)); }
__device__ __forceinline__ float gelu_tanh_f(float x) {
    const float u = 0.7978845608028654f * (x + 0.044715f * x * x * x);
    return x * sigmoid_f(2.f * u);
}

#define XB_TMO      128
#define XB_XCNT(j)  (256  + 64 * (j))
#define XB_XSUB(j)  (1280 + 64 * (j))
#define XB_XGEN(j)  (2304 + 64 * (j))
#define XB_TOP      3328
#define XB_TOPGEN   3392
#define XCD_BAR_WORDS 3456
#define XB_SPIN_CAP (1u << 18)
__device__ __forceinline__ unsigned xb_ld(unsigned* p)              { return __hip_atomic_load(p, __ATOMIC_RELAXED, __HIP_MEMORY_SCOPE_AGENT); }
__device__ __forceinline__ unsigned xb_add(unsigned* p, unsigned v) { return __hip_atomic_fetch_add(p, v, __ATOMIC_RELAXED, __HIP_MEMORY_SCOPE_AGENT); }
__device__ __forceinline__ unsigned xb_xcc_id() { return (unsigned)__builtin_amdgcn_s_getreg((3 << 11) | 20) & 0xFu; }
#define XB_SPIN(cond, bar) do { unsigned _sp = 0; while (cond) { __builtin_amdgcn_s_sleep(1); \
    if ((++_sp & 255u) == 0u) { if (xb_ld(&(bar)[XB_TMO])) break; if (_sp > XB_SPIN_CAP) { atomicAdd(&(bar)[XB_TMO], 1u); break; } } } } while (0)
struct XcdBarrier { unsigned* bar; unsigned x; volatile LAS unsigned* st; };
__device__ __forceinline__ XcdBarrier xcd_barrier_post(unsigned* bar, volatile LAS unsigned* st) {
    XcdBarrier b; b.bar = bar; b.x = xb_xcc_id(); b.st = st;
    if (threadIdx.x == 0) (void)xb_add(&bar[XB_XCNT(b.x)], 1u);
    return b;
}
__device__ __forceinline__ void xcd_barrier_complete(unsigned* bar, unsigned x, unsigned& nloc, unsigned& nx) {
    const unsigned G = gridDim.x * gridDim.y * gridDim.z;
    unsigned sum, cnt, mine, sp = 0u;
    for (;;) {
        sum = 0u; cnt = 0u; mine = 0u;
#pragma unroll 1
        for (unsigned j = 0; j < 16; ++j) { const unsigned c = xb_ld(&bar[XB_XCNT(j)]); sum += c; cnt += (c > 0u) ? 1u : 0u; mine = (j == x) ? c : mine; }
        if (sum == G) break;
        __builtin_amdgcn_s_sleep(1);
        if ((++sp & 255u) == 0u) { if (xb_ld(&bar[XB_TMO])) break; if (sp > XB_SPIN_CAP) { atomicAdd(&bar[XB_TMO], 1u); break; } }
    }
    nloc = mine > 0u ? mine : 1u; nx = cnt > 0u ? cnt : 1u;
}
__device__ __forceinline__ void xcd_barrier(const XcdBarrier& b) {
    asm volatile("s_waitcnt vmcnt(0)" ::: "memory");
    __syncthreads();
    if (threadIdx.x == 0) {
        unsigned* bar = b.bar;
        __builtin_amdgcn_s_waitcnt(0);
        unsigned nloc = b.st[0], nx = b.st[1];
        if (nloc == 0u) { xcd_barrier_complete(bar, b.x, nloc, nx); b.st[0] = nloc; b.st[1] = nx; }
        const unsigned old = xb_add(&bar[XB_XSUB(b.x)], 1u);
        const unsigned gen = old / nloc;
        if (old + 1u == (gen + 1u) * nloc) {
            __builtin_amdgcn_fence(__ATOMIC_RELEASE, "agent");
            asm volatile("s_waitcnt vmcnt(0)" ::: "memory");
            const unsigned og = xb_add(&bar[XB_TOP], 1u);
            const unsigned tg = og / nx;
            if (og + 1u == (tg + 1u) * nx) xb_add(&bar[XB_TOPGEN], 1u);
            else XB_SPIN(xb_ld(&bar[XB_TOPGEN]) == tg, bar);
            __builtin_amdgcn_fence(__ATOMIC_ACQUIRE, "agent");
            xb_add(&bar[XB_XGEN(b.x)], 1u);
            asm volatile("s_waitcnt vmcnt(0)" ::: "memory");
        } else {
            XB_SPIN(xb_ld(&bar[XB_XGEN(b.x)]) == gen, bar);
            __builtin_amdgcn_fence(__ATOMIC_ACQUIRE, "agent");
            asm volatile("s_waitcnt vmcnt(0)" ::: "memory");
        }
    }
    __syncthreads();
}

struct Inputs {
    const float *x, *c, *ctx, *c_ctx, *w_mod, *b_mod, *g1, *g2, *w_in, *sink, *lam_re, *lam_im, *log_dt, *sb_re, *sb_im, *sc_re, *sc_im, *ssm_d,
        *w_glu, *w_bra, *w_brs, *w_out, *w_rg, *w_re, *w_eg, *w_eu, *w_ed, *g_final;
};
struct Frame {
    LAS unsigned char* lds;
    gu32* ctl;
    unsigned char* ws;
    int tid, lane, wave;
    int vcu, G;
    float* out;
};
__device__ __forceinline__ float row16_sum(float v) {
    v += __uint_as_float((unsigned)__builtin_amdgcn_update_dpp(0, (int)__float_as_uint(v), 0x128, 0xf, 0xf, false));
    v += __uint_as_float((unsigned)__builtin_amdgcn_update_dpp(0, (int)__float_as_uint(v), 0x124, 0xf, 0xf, false));
    v += __uint_as_float((unsigned)__builtin_amdgcn_update_dpp(0, (int)__float_as_uint(v), 0x122, 0xf, 0xf, false));
    v += __uint_as_float((unsigned)__builtin_amdgcn_update_dpp(0, (int)__float_as_uint(v), 0x121, 0xf, 0xf, false));
    return v; }
__device__ __forceinline__ float swap32_sum(float lo_keep, float hi_keep) {
    auto r = __builtin_amdgcn_permlane32_swap(__float_as_uint(lo_keep), __float_as_uint(hi_keep), false, false); return __uint_as_float(r[0]) + __uint_as_float(r[1]); }
__device__ __forceinline__ float swap16_sum(float even_keep, float odd_keep) {
    auto r = __builtin_amdgcn_permlane16_swap(__float_as_uint(even_keep), __float_as_uint(odd_keep), false, false); return __uint_as_float(r[0]) + __uint_as_float(r[1]); }
__device__ __forceinline__ float wave_sum(float v) { v = row16_sum(v); v = swap16_sum(v, v); return swap32_sum(v, v); }
__device__ __forceinline__ int which_of_row(int r) { return r < NTOK ? (r >> 13) : 2; }
__device__ __forceinline__ unsigned f2bf_rne(float f) { unsigned u = __builtin_bit_cast(unsigned, f); return (u + 0x7fffu + ((u >> 16) & 1u)) >> 16; }
__device__ __forceinline__ unsigned pk2(float lo, float hi) { return f2bf_rne(lo) | (f2bf_rne(hi) << 16); }
typedef float f32x2g __attribute__((ext_vector_type(2)));
__device__ __forceinline__ void transpose_item(const float* W, int K, int N, bf16* WT, int mode, int item, int lane) {
    const int nblk = N / 128, kb = item / nblk, nb = item % nblk, k0 = 64 * kb, n = 128 * nb + 2 * lane;
    const int row = mode == 0 ? n : (8 * (n >> 2) + (n & 3) + (mode == 2 ? 4 : 0));
    const float* wp = W + (size_t)k0 * N + n;
    f32x2g v[64];
#pragma unroll
    for (int j = 0; j < 64; ++j) v[j] = __builtin_nontemporal_load((const f32x2g*)(wp + (size_t)j * N));
    GAS v4u* op0 = (GAS v4u*)(WT + (size_t)row * K + k0); GAS v4u* op1 = (GAS v4u*)(WT + (size_t)(row + 1) * K + k0);
#pragma unroll
    for (int q = 0; q < 8; ++q) { v4u o; o.x = cvt_pk_bf16(v[8 * q].x, v[8 * q + 1].x); o.y = cvt_pk_bf16(v[8 * q + 2].x, v[8 * q + 3].x); o.z = cvt_pk_bf16(v[8 * q + 4].x, v[8 * q + 5].x); o.w = cvt_pk_bf16(v[8 * q + 6].x, v[8 * q + 7].x); op0[q] = o; }
#pragma unroll
    for (int q = 0; q < 8; ++q) { v4u o; o.x = cvt_pk_bf16(v[8 * q].y, v[8 * q + 1].y); o.y = cvt_pk_bf16(v[8 * q + 2].y, v[8 * q + 3].y); o.z = cvt_pk_bf16(v[8 * q + 4].y, v[8 * q + 5].y); o.w = cvt_pk_bf16(v[8 * q + 6].y, v[8 * q + 7].y); op1[q] = o; }
}
constexpr int CV_IN = (D / 64) * (DIN / 128), CV_GLU = 8 * 4, CV_BR = 8 * 8, CV_OUT = 16 * 8, CV_G1 = 16 * 4, CV_D1 = 8 * 8;
constexpr int CV_TOTAL = CV_IN + CV_GLU + 2 * CV_BR + CV_OUT + NE * (2 * CV_G1 + CV_D1);
__device__ __forceinline__ void convert_item(const Inputs& I, unsigned char* ws, int l, int it, int lane) {
    int r = it;
    if (r < NE * CV_G1) { const int e = r / CV_G1; transpose_item(I.w_eg + ((size_t)l * NE + e) * D * DE, D, DE, (bf16*)(ws + W_GU) + (size_t)e * 1024 * 1024, 1, r % CV_G1, lane); return; } r -= NE * CV_G1;
    if (r < NE * CV_G1) { const int e = r / CV_G1; transpose_item(I.w_eu + ((size_t)l * NE + e) * D * DE, D, DE, (bf16*)(ws + W_GU) + (size_t)e * 1024 * 1024, 2, r % CV_G1, lane); return; } r -= NE * CV_G1;
    if (r < NE * CV_D1) { const int e = r / CV_D1; transpose_item(I.w_ed + ((size_t)l * NE + e) * DE * D, DE, D, (bf16*)(ws + W_DN) + (size_t)e * 1024 * 512, 0, r % CV_D1, lane); return; } r -= NE * CV_D1;
    if (r < CV_IN) { transpose_item(I.w_in + (size_t)l * D * DIN, D, DIN, (bf16*)(ws + W_IN), 0, r, lane); return; } r -= CV_IN;
    if (r < CV_GLU) { transpose_item(I.w_glu + (size_t)l * 512 * 512, 512, 512, (bf16*)(ws + W_GLU), 0, r, lane); return; } r -= CV_GLU;
    if (r < CV_BR) { transpose_item(I.w_bra + (size_t)l * 512 * D, 512, D, (bf16*)(ws + W_BRA), 0, r, lane); return; } r -= CV_BR;
    if (r < CV_BR) { transpose_item(I.w_brs + (size_t)l * 512 * D, 512, D, (bf16*)(ws + W_BRS), 0, r, lane); return; } r -= CV_BR;
    transpose_item(I.w_out + (size_t)l * D * D, D, D, (bf16*)(ws + W_OUT), 0, r, lane);
}
__device__ __forceinline__ void convert_weights(Frame& F, const Inputs& I, int l) {
    if (F.vcu < NG) return;
    const int gw = (F.vcu - NG) * NWAVES + F.wave, NGW = (F.G - NG) * NWAVES;
    for (int r = 0, base = 0; base < CV_TOTAL; ++r, base += NGW) {
        const int it = base + ((r & 1) ? (NGW - 1 - gw) : gw);
        if (it < CV_TOTAL) convert_item(I, F.ws, l, it, F.lane);
    }
}

__device__ __forceinline__ void ssm_cs(float li, float dt, int tau, float& c, float& s) {
    const double x = (double)tau * ((double)li * (double)dt);
    const double k = __builtin_rint(x * 0.15915494309189535);
    const float r = (float)(x - k * 6.283185307179586);
    c = cosf(r); s = sinf(r);
}
constexpr int APS = 130;
__device__ __forceinline__ void ssmgen_job(Frame& F, const Inputs& I, int l, int g) {
    LAS float* Kt = (LAS float*)(F.lds);
    LAS float* apw = (LAS float*)(F.lds + 65536);
    LAS float* Bb = (LAS float*)(F.lds + 99872);
    LAS float* Ct = (LAS float*)(F.lds + 116256);
    const int tid = F.tid, lane = tid & 63, wave = tid >> 6;
    __syncthreads();
    if (tid < 128) {
        const int dir = tid >> 6, p = tid & 63, pg = (l * 2 + dir) * NG + g;
        const float lr = I.lam_re[pg * NST + p], li = I.lam_im[pg * NST + p], dt = expf(I.log_dt[pg]);
        float c1, s1; ssm_cs(li, dt, 1, c1, s1);
        const float mag = expf(lr * dt), sh = sinf(0.5f * li * dt);
        const float aim = mag * s1, nr = expm1f(lr * dt) * c1 - 2.f * sh * sh, den = lr * lr + li * li;
        const float fre = (nr * lr + aim * li) / den, fim = (aim * lr - nr * li) / den;
#pragma unroll 4
        for (int m = 0; m < 16; ++m) {
            const float br = I.sb_re[((size_t)pg * NST + p) * GS + m], bi = I.sb_im[((size_t)pg * NST + p) * GS + m];
            Bb[((dir * 64 + p) * 16 + m) * 2 + 0] = fre * br - fim * bi;
            Bb[((dir * 64 + p) * 16 + m) * 2 + 1] = fre * bi + fim * br;
            Ct[((dir * 64 + p) * 16 + m) * 2 + 0] = I.sc_re[((size_t)pg * GS + m) * NST + p];
            Ct[((dir * 64 + p) * 16 + m) * 2 + 1] = I.sc_im[((size_t)pg * GS + m) * NST + p];
        }
        float* tab = (float*)(F.ws + SM_SSMTAB);
        float c32, s32; ssm_cs(li, dt, 32, c32, s32);
        const float m32 = expf(32.f * lr * dt), a32r = m32 * c32, a32i = m32 * s32;
        float pr = a32r, pi = a32i;
#pragma unroll
        for (int q = 0; q < 5; ++q) { const float nr2 = pr * pr - pi * pi, ni2 = 2.f * pr * pi; pr = nr2; pi = ni2; }
        const float sr = pr * a32r - pi * a32i, si = pr * a32i + pi * a32r;
        const size_t ti = ((((size_t)l * NG + g) * 2 + dir) * 64 + p) * 2;
        tab[ti] = a32r; tab[ti + 1] = a32i; tab[16384 + ti] = sr; tab[16384 + ti + 1] = si;
    }
    for (int idx = tid; idx < 2 * 33 * 64; idx += 512) {
        const int p = idx & 63, tau = (idx >> 6) % 33, dir = idx / (33 * 64), pg = (l * 2 + dir) * NG + g;
        const float lr = I.lam_re[pg * NST + p], li = I.lam_im[pg * NST + p], dt = expf(I.log_dt[pg]);
        float c, sn; ssm_cs(li, dt, tau, c, sn);
        const float mg = expf((float)tau * lr * dt);
        apw[(dir * 33 + tau) * APS + p * 2] = mg * c; apw[(dir * 33 + tau) * APS + p * 2 + 1] = mg * sn;
    }
    __syncthreads();
    for (int idx = tid; idx < 1024; idx += 512) {
        const int dir = idx >> 9, tau = (idx >> 4) & 31, mp = idx & 15;
        float acc[16];
#pragma unroll
        for (int m = 0; m < 16; ++m) acc[m] = 0.f;
        for (int p = 0; p < 64; ++p) {
            const float ar = apw[(dir * 33 + tau) * APS + p * 2], ai = apw[(dir * 33 + tau) * APS + p * 2 + 1];
            const float br = Bb[((dir * 64 + p) * 16 + mp) * 2], bi = Bb[((dir * 64 + p) * 16 + mp) * 2 + 1];
            const float tr = ar * br - ai * bi, ti = ar * bi + ai * br;
            const LAS f32x4* cp = (const LAS f32x4*)(Ct + (dir * 64 + p) * 32);
#pragma unroll
            for (int q = 0; q < 8; ++q) { const f32x4 cv = cp[q]; acc[2 * q] += cv.x * tr - cv.y * ti; acc[2 * q + 1] += cv.z * tr - cv.w * ti; }
        }
#pragma unroll
        for (int m = 0; m < 16; ++m) Kt[((dir * 16 + m) * 32 + tau) * 16 + mp] = acc[m];
    }
    __syncthreads();
    bf16* W3 = (bf16*)(F.ws + W_S3) + (size_t)g * 512 * 768;
    const float* dsk = I.ssm_d + l * DSSM + g * 16;
    for (int n = wave; n < 512; n += 8) {
        const int t = n >> 4, m = n & 15;
        {
            const int s_ = lane >> 1, mp0 = (lane & 1) * 8;
            float v[8];
            if (s_ != t) { const int dir = s_ < t ? 0 : 1, tau = s_ < t ? t - s_ : s_ - t; const LAS f32x4* kp = (const LAS f32x4*)(Kt + ((dir * 16 + m) * 32 + tau) * 16 + mp0);
                const f32x4 a = kp[0], b = kp[1]; v[0] = a.x; v[1] = a.y; v[2] = a.z; v[3] = a.w; v[4] = b.x; v[5] = b.y; v[6] = b.z; v[7] = b.w; }
            else { const LAS f32x4* k0p = (const LAS f32x4*)(Kt + ((0 * 16 + m) * 32 + 0) * 16 + mp0); const LAS f32x4* k1p = (const LAS f32x4*)(Kt + ((1 * 16 + m) * 32 + 0) * 16 + mp0); const float dv = dsk[m];
                const f32x4 a = k0p[0] + k1p[0], b = k0p[1] + k1p[1]; v[0] = a.x; v[1] = a.y; v[2] = a.z; v[3] = a.w; v[4] = b.x; v[5] = b.y; v[6] = b.z; v[7] = b.w;
#pragma unroll
                for (int j = 0; j < 8; ++j) v[j] += (mp0 + j) == m ? dv : 0.f; }
            v4u o; o.x = cvt_pk_bf16(v[0], v[1]); o.y = cvt_pk_bf16(v[2], v[3]); o.z = cvt_pk_bf16(v[4], v[5]); o.w = cvt_pk_bf16(v[6], v[7]);
            *(GAS v4u*)(W3 + (size_t)n * 768 + lane * 8) = o;
        }
        if (lane < 32) {
            const int dir = lane >> 4, ri = (lane >> 3) & 1, p0 = (lane & 7) * 8, tw = dir == 0 ? t + 1 : 32 - t, pg = (l * 2 + dir) * NG + g;
            const GAS f32x4* crp = (const GAS f32x4*)(I.sc_re + ((size_t)pg * GS + m) * NST + p0); const GAS f32x4* cip = (const GAS f32x4*)(I.sc_im + ((size_t)pg * GS + m) * NST + p0);
            const f32x4 cr0 = crp[0], cr1 = crp[1], ci0 = cip[0], ci1 = cip[1];
            const float crv[8] = {cr0.x, cr0.y, cr0.z, cr0.w, cr1.x, cr1.y, cr1.z, cr1.w}, civ[8] = {ci0.x, ci0.y, ci0.z, ci0.w, ci1.x, ci1.y, ci1.z, ci1.w};
            float v[8];
#pragma unroll
            for (int j = 0; j < 8; ++j) { const float ar = apw[(dir * 33 + tw) * APS + (p0 + j) * 2], ai = apw[(dir * 33 + tw) * APS + (p0 + j) * 2 + 1];
                v[j] = ri == 0 ? (crv[j] * ar - civ[j] * ai) : -(crv[j] * ai + civ[j] * ar); }
            v4u o; o.x = cvt_pk_bf16(v[0], v[1]); o.y = cvt_pk_bf16(v[2], v[3]); o.z = cvt_pk_bf16(v[4], v[5]); o.w = cvt_pk_bf16(v[6], v[7]);
            *(GAS v4u*)(W3 + (size_t)n * 768 + 512 + lane * 8) = o;
        }
    }
    bf16* E = (bf16*)(F.ws + W_SE) + (size_t)g * 256 * 512;
    for (int n = wave; n < 256; n += 8) {
        const int dir = n >> 7, ri = (n >> 6) & 1, p = n & 63, s_ = lane >> 1, mp0 = (lane & 1) * 8, te = dir == 0 ? 31 - s_ : s_;
        const float ar = apw[(dir * 33 + te) * APS + p * 2], ai = apw[(dir * 33 + te) * APS + p * 2 + 1];
        float v[8];
#pragma unroll
        for (int j = 0; j < 8; ++j) { const float br = Bb[((dir * 64 + p) * 16 + mp0 + j) * 2], bi = Bb[((dir * 64 + p) * 16 + mp0 + j) * 2 + 1];
            v[j] = ri == 0 ? (ar * br - ai * bi) : (ar * bi + ai * br); }
        v4u o; o.x = cvt_pk_bf16(v[0], v[1]); o.y = cvt_pk_bf16(v[2], v[3]); o.z = cvt_pk_bf16(v[4], v[5]); o.w = cvt_pk_bf16(v[6], v[7]);
        *(GAS v4u*)(E + (size_t)n * 512 + lane * 8) = o;
    }
    __syncthreads();
}

__device__ __forceinline__ void mod_item(Frame& F, const Inputs& I, int item) {
    LAS float* sl = (LAS float*)(F.lds);
    LAS float* part = (LAS float*)(F.lds + 16384);
    __syncthreads();
    for (int i = F.tid; i < 3 * 1024; i += 512) { const int w = i >> 10, k = i & 1023; const float v = w < 2 ? I.c[w * D + k] : I.c_ctx[k]; sl[i] = v / (1.f + expf(-v)); }
    __syncthreads();
    const int l = item / 96, cb = item % 96, col = cb * 64 + F.lane;
    const float* W = I.w_mod + (size_t)l * D * 6144;
    float a0 = 0.f, a1 = 0.f, a2 = 0.f;
#pragma unroll 16
    for (int kk = 0; kk < 128; ++kk) { const int k = F.wave * 128 + kk; const float wv = W[(size_t)k * 6144 + col]; a0 += sl[k] * wv; a1 += sl[1024 + k] * wv; a2 += sl[2048 + k] * wv; }
    part[(F.wave * 3 + 0) * 64 + F.lane] = a0; part[(F.wave * 3 + 1) * 64 + F.lane] = a1; part[(F.wave * 3 + 2) * 64 + F.lane] = a2;
    __syncthreads();
    if (F.tid < 192) { const int w = F.tid >> 6, c = F.tid & 63; float s = 0.f;
#pragma unroll
        for (int v = 0; v < 8; ++v) s += part[(v * 3 + w) * 64 + c];
        ((float*)(F.ws + SM_MOD))[(l * 3 + w) * 6144 + cb * 64 + c] = s + I.b_mod[l * 6144 + cb * 64 + c]; }
    __syncthreads();
}
__device__ __forceinline__ void p0_small(Frame& F, const Inputs& I) {
    const int b = F.vcu - 224;
    if (b < 0) return;
    const int t = b * 512 + F.tid, NT = 32 * 512;
    float* rope = (float*)(F.ws + SM_ROPE);
    for (int i = t; i < 128 * 16; i += NT) { const int pos = i >> 4, j = i & 15; const float freq = exp2f(-(float)j * (13.287712379549449f / 16.f)); const float ang = (float)pos * freq;
        const double x = (double)ang; const double k = __builtin_rint(x * 0.15915494309189535); const float r = (float)(x - k * 6.283185307179586);
        rope[i] = cosf(r); rope[2048 + i] = sinf(r); }
    float* wrt = (float*)(F.ws + SM_WRT);
    for (int i = t; i < 2 * 36 * 1024; i += NT) { const int k = i & 1023, j = (i >> 10) % 36, l = i / (36 * 1024);
        wrt[i] = j < 4 ? I.w_rg[((size_t)l * D + k) * 4 + j] : I.w_re[((size_t)l * D + k) * 32 + (j - 4)]; }
}
struct RowVec { f32x4 v[4]; };
__device__ __forceinline__ RowVec load_row_f32(const float* p, int lane) { RowVec r; const GAS f32x4* q = (const GAS f32x4*)p + lane;
#pragma unroll
    for (int j = 0; j < 4; ++j) r.v[j] = q[64 * j]; return r; }
__device__ __forceinline__ void store_row_f32(float* p, int lane, const RowVec& r) { GAS f32x4* q = (GAS f32x4*)p + lane;
#pragma unroll
    for (int j = 0; j < 4; ++j) q[64 * j] = r.v[j]; }
__device__ __forceinline__ RowVec load_row_bf16(const bf16* p, int lane) { RowVec r; const GAS v2u* q = (const GAS v2u*)p + lane;
#pragma unroll
    for (int j = 0; j < 4; ++j) { const v2u w = q[64 * j]; r.v[j] = (f32x4){bf_lo(w.x), bf_hi(w.x), bf_lo(w.y), bf_hi(w.y)}; } return r; }
__device__ __forceinline__ void store_row_bf16(bf16* p, int lane, const RowVec& r) { GAS v2u* q = (GAS v2u*)p + lane;
#pragma unroll
    for (int j = 0; j < 4; ++j) { v2u w; w.x = cvt_pk_bf16(r.v[j].x, r.v[j].y); w.y = cvt_pk_bf16(r.v[j].z, r.v[j].w); q[64 * j] = w; } }
__device__ __forceinline__ float row_rinv(const RowVec& r) { float s = 0.f;
#pragma unroll
    for (int j = 0; j < 4; ++j) s += (r.v[j].x * r.v[j].x + r.v[j].y * r.v[j].y) + (r.v[j].z * r.v[j].z + r.v[j].w * r.v[j].w);
    return rsqrtf(wave_sum(s) * (1.f / D) + 1e-6f); }
__device__ __forceinline__ RowVec norm_mod(const RowVec& x, float rinv, const float* g, const float* shift, const float* scale, int lane) {
    RowVec o; const GAS f32x4* gp = (const GAS f32x4*)g + lane; const GAS f32x4* sh = (const GAS f32x4*)shift + lane; const GAS f32x4* sc = (const GAS f32x4*)scale + lane;
#pragma unroll
    for (int j = 0; j < 4; ++j) o.v[j] = x.v[j] * rinv * gp[64 * j] * (1.f + sc[64 * j]) + sh[64 * j];
    return o; }
__device__ __forceinline__ void moe_combine(RowVec& x, const bf16* ye, const int* rdest, int row, const float* gate, int lane) {
    const int d0 = rdest[row * 2], d1 = rdest[row * 2 + 1];
    const RowVec a = load_row_bf16(ye + (size_t)d0 * D, lane), b = load_row_bf16(ye + (size_t)d1 * D, lane);
    const GAS f32x4* gp = (const GAS f32x4*)gate + lane;
#pragma unroll
    for (int j = 0; j < 4; ++j) x.v[j] = x.v[j] + gp[64 * j] * (a.v[j] + b.v[j]);
}
__device__ __forceinline__ void phase_norm1(Frame& F, const Inputs& I, int l) {
    const int gw = F.vcu * NWAVES + F.wave, NGW = F.G * NWAVES;
    const float* mod = (const float*)(F.ws + SM_MOD);
    float* XC = (float*)(F.ws + WS_XC); bf16* H = (bf16*)(F.ws + WS_H);
    const bf16* YE = (const bf16*)(F.ws + B_YE); const int* RD = (const int*)(F.ws + SM_RDEST);
    for (int r0 = gw; r0 < NALL; r0 += 2 * NGW) {
        const int r1 = r0 + NGW; const bool two = r1 < NALL; const int r1c = two ? r1 : r0;
        RowVec x0, x1;
        if (l == 0) { x0 = load_row_f32(r0 < NTOK ? I.x + (size_t)r0 * D : I.ctx + (size_t)(r0 - NTOK) * D, F.lane); x1 = load_row_f32(r1c < NTOK ? I.x + (size_t)r1c * D : I.ctx + (size_t)(r1c - NTOK) * D, F.lane); }
        else {
            const int d00 = RD[r0 * 2], d01 = RD[r0 * 2 + 1], d10 = RD[r1c * 2], d11 = RD[r1c * 2 + 1];
            x0 = load_row_f32(XC + (size_t)r0 * D, F.lane); x1 = load_row_f32(XC + (size_t)r1c * D, F.lane);
            const RowVec a0 = load_row_bf16(YE + (size_t)d00 * D, F.lane), b0 = load_row_bf16(YE + (size_t)d01 * D, F.lane), a1 = load_row_bf16(YE + (size_t)d10 * D, F.lane), b1 = load_row_bf16(YE + (size_t)d11 * D, F.lane);
            const GAS f32x4* g0 = (const GAS f32x4*)(mod + (0 * 3 + which_of_row(r0)) * 6144 + 5 * D) + F.lane; const GAS f32x4* g1p = (const GAS f32x4*)(mod + (0 * 3 + which_of_row(r1c)) * 6144 + 5 * D) + F.lane;
#pragma unroll
            for (int j = 0; j < 4; ++j) { x0.v[j] = x0.v[j] + g0[64 * j] * (a0.v[j] + b0.v[j]); x1.v[j] = x1.v[j] + g1p[64 * j] * (a1.v[j] + b1.v[j]); }
            store_row_f32(XC + (size_t)r0 * D, F.lane, x0); if (two) store_row_f32(XC + (size_t)r1 * D, F.lane, x1);
        }
        const float ri0 = row_rinv(x0), ri1 = row_rinv(x1);
        const float* m0 = mod + (l * 3 + which_of_row(r0)) * 6144; const float* m1 = mod + (l * 3 + which_of_row(r1c)) * 6144;
        const RowVec h0 = norm_mod(x0, ri0, I.g1 + l * D, m0 + 0 * D, m0 + 1 * D, F.lane), h1 = norm_mod(x1, ri1, I.g1 + l * D, m1 + 0 * D, m1 + 1 * D, F.lane);
        store_row_bf16(H + (size_t)r0 * D, F.lane, h0); if (two) store_row_bf16(H + (size_t)r1 * D, F.lane, h1);
    }
}
__device__ __forceinline__ void phase_final(Frame& F, const Inputs& I) {
    const int gw = F.vcu * NWAVES + F.wave, NGW = F.G * NWAVES;
    const float* mod = (const float*)(F.ws + SM_MOD);
    const float* XC = (const float*)(F.ws + WS_XC);
    const bf16* YE = (const bf16*)(F.ws + B_YE); const int* RD = (const int*)(F.ws + SM_RDEST);
    for (int r0 = gw; r0 < NTOK; r0 += 2 * NGW) {
        const int r1 = r0 + NGW; const bool two = r1 < NTOK; const int r1c = two ? r1 : r0;
        const int d00 = RD[r0 * 2], d01 = RD[r0 * 2 + 1], d10 = RD[r1c * 2], d11 = RD[r1c * 2 + 1];
        RowVec x0 = load_row_f32(XC + (size_t)r0 * D, F.lane), x1 = load_row_f32(XC + (size_t)r1c * D, F.lane);
        const RowVec a0 = load_row_bf16(YE + (size_t)d00 * D, F.lane), b0 = load_row_bf16(YE + (size_t)d01 * D, F.lane), a1 = load_row_bf16(YE + (size_t)d10 * D, F.lane), b1 = load_row_bf16(YE + (size_t)d11 * D, F.lane);
        const GAS f32x4* g0 = (const GAS f32x4*)(mod + (1 * 3 + which_of_row(r0)) * 6144 + 5 * D) + F.lane; const GAS f32x4* g1p = (const GAS f32x4*)(mod + (1 * 3 + which_of_row(r1c)) * 6144 + 5 * D) + F.lane;
#pragma unroll
        for (int j = 0; j < 4; ++j) { x0.v[j] = x0.v[j] + g0[64 * j] * (a0.v[j] + b0.v[j]); x1.v[j] = x1.v[j] + g1p[64 * j] * (a1.v[j] + b1.v[j]); }
        const float ri0 = row_rinv(x0), ri1 = row_rinv(x1);
        RowVec o0, o1; const GAS f32x4* gp = (const GAS f32x4*)I.g_final + F.lane;
#pragma unroll
        for (int j = 0; j < 4; ++j) { o0.v[j] = x0.v[j] * ri0 * gp[64 * j]; o1.v[j] = x1.v[j] * ri1 * gp[64 * j]; }
        store_row_f32(F.out + (size_t)r0 * D, F.lane, o0); if (two) store_row_f32(F.out + (size_t)r1 * D, F.lane, o1);
    }
}

__device__ __forceinline__ void phase_norm2_route(Frame& F, const Inputs& I, int l, int dbgf = 0) {
    const int nrows = l == 0 ? NALL : NTOK, R = nrows / 256, row_base = F.vcu * R, nextra = R - 64;
    const float* mod = (const float*)(F.ws + SM_MOD);
    const float* XC = (const float*)(F.ws + WS_XC); bf16* H = (bf16*)(F.ws + WS_H);
    const float* wrt = (const float*)(F.ws + SM_WRT) + (size_t)l * 36 * 1024;
    volatile LAS int* lcnt = (volatile LAS int*)(F.lds + L_WGCNT);
    LAS float* wt = (LAS float*)(F.lds);
    LAS float* lg = (LAS float*)(F.lds + 131072 + F.wave * 1296);
    int* RE = (int*)(F.ws + SM_RE); float* RW = (float*)(F.ws + SM_RW); int* RSLOT = (int*)(F.ws + SM_RSLOT);
    __syncthreads();
    if (F.tid < 64) lcnt[F.tid] = 0;
    { const GAS f32x4* src = (const GAS f32x4*)(wrt + 4 * 1024); LAS f32x4* dst = (LAS f32x4*)wt;
#pragma unroll 8
      for (int i = F.tid; i < 32 * 256; i += 512) dst[i] = src[i]; }
    __syncthreads();
    const int ngroups = F.wave < nextra ? 3 : 2;
#pragma unroll 1
    for (int grp = 0; grp < ngroups; ++grp) {
        RowVec h[4];
        const int rfirst = row_base + (grp < 2 ? F.wave * 8 + grp * 4 : 64 + F.wave), rstep = grp < 2 ? 1 : 0;
#pragma unroll
        for (int rr = 0; rr < 4; ++rr) h[rr] = load_row_f32(XC + (size_t)(rfirst + rr * rstep) * D, F.lane);
        const float* ml = mod + (l * 3 + which_of_row(rfirst)) * 6144;
        RowVec gsc, gsh;
        { const GAS f32x4* gp = (const GAS f32x4*)(I.g2 + l * D) + F.lane; const GAS f32x4* sc = (const GAS f32x4*)(ml + 4 * D) + F.lane; const GAS f32x4* sh = (const GAS f32x4*)(ml + 3 * D) + F.lane;
#pragma unroll
          for (int j = 0; j < 4; ++j) { gsc.v[j] = gp[64 * j] * (1.f + sc[64 * j]); gsh.v[j] = sh[64 * j]; } }
#pragma unroll
        for (int rr = 0; rr < 4; ++rr) {
            const int r = rfirst + rr * rstep;
            const float rinv = row_rinv(h[rr]);
            if (which_of_row(r) == which_of_row(rfirst)) {
#pragma unroll
                for (int j = 0; j < 4; ++j) h[rr].v[j] = h[rr].v[j] * rinv * gsc.v[j] + gsh.v[j];
            } else { const float* m2 = mod + (l * 3 + which_of_row(r)) * 6144; h[rr] = norm_mod(h[rr], rinv, I.g2 + l * D, m2 + 3 * D, m2 + 4 * D, F.lane); }
            if (grp < 2 || rr == 0) store_row_bf16(H + (size_t)r * D, F.lane, h[rr]);
        }
#pragma unroll
        for (int j = 0; j < 4; ++j) { const GAS f32x4* wp = (const GAS f32x4*)(wrt + j * 1024) + F.lane; f32x4 wv[4];
#pragma unroll
            for (int q = 0; q < 4; ++q) wv[q] = wp[64 * q];
            float a_[4];
#pragma unroll
            for (int rr = 0; rr < 4; ++rr) { f32x4 s4 = h[rr].v[0] * wv[0]; s4 = s4 + h[rr].v[1] * wv[1]; s4 = s4 + h[rr].v[2] * wv[2]; s4 = s4 + h[rr].v[3] * wv[3]; a_[rr] = (s4.x + s4.y) + (s4.z + s4.w); }
            const float c20 = swap32_sum(a_[0], a_[2]), c21 = swap32_sum(a_[1], a_[3]); float c1 = swap16_sum(c20, c21); c1 = row16_sum(c1);
            if ((F.lane & 15) == 0) { const int rr = F.lane >> 4; if (grp < 2) lg[(grp * 4 + rr) * 36 + j] = c1; else if (rr == 0) lg[8 * 36 + j] = c1; } }
        LDS_WAIT(); asm volatile("" ::: "memory");
#pragma unroll
        for (int rr = 0; rr < 4; ++rr) {
            if (grp == 2 && rr > 0) break;
            const int lrow = grp < 2 ? grp * 4 + rr : 8;
            const LAS float* q = lg + lrow * 36;
            int gi = 0; float gm = q[0];
#pragma unroll
            for (int i = 1; i < 4; ++i) { const float v = q[i]; if (v > gm) { gm = v; gi = i; } }
            gi = __builtin_amdgcn_readfirstlane(gi);
            float a_[8];
#pragma unroll
            for (int e = 0; e < 8; ++e) { const LAS f32x4* wp = (const LAS f32x4*)(wt + (gi * 8 + e) * 1024) + F.lane;
                f32x4 s4 = h[rr].v[0] * wp[0]; s4 = s4 + h[rr].v[1] * wp[64]; s4 = s4 + h[rr].v[2] * wp[128]; s4 = s4 + h[rr].v[3] * wp[192]; a_[e] = (s4.x + s4.y) + (s4.z + s4.w); }
            const float c40 = swap32_sum(a_[0], a_[4]), c41 = swap32_sum(a_[1], a_[5]), c42 = swap32_sum(a_[2], a_[6]), c43 = swap32_sum(a_[3], a_[7]);
            float c20 = swap16_sum(c40, c42), c21 = swap16_sum(c41, c43);
            c20 = row16_sum(c20); c21 = row16_sum(c21);
            if ((F.lane & 15) == 0) { const int e0 = (F.lane >> 4) * 2; lg[lrow * 36 + 4 + e0] = c20; lg[lrow * 36 + 4 + e0 + 1] = c21; }
        }
    }
    LDS_WAIT(); asm volatile("" ::: "memory");
    int my_e0 = 0, my_e1 = 0, my_l0 = 0, my_l1 = 0, my_row = -1;
    if (F.lane < 8 || (F.lane == 8 && F.wave < nextra)) {
        const LAS float* q = lg + F.lane * 36;
        int gi = 0; float gm = q[0];
#pragma unroll
        for (int i = 1; i < 4; ++i) if (q[i] > gm) { gm = q[i]; gi = i; }
        float gs = 0.f;
#pragma unroll
        for (int i = 0; i < 4; ++i) gs += expf(q[i] - gm);
        const float gprob = 1.f / gs;
        const LAS float* el = q + 4;
        int i1 = 0; float v1 = el[0];
#pragma unroll
        for (int i = 1; i < 8; ++i) if (el[i] > v1) { v1 = el[i]; i1 = i; }
        int i2 = 0; float v2 = -INFINITY;
#pragma unroll
        for (int i = 0; i < 8; ++i) if (i != i1 && el[i] > v2) { v2 = el[i]; i2 = i; }
        const float e2 = expf(v2 - v1), p1 = 1.f / (1.f + e2), p2 = e2 / (1.f + e2);
        const int r = row_base + (F.lane < 8 ? F.wave * 8 + F.lane : 64 + F.wave), e0 = gi * 8 + i1, e1 = gi * 8 + i2;
        RE[r * 2] = e0; RE[r * 2 + 1] = e1; RW[r * 2] = gprob * p1; RW[r * 2 + 1] = gprob * p2;
        my_row = r; my_e0 = e0; my_e1 = e1;
        my_l0 = __hip_atomic_fetch_add((LAS int*)(F.lds + L_WGCNT) + e0, 1, __ATOMIC_RELAXED, __HIP_MEMORY_SCOPE_WORKGROUP);
        my_l1 = __hip_atomic_fetch_add((LAS int*)(F.lds + L_WGCNT) + e1, 1, __ATOMIC_RELAXED, __HIP_MEMORY_SCOPE_WORKGROUP);
    }
    __syncthreads();
    if (F.tid < 32) { const int c = lcnt[F.tid]; int base = 0; if (c > 0) base = (int)__hip_atomic_fetch_add(F.ctl + CW_CNT + 64 * l + F.tid, (unsigned)c, RLX_AGENT); lcnt[32 + F.tid] = base; }
    __syncthreads();
    if (my_row >= 0) { RSLOT[my_row * 2] = lcnt[32 + my_e0] + my_l0; RSLOT[my_row * 2 + 1] = lcnt[32 + my_e1] + my_l1; }
    __syncthreads();
}

__device__ __forceinline__ void moe_tables(Frame& F, int l) {
    volatile LAS int* tp = (volatile LAS int*)(F.lds + L_MOETAB);
    __syncthreads();
    if (F.tid == 0) { int acc = 0;
        for (int e = 0; e < NE; ++e) { tp[e] = acc; const int c = (int)__hip_atomic_load(F.ctl + CW_CNT + 64 * l + e, RLX_AGENT); acc += (c + 255) >> 8; }
        tp[NE] = acc; }
    __syncthreads();
}
__device__ __forceinline__ void phase_gather(Frame& F, int l) {
    moe_tables(F, l);
    const volatile LAS int* tp = (const volatile LAS int*)(F.lds + L_MOETAB);
    const int nrows = l == 0 ? NALL : NTOK;
    const int gw = F.vcu * NWAVES + F.wave, NGW = F.G * NWAVES;
    const bf16* H = (const bf16*)(F.ws + WS_H); bf16* HS = (bf16*)(F.ws + B_HS);
    const int* RE = (const int*)(F.ws + SM_RE); const float* RW = (const float*)(F.ws + SM_RW); const int* RSLOT = (const int*)(F.ws + SM_RSLOT);
    int* RDEST = (int*)(F.ws + SM_RDEST); float* RWS = (float*)(F.ws + SM_RWS);
    for (int r0 = gw; r0 < nrows; r0 += 2 * NGW) {
        const int r1 = r0 + NGW; const bool two = r1 < nrows; const int r1c = two ? r1 : r0;
        const GAS v4u* s0 = (const GAS v4u*)(H + (size_t)r0 * D) + F.lane; const GAS v4u* s1 = (const GAS v4u*)(H + (size_t)r1c * D) + F.lane;
        const v4u a0 = s0[0], b0 = s0[64], a1 = s1[0], b1 = s1[64];
        const int e00 = RE[r0 * 2], e01 = RE[r0 * 2 + 1], e10 = RE[r1c * 2], e11 = RE[r1c * 2 + 1];
        const int dd[4] = {256 * tp[e00] + RSLOT[r0 * 2], 256 * tp[e01] + RSLOT[r0 * 2 + 1], 256 * tp[e10] + RSLOT[r1c * 2], 256 * tp[e11] + RSLOT[r1c * 2 + 1]};
#pragma unroll
        for (int k = 0; k < 4; ++k) {
            if (k >= 2 && !two) break;
            GAS v4u* dst = (GAS v4u*)(HS + (size_t)dd[k] * D) + F.lane;
            dst[0] = k < 2 ? a0 : a1; dst[64] = k < 2 ? b0 : b1;
            const int r = k < 2 ? r0 : r1;
            if (F.lane == 0) { RDEST[r * 2 + (k & 1)] = dd[k]; RWS[dd[k]] = RW[r * 2 + (k & 1)]; }
        }
    }
}
__device__ __forceinline__ int carry_cidx(int dir, int b, int v) { return dir == 0 ? (v < 8 ? 512 + b * 8 + v : b * 256 + (v - 8)) : (v < 8 ? 512 + b * 8 + (7 - v) : b * 256 + 255 - (v - 8)); }
__device__ __forceinline__ void phase_ssm_carry(Frame& F, int l) {
    if (F.vcu >= 128) return;
    const int g = F.vcu >> 2, b = (F.vcu >> 1) & 1, dir = F.vcu & 1, seg = F.tid >> 6, p = F.tid & 63;
    const float* tab = (const float*)(F.ws + SM_SSMTAB);
    const size_t ti = ((((size_t)l * NG + g) * 2 + dir) * 64 + p) * 2;
    const float a32r = tab[ti], a32i = tab[ti + 1], asr = tab[16384 + ti], asi = tab[16384 + ti + 1];
    const float* send = (const float*)(F.ws + B_SEND) + (size_t)g * NCH * 256 + dir * 128 + p;
    bf16* A3 = (bf16*)(F.ws + B_A3) + (size_t)g * NCH * 768 + 512 + dir * 128 + p;
    LAS float* segend = (LAS float*)(F.lds);
    float xr = 0.f, xi = 0.f;
#pragma unroll 1
    for (int k0 = 0; k0 < 33; k0 += 11) {
        float sr[11], si[11];
#pragma unroll
        for (int k = 0; k < 11; ++k) { const unsigned c = (unsigned)carry_cidx(dir, b, seg * 33 + k0 + k); sr[k] = send[c * 256u]; si[k] = send[c * 256u + 64u]; }
#pragma unroll
        for (int k = 0; k < 11; ++k) { const float nr = a32r * xr - a32i * xi + sr[k], ni = a32r * xi + a32i * xr + si[k]; xr = nr; xi = ni; }
    }
    __syncthreads();
    segend[(seg * 64 + p) * 2] = xr; segend[(seg * 64 + p) * 2 + 1] = xi;
    __syncthreads();
    float cr = 0.f, ci = 0.f;
    for (int k = 0; k < seg; ++k) { const float er = segend[(k * 64 + p) * 2], ei = segend[(k * 64 + p) * 2 + 1]; const float nr = asr * cr - asi * ci + er, ni = asr * ci + asi * cr + ei; cr = nr; ci = ni; }
    xr = cr; xi = ci;
#pragma unroll 1
    for (int k0 = 0; k0 < 33; k0 += 11) {
        float sr[11], si[11];
#pragma unroll
        for (int k = 0; k < 11; ++k) { const unsigned c = (unsigned)carry_cidx(dir, b, seg * 33 + k0 + k); sr[k] = send[c * 256u]; si[k] = send[c * 256u + 64u]; }
#pragma unroll
        for (int k = 0; k < 11; ++k) { const unsigned c = (unsigned)carry_cidx(dir, b, seg * 33 + k0 + k);
            A3[c * 768u] = (bf16)f2bf_rne(xr); A3[c * 768u + 64u] = (bf16)f2bf_rne(xi);
            const float nr = a32r * xr - a32i * xi + sr[k], ni = a32r * xi + a32i * xr + si[k]; xr = nr; xi = ni; }
    }
    __syncthreads();
}
struct KFrag { bf16x8 k[4]; };
struct VFrag { bf16x8 v[2][2]; };
__device__ __forceinline__ void k_load(KFrag& f, const bf16* kp  , int lane) {
    const int r32 = lane & 31, hi = lane >> 5;
#pragma unroll
    for (int d0 = 0; d0 < 4; ++d0) f.k[d0] = *(const GAS bf16x8*)(kp + (size_t)r32 * 128 + d0 * 16 + hi * 8);
}
__device__ __forceinline__ void v_load(VFrag& f, const bf16* vp  , int vpitch, int lane) {
    const int r32 = lane & 31, hi = lane >> 5;
#pragma unroll
    for (int db = 0; db < 2; ++db)
#pragma unroll
        for (int ks = 0; ks < 2; ++ks) f.v[db][ks] = *(const GAS bf16x8*)(vp + (size_t)(32 * db + r32) * vpitch + 16 * ks + 8 * hi);
}
__device__ __forceinline__ void attn_tile(f32x16 (&o)[2], float& m_run, float& l_run, const bf16x8 (&qf)[4], const KFrag& fk, const VFrag& f, int mask_mode  , int lane) {
    const int r32 = lane & 31, hi = lane >> 5;
    f32x16 s = {};
#pragma unroll
    for (int d0 = 0; d0 < 4; ++d0) s = __builtin_amdgcn_mfma_f32_32x32x16_bf16(fk.k[d0], qf[d0], s, 0, 0, 0);
    __builtin_amdgcn_sched_barrier(0);
    if (mask_mode != 0) {
#pragma unroll
        for (int r = 0; r < 16; ++r) { const int kidx = (r & 3) + 8 * (r >> 2) + 4 * hi; const bool valid = mask_mode == 1 ? (kidx >= r32) : (kidx <= r32); if (!valid) s[r] = -INFINITY; }
    }
    float tm = s[0];
#pragma unroll
    for (int r = 1; r < 16; ++r) tm = fmaxf(tm, s[r]);
    { auto rr = __builtin_amdgcn_permlane32_swap(__float_as_uint(tm), __float_as_uint(tm), false, false); tm = fmaxf(__uint_as_float(rr[0]), __uint_as_float(rr[1])); }
    const float m_new = fmaxf(m_run, tm);
    const float alpha = __builtin_amdgcn_exp2f(m_run - m_new);
    m_run = m_new;
    float ps = 0.f;
#pragma unroll
    for (int r = 0; r < 16; ++r) { s[r] = __builtin_amdgcn_exp2f(s[r] - m_new); ps += s[r]; }
    l_run = l_run * alpha + ps;
    __builtin_amdgcn_sched_barrier(0);
#pragma unroll
    for (int db = 0; db < 2; ++db)
#pragma unroll
        for (int r = 0; r < 16; ++r) o[db][r] *= alpha;
    __builtin_amdgcn_sched_barrier(0);
    bf16x8 pf[2];
#pragma unroll
    for (int ks = 0; ks < 2; ++ks) {
        v4u w; w.x = cvt_pk_bf16(s[8 * ks + 0], s[8 * ks + 1]); w.y = cvt_pk_bf16(s[8 * ks + 2], s[8 * ks + 3]); w.z = cvt_pk_bf16(s[8 * ks + 4], s[8 * ks + 5]); w.w = cvt_pk_bf16(s[8 * ks + 6], s[8 * ks + 7]);
        pf[ks] = __builtin_bit_cast(bf16x8, w);
    }
#pragma unroll
    for (int db = 0; db < 2; ++db)
#pragma unroll
        for (int ks = 0; ks < 2; ++ks) o[db] = __builtin_amdgcn_mfma_f32_32x32x16_bf16(f.v[db][ks], pf[ks], o[db], 0, 0, 0);
}
__device__ __forceinline__ void tile_ptrs(int t, int nloc, int i_lo, int p0, const bf16* kl, const bf16* vl, const bf16* kc, const bf16* vc, const bf16*& kp, const bf16*& vp, int& vpitch, int& mm) {
    if (t < nloc) { const int i = i_lo + t, kt = p0 - 128 + 32 * i; kp = kl + (size_t)kt * 128; vp = vl + kt; vpitch = S; mm = i == 0 ? 1 : (i == 8 ? 2 : 0); }
    else { const int c = t - nloc; kp = kc + (size_t)(32 * c) * 128; vp = vc + 32 * c; vpitch = CTX; mm = 0; }
}
__device__ __forceinline__ void attn_wave(Frame& F, int qrow0, int h0, int b, int p0, float sink0, float sink1) {
    const int lane = F.lane, r32 = lane & 31, hi = lane >> 5, kvh = h0 >> 2;
    const bf16* Q = (const bf16*)(F.ws + B_Q); const bf16* KB = (const bf16*)(F.ws + B_K); const bf16* VT = (const bf16*)(F.ws + B_VT);
    bf16x8 qa[4], qb[4];
#pragma unroll
    for (int d0 = 0; d0 < 4; ++d0) { qa[d0] = *(const GAS bf16x8*)(Q + (size_t)(qrow0 + r32) * 512 + h0 * 64 + d0 * 16 + hi * 8); qb[d0] = *(const GAS bf16x8*)(Q + (size_t)(qrow0 + r32) * 512 + (h0 + 1) * 64 + d0 * 16 + hi * 8); }
    f32x16 oa[2], ob[2]; oa[0] = f32x16{}; oa[1] = f32x16{}; ob[0] = f32x16{}; ob[1] = f32x16{};
    float ma = sink0 * LOG2E, mb = sink1 * LOG2E, la = hi == 0 ? 1.f : 0.f, lb = la;
    const bf16* kl = KB + (size_t)(b * S) * 128 + kvh * 64; const bf16* vl = VT + (size_t)((b * 2 + kvh) * 64) * S;
    const bf16* kc = KB + (size_t)(NTOK + b * CTX) * 128 + kvh * 64; const bf16* vc = VT + (size_t)NTOK * 128 + (size_t)((b * 2 + kvh) * 64) * CTX;
    int i_lo = 0, nloc = 0;
    if (p0 >= 0) { i_lo = 4 - (p0 >> 5); if (i_lo < 0) i_lo = 0; int i_hi = (S + 128 - p0) >> 5; if (i_hi > 9) i_hi = 9; nloc = i_hi - i_lo; }
    const int nt = nloc + 8;
    KFrag ka, kb; VFrag vv;
    { const bf16* kp; const bf16* vp; int vpitch, mm; tile_ptrs(0, nloc, i_lo, p0, kl, vl, kc, vc, kp, vp, vpitch, mm); k_load(ka, kp, lane); }
#pragma unroll 1
    for (int t = 0; t < nt; t += 2) {
        const bf16* kp; const bf16* vp; int vpitch, mm0, mm1 = 0, mmx;
        tile_ptrs(t, nloc, i_lo, p0, kl, vl, kc, vc, kp, vp, vpitch, mm0); v_load(vv, vp, vpitch, lane);
        if (t + 1 < nt) { tile_ptrs(t + 1, nloc, i_lo, p0, kl, vl, kc, vc, kp, vp, vpitch, mm1); k_load(kb, kp, lane); }
        attn_tile(oa, ma, la, qa, ka, vv, mm0, lane); attn_tile(ob, mb, lb, qb, ka, vv, mm0, lane);
        if (t + 1 < nt) {
            v_load(vv, vp, vpitch, lane);
            if (t + 2 < nt) { tile_ptrs(t + 2, nloc, i_lo, p0, kl, vl, kc, vc, kp, vp, vpitch, mmx); k_load(ka, kp, lane); }
            attn_tile(oa, ma, la, qa, kb, vv, mm1, lane); attn_tile(ob, mb, lb, qb, kb, vv, mm1, lane);
        }
    }
    bf16* O = (bf16*)(F.ws + B_ATT) + (size_t)(qrow0 + r32) * 512 + h0 * 64;
    { const float inv = 1.f / (la + __shfl_xor(la, 32));
#pragma unroll
      for (int db = 0; db < 2; ++db)
#pragma unroll
        for (int g4 = 0; g4 < 4; ++g4) { v2u w; w.x = cvt_pk_bf16(oa[db][4 * g4 + 0] * inv, oa[db][4 * g4 + 1] * inv); w.y = cvt_pk_bf16(oa[db][4 * g4 + 2] * inv, oa[db][4 * g4 + 3] * inv); *(GAS v2u*)(O + 32 * db + 8 * g4 + 4 * hi) = w; } }
    { const float inv = 1.f / (lb + __shfl_xor(lb, 32));
#pragma unroll
      for (int db = 0; db < 2; ++db)
#pragma unroll
        for (int g4 = 0; g4 < 4; ++g4) { v2u w; w.x = cvt_pk_bf16(ob[db][4 * g4 + 0] * inv, ob[db][4 * g4 + 1] * inv); w.y = cvt_pk_bf16(ob[db][4 * g4 + 2] * inv, ob[db][4 * g4 + 3] * inv); *(GAS v2u*)(O + 64 + 32 * db + 8 * g4 + 4 * hi) = w; } }
}
constexpr int ATT_V_OFF = 49152;
__device__ __forceinline__ void lds_frag_load(KFrag& kf, VFrag& vf, const LAS unsigned char* kt, const LAS unsigned char* vt, int lane) {
    const int r32 = lane & 31, hi = lane >> 5;
#pragma unroll
    for (int d0 = 0; d0 < 4; ++d0) kf.k[d0] = *(const LAS bf16x8*)(kt + r32 * 128 + (((2 * d0 + hi) ^ ((r32 >> 1) & 7)) * 16));
#pragma unroll
    for (int db = 0; db < 2; ++db)
#pragma unroll
        for (int ks = 0; ks < 2; ++ks) { const int d = 32 * db + r32; vf.v[db][ks] = *(const LAS bf16x8*)(vt + d * 64 + (((2 * ks + hi) ^ ((d >> 2) & 3)) * 16)); }
}
__device__ __forceinline__ void attn_wg_task(Frame& F, const Inputs& I, int l, int v) {
    int lane_ = F.lane, wave_ = F.wave; asm volatile("" : "+v"(lane_), "+s"(wave_));
    const int lane = lane_, wave = wave_, r32 = lane & 31, hi = lane >> 5;
    const int bk = v >> 6, b = bk >> 1, kvh = bk & 1, q0 = (v & 63) * 128, h0 = kvh * 4 + 2 * (wave & 1), qt = wave >> 1, p0 = q0 + 32 * qt, kb0 = q0 - 128;
    const bf16* Q = (const bf16*)(F.ws + B_Q); const bf16* KB = (const bf16*)(F.ws + B_K); const bf16* VT = (const bf16*)(F.ws + B_VT);
    const bf16* kl = KB + (size_t)(b * S) * 128 + kvh * 64; const bf16* vl = VT + (size_t)((b * 2 + kvh) * 64) * S;
    const bf16* kc = KB + (size_t)(NTOK + b * CTX) * 128 + kvh * 64; const bf16* vc = VT + (size_t)NTOK * 128 + (size_t)((b * 2 + kvh) * 64) * CTX;
    LAS unsigned char* L = F.lds;
    {
        v4u kr[6], vr[6];
#pragma unroll
        for (int j = 0; j < 6; ++j) { const int slot = wave * 6 + j, T = slot >> 2, part = slot & 3, kt = kb0 + 32 * T; const bool ok = kt >= 0 && kt < S;
            kr[j] = (v4u){0u, 0u, 0u, 0u}; vr[j] = kr[j];
            if (ok) { kr[j] = *(const GAS v4u*)(kl + (unsigned)((kt + 8 * part + (lane >> 3)) * 128 + (lane & 7) * 8)); vr[j] = *(const GAS v4u*)(vl + (unsigned)((16 * part + (lane >> 2)) * S + kt + (lane & 3) * 8)); } }
#pragma unroll
        for (int j = 0; j < 6; ++j) { const int slot = wave * 6 + j, T = slot >> 2, part = slot & 3, kq = 8 * part + (lane >> 3), d = 16 * part + (lane >> 2);
            *(LAS v4u*)(L + T * 4096 + kq * 128 + (((lane & 7) ^ ((kq >> 1) & 7)) * 16)) = kr[j];
            *(LAS v4u*)(L + ATT_V_OFF + T * 4096 + d * 64 + (((lane & 3) ^ ((d >> 2) & 3)) * 16)) = vr[j]; }
    }
    asm volatile("" ::: "memory");
    {
        v4u ckr[4];
#pragma unroll
        for (int j = 0; j < 4; ++j) { const int slot = wave * 4 + j, T = slot >> 2, part = slot & 3; ckr[j] = *(const GAS v4u*)(kc + (unsigned)((32 * T + 8 * part + (lane >> 3)) * 128 + (lane & 7) * 8)); }
#pragma unroll
        for (int j = 0; j < 4; ++j) { const int slot = wave * 4 + j, T = slot >> 2, part = slot & 3, kq = 8 * part + (lane >> 3);
            *(LAS v4u*)(L + 98304 + T * 4096 + kq * 128 + (((lane & 7) ^ ((kq >> 1) & 7)) * 16)) = ckr[j]; }
    }
    asm volatile("" ::: "memory");
    bf16x8 qa[4], qb[4];
#pragma unroll
    for (int d0 = 0; d0 < 4; ++d0) { qa[d0] = *(const GAS bf16x8*)(Q + (size_t)(b * S + p0 + r32) * 512 + h0 * 64 + d0 * 16 + hi * 8); qb[d0] = *(const GAS bf16x8*)(Q + (size_t)(b * S + p0 + r32) * 512 + (h0 + 1) * 64 + d0 * 16 + hi * 8); }
    __syncthreads();
    f32x16 oa[2], ob[2]; oa[0] = f32x16{}; oa[1] = f32x16{}; ob[0] = f32x16{}; ob[1] = f32x16{};
    float ma = I.sink[l * NH + h0] * LOG2E, mb = I.sink[l * NH + h0 + 1] * LOG2E, la = hi == 0 ? 1.f : 0.f, lb = la;
#pragma unroll 1
    for (int i = 0; i < 9; ++i) {
        const int kt = p0 - 128 + 32 * i; if (kt < 0 || kt >= S) continue;
        const int T = qt + i; KFrag kf; VFrag vf;
        lds_frag_load(kf, vf, L + T * 4096, L + ATT_V_OFF + T * 4096, lane);
        const int mm = i == 0 ? 1 : (i == 8 ? 2 : 0);
        attn_tile(oa, ma, la, qa, kf, vf, mm, lane); __builtin_amdgcn_sched_barrier(0); attn_tile(ob, mb, lb, qb, kf, vf, mm, lane); __builtin_amdgcn_sched_barrier(0);
    }
    { v4u cvr[4];
#pragma unroll
      for (int j = 0; j < 4; ++j) { const int slot = wave * 4 + j, T = slot >> 2, part = slot & 3; cvr[j] = *(const GAS v4u*)(vc + (unsigned)((16 * part + (lane >> 2)) * CTX + 32 * T + (lane & 3) * 8)); }
      __syncthreads();
#pragma unroll
      for (int j = 0; j < 4; ++j) { const int slot = wave * 4 + j, T = slot >> 2, part = slot & 3, d = 16 * part + (lane >> 2);
        *(LAS v4u*)(L + T * 4096 + d * 64 + (((lane & 3) ^ ((d >> 2) & 3)) * 16)) = cvr[j]; } }
    __syncthreads();
#pragma unroll 1
    for (int T = 0; T < 8; ++T) { KFrag kf; VFrag vf; lds_frag_load(kf, vf, L + 98304 + T * 4096, L + T * 4096, lane);
        attn_tile(oa, ma, la, qa, kf, vf, 0, lane); __builtin_amdgcn_sched_barrier(0); attn_tile(ob, mb, lb, qb, kf, vf, 0, lane); __builtin_amdgcn_sched_barrier(0); }
    __syncthreads();
    bf16* O = (bf16*)(F.ws + B_ATT) + (size_t)(b * S + p0 + r32) * 512 + h0 * 64;
    { const float inv = 1.f / (la + __shfl_xor(la, 32));
#pragma unroll
      for (int db = 0; db < 2; ++db)
#pragma unroll
        for (int g4 = 0; g4 < 4; ++g4) { v2u w; w.x = cvt_pk_bf16(oa[db][4 * g4 + 0] * inv, oa[db][4 * g4 + 1] * inv); w.y = cvt_pk_bf16(oa[db][4 * g4 + 2] * inv, oa[db][4 * g4 + 3] * inv); *(GAS v2u*)(O + 32 * db + 8 * g4 + 4 * hi) = w; } }
    { const float inv = 1.f / (lb + __shfl_xor(lb, 32));
#pragma unroll
      for (int db = 0; db < 2; ++db)
#pragma unroll
        for (int g4 = 0; g4 < 4; ++g4) { v2u w; w.x = cvt_pk_bf16(ob[db][4 * g4 + 0] * inv, ob[db][4 * g4 + 1] * inv); w.y = cvt_pk_bf16(ob[db][4 * g4 + 2] * inv, ob[db][4 * g4 + 3] * inv); *(GAS v2u*)(O + 64 + 32 * db + 8 * g4 + 4 * hi) = w; } }
}
__device__ __forceinline__ void phase_attn_latent(Frame& F, const Inputs& I, int l) {
    __syncthreads();
    for (int v = F.vcu; v < 256; v += F.G) attn_wg_task(F, I, l, v);
}
__device__ __forceinline__ void phase_attn_ctx(Frame& F, const Inputs& I, int l, int first_wg) {
    const int wv = (F.vcu - first_wg) * NWAVES + F.wave;
    if (F.vcu < first_wg || wv >= 64) return;
    const int b = wv >> 5, h0 = ((wv >> 3) & 3) * 2, qt = wv & 7;
    attn_wave(F, NTOK + b * CTX + qt * 32, h0, b, -1, I.sink[l * NH + h0], I.sink[l * NH + h0 + 1]);
}
__device__ __forceinline__ f32x16 small_prod(const bf16* A, int lda, const bf16* Bt, int ldb, int kbeg, int ksteps, int lane) {
    const int r32 = lane & 31, hi = lane >> 5;
    const bf16* ap = A + (size_t)r32 * lda + kbeg + hi * 8; const bf16* bp = Bt + (size_t)r32 * ldb + kbeg + hi * 8;
    f32x16 acc = {};
#pragma unroll 1
    for (int k0 = 0; k0 < ksteps; k0 += 8) {
        bf16x8 af[8], bf_[8];
#pragma unroll
        for (int j = 0; j < 8; ++j) { af[j] = *(const GAS bf16x8*)(ap + (k0 + j) * 16); bf_[j] = *(const GAS bf16x8*)(bp + (k0 + j) * 16); }
#pragma unroll
        for (int j = 0; j < 8; ++j) acc = __builtin_amdgcn_mfma_f32_32x32x16_bf16(af[j], bf_[j], acc, 0, 0, 0);
    }
    return acc;
}
__device__ __forceinline__ void ctx_small_gemm(Frame& F, const Inputs& I, int kind) {
    if (F.vcu >= 256) return;
    const int tm = F.vcu >> 4, tn = F.vcu & 15, nb = F.wave & 1, kq = F.wave >> 1, lane = F.lane, r32 = lane & 31, hi = lane >> 5;
    const int row0 = NTOK + 32 * tm, col0 = 64 * tn + 32 * nb;
    LAS float* red = (LAS float*)(F.lds);
    f32x16 p1, p2 = {};
    if (kind == 0) {
        p1 = small_prod((const bf16*)(F.ws + B_ATT) + (size_t)row0 * 512, 512, (const bf16*)(F.ws + W_BRA) + (size_t)col0 * 512, 512, kq * 128, 8, lane);
        p2 = small_prod((const bf16*)(F.ws + B_SG) + (size_t)row0 * 512, 512, (const bf16*)(F.ws + W_BRS) + (size_t)col0 * 512, 512, kq * 128, 8, lane);
    } else p1 = small_prod((const bf16*)(F.ws + B_MB) + (size_t)row0 * D, D, (const bf16*)(F.ws + W_OUT) + (size_t)col0 * D, D, kq * 256, 16, lane);
    __syncthreads();
#pragma unroll
    for (int r = 0; r < 16; ++r) { red[((0 * 8 + F.wave) * 16 + r) * 64 + lane] = p1[r]; if (kind == 0) red[((1 * 8 + F.wave) * 16 + r) * 64 + lane] = p2[r]; }
    __syncthreads();
    if (F.wave < 2) {
        const int col = col0 + r32;
#pragma unroll
        for (int r = 0; r < 16; ++r) {
            const int row = row0 + (r & 3) + 8 * (r >> 2) + 4 * hi;
            float s1 = 0.f, s2 = 0.f;
#pragma unroll
            for (int q = 0; q < 4; ++q) { s1 += red[((0 * 8 + 2 * q + nb) * 16 + r) * 64 + lane]; if (kind == 0) s2 += red[((1 * 8 + 2 * q + nb) * 16 + r) * 64 + lane]; }
            if (kind == 0) {
                const float ga = bf_lo((unsigned)((const bf16*)(F.ws + B_GA))[(size_t)row * D + col]), gs = bf_lo((unsigned)((const bf16*)(F.ws + B_GS))[(size_t)row * D + col]);
                __hip_atomic_store((GAS unsigned short*)((bf16*)(F.ws + B_MB) + (size_t)row * D + col), (unsigned short)f2bf_rne(ga * s1 + gs * s2), __ATOMIC_RELAXED, __HIP_MEMORY_SCOPE_AGENT);
            } else {
                const float gate = ((const float*)(F.ws + SM_MOD))[(0 * 3 + 2) * 6144 + 2 * D + col];
                ((float*)(F.ws + WS_XC))[(size_t)row * D + col] = I.ctx[(size_t)(row - NTOK) * D + col] + gate * s1;
            }
        }
        if (kind == 0) { asm volatile("s_waitcnt vmcnt(0)" ::: "memory"); if (lane == 0) __hip_atomic_fetch_add((gu32*)(F.ws + WS_CTL) + 49152 + 64 * (0 * 160 + 130 + tm), 1u, RLX_AGENT); }
    }
    __syncthreads();
}
using pg8::Unit;
#ifndef GEMM_ALIGN
#define GEMM_ALIGN true
#endif
#ifndef MOE_FUSED
#define MOE_FUSED 1
#endif
#ifndef E2_FUSED
#define E2_FUSED 0
#endif
#ifndef S1_IN_G1
#define S1_IN_G1 1
#endif
constexpr int CW_U = 94208;
#ifndef S2_FUSED
#define S2_FUSED 1
#endif
constexpr int CW_S1 = 90112;
#ifndef GEMM_SP2
#define GEMM_SP2 true
#endif
__device__ __forceinline__ v4u pack8(const f32x4& a, const f32x4& b) { v4u w; w.x = cvt_pk_bf16(a.x, a.y); w.y = cvt_pk_bf16(a.z, a.w); w.z = cvt_pk_bf16(b.x, b.y); w.w = cvt_pk_bf16(b.z, b.w); return w; }
__device__ __forceinline__ void unpack8(const v4u w, f32x4& a, f32x4& b) { a = (f32x4){bf_lo(w.x), bf_hi(w.x), bf_lo(w.y), bf_hi(w.y)}; b = (f32x4){bf_lo(w.z), bf_hi(w.z), bf_lo(w.w), bf_hi(w.w)}; }
__device__ __forceinline__ f32x4 sig4(const f32x4& v) { return (f32x4){sigmoid_f(v.x), sigmoid_f(v.y), sigmoid_f(v.z), sigmoid_f(v.w)}; }
__device__ __forceinline__ f32x4 gelu4(const f32x4& v) { return (f32x4){gelu_tanh_f(v.x), gelu_tanh_f(v.y), gelu_tanh_f(v.z), gelu_tanh_f(v.w)}; }

enum GemmKind { GK_INPROJ = 0, GK_S1, GK_S3, GK_GLU, GK_BR, GK_OUT, GK_MU, GK_MD, GK_MOE, GK_E2A, GK_E2B };
constexpr int CW_E2 = 49152;
__device__ __forceinline__ void store16_wt(unsigned char* ws, size_t byte_off, const v4u w) {
    const __amdgpu_buffer_rsrc_t rs = __builtin_amdgcn_make_buffer_rsrc(ws, 0, (int)WS_END, 0x00020000);
    __builtin_amdgcn_raw_buffer_store_b128(w, rs, (int)byte_off, 0, 16); }
__device__ __forceinline__ void wg_wait_count(unsigned char* ws, int word, unsigned need) {
    if (threadIdx.x < 64) { gu32* w = (gu32*)(ws + WS_CTL) + word; unsigned sp = 0;
        while ((unsigned)__builtin_amdgcn_readfirstlane((int)__hip_atomic_load(w, RLX_AGENT)) < need) { __builtin_amdgcn_s_sleep(2);
            if (++sp > (1u << 20)) { if (threadIdx.x == 0) __hip_atomic_store((gu32*)(ws + WS_CTL) + CW_TMO, 1u, RLX_AGENT); break; } }
        __builtin_amdgcn_fence(__ATOMIC_ACQUIRE, "agent"); asm volatile("s_waitcnt vmcnt(0)" ::: "memory"); }
    asm volatile("" ::: "memory"); __builtin_amdgcn_s_barrier(); asm volatile("" ::: "memory"); }
__device__ __forceinline__ void wave_arrive(unsigned char* ws, int word) { asm volatile("s_waitcnt vmcnt(0)" ::: "memory"); if ((threadIdx.x & 63) == 0) __hip_atomic_fetch_add((gu32*)(ws + WS_CTL) + word, 1u, RLX_AGENT); }
constexpr int CW_RDY = 16384;
struct GemmDesc { int kind, layer, G, c, vc, nM; unsigned char* ws; const float* xlat; const float* xctx; };

template <int KIND> struct EpiAll {
    static constexpr bool PERM = true;
    GemmDesc d;
    typedef const f32x4 (&Acc)[2][2][4][2];
    __device__ __forceinline__ void inproj(Acc acc, const Unit& u, int wr, int wc, int fr, int fq) const {
        unsigned char* ws = d.ws;
        const int pn = u.pn, pm = u.pm, r0 = pm * 256 + wr * 64 + fr;
        const bool latent = pm < 64;
        if (pn <= 2) {
            const float* rope = (const float*)(ws + SM_ROPE);
            bf16* Q = (bf16*)(ws + B_Q); bf16* KB = (bf16*)(ws + B_K); bf16* VT = (bf16*)(ws + B_VT);
            const int jb = 8 * (fq & 1); const float sgn = fq < 2 ? -1.f : 1.f;
#pragma unroll
            for (int ai = 0; ai < 2; ++ai)
#pragma unroll
                for (int m = 0; m < 4; ++m) {
                    const int r = r0 + ai * 128 + m * 16;
                    f32x4 c0 = {1.f, 1.f, 1.f, 1.f}, c1 = c0, s0 = {0.f, 0.f, 0.f, 0.f}, s1 = s0;
                    if (latent) { const int s = r & 8191, pos = (wc & 1) ? (s & 63) : (s >> 6); const float* rp = rope + pos * 16 + jb;
                        c0 = *(const GAS f32x4*)rp; c1 = *(const GAS f32x4*)(rp + 4); s0 = *(const GAS f32x4*)(rp + 2048); s1 = *(const GAS f32x4*)(rp + 2052); }
#pragma unroll
                    for (int bj = 0; bj < 2; ++bj) {
                        f32x4 v0 = acc[ai][bj][m][0], v1 = acc[ai][bj][m][1];
                        if (pn == 2 && bj == 1) {
                            const int dd = 32 * (wc & 1) + 8 * fq, kvh = wc >> 1; bf16* vt; size_t pitch;
                            if (latent) { const int b = r >> 13, k_ = r & 8191, key = (k_ & ~12) | ((k_ & 4) << 1) | ((k_ & 8) >> 1); vt = VT + (size_t)((b * 2 + kvh) * 64 + dd) * S + key; pitch = S; }
                            else { const int rc = r - NTOK, b = rc >> 8, k_ = rc & 255, key = (k_ & ~12) | ((k_ & 4) << 1) | ((k_ & 8) >> 1); vt = VT + (size_t)NTOK * 128 + (size_t)((b * 2 + kvh) * 64 + dd) * CTX + key; pitch = CTX; }
                            vt[0] = (bf16)f2bf_rne(v0.x); vt[pitch] = (bf16)f2bf_rne(v0.y); vt[2 * pitch] = (bf16)f2bf_rne(v0.z); vt[3 * pitch] = (bf16)f2bf_rne(v0.w);
                            vt[4 * pitch] = (bf16)f2bf_rne(v1.x); vt[5 * pitch] = (bf16)f2bf_rne(v1.y); vt[6 * pitch] = (bf16)f2bf_rne(v1.z); vt[7 * pitch] = (bf16)f2bf_rne(v1.w);
                            continue;
                        }
                        if (latent) {
                            f32x4 p0, p1;
                            p0.x = __shfl_xor(v0.x, 32); p0.y = __shfl_xor(v0.y, 32); p0.z = __shfl_xor(v0.z, 32); p0.w = __shfl_xor(v0.w, 32);
                            p1.x = __shfl_xor(v1.x, 32); p1.y = __shfl_xor(v1.y, 32); p1.z = __shfl_xor(v1.z, 32); p1.w = __shfl_xor(v1.w, 32);
                            v0 = v0 * c0 + (p0 * s0) * sgn; v1 = v1 * c1 + (p1 * s1) * sgn;
                        }
                        if (pn < 2) { v0 = v0 * C2; v1 = v1 * C2; *(GAS v4u*)(Q + (size_t)r * 512 + pn * 256 + bj * 128 + wc * 32 + 8 * fq) = pack8(v0, v1); }
                        else *(GAS v4u*)(KB + (size_t)r * 128 + wc * 32 + 8 * fq) = pack8(v0, v1);
                    }
                }
        } else if (pn <= 4) {
            bf16* A3 = (bf16*)(ws + B_A3);
#pragma unroll
            for (int ai = 0; ai < 2; ++ai)
#pragma unroll
                for (int m = 0; m < 4; ++m) {
                    const int r = r0 + ai * 128 + m * 16, cidx = r >> 5, s = r & 31;
#pragma unroll
                    for (int bj = 0; bj < 2; ++bj) { const int c = 256 * (pn - 3) + 128 * bj + 32 * wc + 8 * fq, g = c >> 4, mp0 = c & 15;
#if S1_IN_G1
                        store16_wt(ws, B_A3 + ((size_t)(g * NCH + cidx) * 768 + s * 16 + mp0) * 2, pack8(acc[ai][bj][m][0], acc[ai][bj][m][1])); }
#else
                        *(GAS v4u*)(A3 + ((size_t)(g * NCH + cidx) * 768 + s * 16 + mp0)) = pack8(acc[ai][bj][m][0], acc[ai][bj][m][1]); }
#endif
                }
        } else {
            bf16* Gt = (bf16*)(ws + (pn <= 8 ? B_GA : B_GS)); const int cb = 256 * (pn <= 8 ? pn - 5 : pn - 9);
#pragma unroll
            for (int ai = 0; ai < 2; ++ai)
#pragma unroll
                for (int m = 0; m < 4; ++m) {
                    const int r = r0 + ai * 128 + m * 16;
#pragma unroll
                    for (int bj = 0; bj < 2; ++bj) *(GAS v4u*)(Gt + (size_t)r * D + cb + 128 * bj + 32 * wc + 8 * fq) = pack8(sig4(acc[ai][bj][m][0]), sig4(acc[ai][bj][m][1]));
                }
        }
    }
    __device__ __forceinline__ void operator()(Acc acc, const Unit& u, int wr, int wc, int fr, int fq) const {
        unsigned char* ws = d.ws;
        if constexpr (KIND == GK_INPROJ) {
            if (S1_IN_G1 && u.k2 == 1) {
                float* send = (float*)(ws + B_SEND) + (size_t)(u.aux * NCH + u.pm * 256 + wr * 64 + fr) * 256 + wc * 32 + 8 * fq;
#pragma unroll
                for (int ai = 0; ai < 2; ++ai)
#pragma unroll
                    for (int m = 0; m < 4; ++m)
#pragma unroll
                        for (int bj = 0; bj < 2; ++bj) { float* o = send + (size_t)(ai * 128 + m * 16) * 256 + bj * 128; *(GAS f32x4*)o = acc[ai][bj][m][0]; *(GAS f32x4*)(o + 4) = acc[ai][bj][m][1]; }
                return;
            }
            inproj(acc, u, wr, wc, fr, fq); return; }
        const int r0 = u.pm * 256 + wr * 64 + fr, c0 = u.pn * 256 + wc * 32 + 8 * fq;
        f32x4 og[2][2] = {};
        if constexpr (KIND == GK_OUT || KIND == GK_E2B) { const int w = u.pm < 64 ? (u.pm >> 5) : 2; const float* gate = (const float*)(ws + SM_MOD) + (d.layer * 3 + w) * 6144 + 2 * D + c0;
#pragma unroll
            for (int bj = 0; bj < 2; ++bj) { og[bj][0] = *(const GAS f32x4*)(gate + bj * 128); og[bj][1] = *(const GAS f32x4*)(gate + bj * 128 + 4); } }
#pragma unroll
        for (int aq = 0; aq < 4; ++aq) { const int ai = aq >> 1, mb = (aq & 1) * 2;
            v4u LA[4][2] = {}, LB[4][2] = {}; float LW[4] = {};
#pragma unroll
            for (int m = mb; m < mb + 2; ++m) {
                const int r = r0 + ai * 128 + m * 16;
                if constexpr (KIND == GK_MD) LW[m] = ((const float*)(ws + SM_RWS))[r];
                if constexpr (KIND == GK_MOE) { if (u.k2 == 1) LW[m] = ((const float*)(ws + SM_RWS))[r]; }
#pragma unroll
                for (int bj = 0; bj < 2; ++bj) { const int c = c0 + bj * 128;
                    if constexpr (KIND == GK_GLU) LA[m][bj] = *(const GAS v4u*)((const bf16*)(ws + B_Z) + (size_t)r * 512 + c);
                    if constexpr (KIND == GK_BR) { const size_t o = (size_t)r * D + c; if (u.aux == 0) LA[m][bj] = *(const GAS v4u*)((const bf16*)(ws + B_GA) + o); else { LA[m][bj] = *(const GAS v4u*)((const bf16*)(ws + B_GS) + o); LB[m][bj] = *(const GAS v4u*)((const bf16*)(ws + B_T1) + o); } }
                    if constexpr (KIND == GK_OUT || KIND == GK_E2B) { const float* xin = (r < NTOK ? d.xlat + (size_t)r * D : d.xctx + (size_t)(r - NTOK) * D) + c; LA[m][bj] = *(const GAS v4u*)xin; LB[m][bj] = *(const GAS v4u*)(xin + 4); }
                }
            }
#pragma unroll
            for (int m = mb; m < mb + 2; ++m) {
                const int r = r0 + ai * 128 + m * 16;
#pragma unroll
                for (int bj = 0; bj < 2; ++bj) {
                    const int c = c0 + bj * 128;
                    const f32x4 v0 = acc[ai][bj][m][0], v1 = acc[ai][bj][m][1];
                    switch (KIND) {
                    case GK_S1: {
                        const size_t o = B_SEND + ((size_t)(u.aux * NCH + r) * 256 + c) * 4;
#if S2_FUSED
                        store16_wt(ws, o, __builtin_bit_cast(v4u, v0)); store16_wt(ws, o + 16, __builtin_bit_cast(v4u, v1));
#else
                        *(GAS f32x4*)(ws + o) = v0; *(GAS f32x4*)(ws + o + 16) = v1;
#endif
                        } break;
                    case GK_S3: {
                        const int t = c >> 4, m0 = c & 15; *(GAS v4u*)((bf16*)(ws + B_Z) + (size_t)(r * 32 + t) * 512 + u.aux * 16 + m0) = pack8(gelu4(v0), gelu4(v1)); } break;
                    case GK_GLU: {
                        const size_t o = (size_t)r * 512 + c; f32x4 z0, z1; unpack8(LA[m][bj], z0, z1);
                        *(GAS v4u*)((bf16*)(ws + B_SG) + o) = pack8(z0 * sig4(v0), z1 * sig4(v1)); } break;
                    case GK_BR: {
                        const size_t o = (size_t)r * D + c;
                        if (u.aux == 0) { f32x4 g0, g1; unpack8(LA[m][bj], g0, g1); *(GAS v4u*)((bf16*)(ws + B_T1) + o) = pack8(g0 * v0, g1 * v1); }
                        else { f32x4 g0, g1, t0, t1; unpack8(LA[m][bj], g0, g1); unpack8(LB[m][bj], t0, t1);
                            *(GAS v4u*)((bf16*)(ws + B_MB) + o) = pack8(t0 + g0 * v0, t1 + g1 * v1); } } break;
                    case GK_E2B:
                    case GK_OUT: {
                        float* xo = (float*)(ws + WS_XC) + (size_t)r * D + c;
                        *(GAS f32x4*)xo = __builtin_bit_cast(f32x4, LA[m][bj]) + og[bj][0] * v0; *(GAS f32x4*)(xo + 4) = __builtin_bit_cast(f32x4, LB[m][bj]) + og[bj][1] * v1; } break;
                    case GK_MU: {
                        const f32x4 a = v0 * sig4(v0) * v1; v2u w; w.x = cvt_pk_bf16(a.x, a.y); w.y = cvt_pk_bf16(a.z, a.w);
                        *(GAS v2u*)((bf16*)(ws + B_ACT) + (size_t)r * DE + (c >> 1)) = w; } break;
                    case GK_E2A: {
                        if (u.aux == 0) { const size_t o = (size_t)r * 512 + c; f32x4 z0, z1; unpack8(*(const GAS v4u*)((const bf16*)(ws + B_Z) + o), z0, z1); store16_wt(ws, B_SG + o * 2, pack8(z0 * sig4(v0), z1 * sig4(v1))); }
                        else { const size_t o = (size_t)r * D + c;
                            if (u.aux == 1) { f32x4 g0, g1; unpack8(*(const GAS v4u*)((const bf16*)(ws + B_GA) + o), g0, g1); *(GAS v4u*)((bf16*)(ws + B_T1) + o) = pack8(g0 * v0, g1 * v1); }
                            else { f32x4 g0, g1, t0, t1; unpack8(*(const GAS v4u*)((const bf16*)(ws + B_GS) + o), g0, g1); unpack8(*(const GAS v4u*)((const bf16*)(ws + B_T1) + o), t0, t1); store16_wt(ws, B_MB + o * 2, pack8(t0 + g0 * v0, t1 + g1 * v1)); } } } break;
                    case GK_MOE: {
                        if (u.k2 == 0) { const f32x4 a = v0 * sig4(v0) * v1; const unsigned long long w = (unsigned long long)cvt_pk_bf16(a.x, a.y) | ((unsigned long long)cvt_pk_bf16(a.z, a.w) << 32);
                            __hip_atomic_store((GAS unsigned long long*)((bf16*)(ws + B_ACT) + (size_t)r * DE + (c >> 1)), w, __ATOMIC_RELAXED, __HIP_MEMORY_SCOPE_AGENT); }
                        else { const float w = LW[m]; *(GAS v4u*)((bf16*)(ws + B_YE) + (size_t)r * D + c) = pack8(v0 * w, v1 * w); } } break;
                    default: {
                        const float w = LW[m]; *(GAS v4u*)((bf16*)(ws + B_YE) + (size_t)r * D + c) = pack8(v0 * w, v1 * w); } break;
                    }
                }
            }
        }
    }
};
template <int KIND> struct SchedAll {
    static constexpr bool VARK = (KIND == GK_MOE) || (KIND == GK_INPROJ && S1_IN_G1);
    GemmDesc d; const volatile LAS int* tp;
    __device__ __forceinline__ void a_ready(const Unit& u) const {
        if constexpr (KIND == GK_INPROJ && S1_IN_G1) { if (u.k2 == 1) wg_wait_count(d.ws, CW_U + 64 * (d.layer * 8 + u.pm * 2 + (u.aux >> 4)), u.pm < 2 ? 256u : 16u); }
        if constexpr (KIND == GK_E2A) { if (u.aux == 2) wg_wait_count(d.ws, CW_E2 + 64 * (d.layer * 160 + u.pm), 16u); }
        if constexpr (KIND == GK_E2B) wg_wait_count(d.ws, CW_E2 + 64 * (d.layer * 160 + 66 + u.pm), 32u);
        if constexpr (KIND == GK_MOE) {
            if (u.k2 == 1) {
                if (threadIdx.x < 64) {
                    gu32* w = (gu32*)(d.ws + WS_CTL) + CW_RDY + 64 * (d.layer * 256 + u.pm); unsigned sp = 0;
                    while ((unsigned)__builtin_amdgcn_readfirstlane((int)__hip_atomic_load(w, RLX_AGENT)) < 32u) {
                        __builtin_amdgcn_s_sleep(2);
                        if (++sp > (1u << 20)) { if (threadIdx.x == 0) __hip_atomic_store((gu32*)(d.ws + WS_CTL) + CW_TMO, 1u, RLX_AGENT); break; } }
                    __builtin_amdgcn_fence(__ATOMIC_ACQUIRE, "agent");
                    asm volatile("s_waitcnt vmcnt(0)" ::: "memory");
                }
                asm volatile("" ::: "memory"); __builtin_amdgcn_s_barrier(); asm volatile("" ::: "memory");
            }
        }
    }
    __device__ __forceinline__ void done(const Unit& u) const {
        if constexpr (KIND == GK_INPROJ && S1_IN_G1) { if (u.k2 == 0 && (u.pn == 3 || u.pn == 4)) wave_arrive(d.ws, CW_U + 64 * (d.layer * 8 + (u.pm < 32 ? 0 : u.pm < 64 ? 1 : 2) * 2 + (u.pn - 3))); }
        if constexpr (KIND == GK_S1 && S2_FUSED) wave_arrive(d.ws, CW_S1 + 64 * (d.layer * 32 + u.aux));
        if constexpr (KIND == GK_E2A) { if (u.aux == 0) wave_arrive(d.ws, CW_E2 + 64 * (d.layer * 160 + u.pm)); else if (u.aux == 2) wave_arrive(d.ws, CW_E2 + 64 * (d.layer * 160 + 66 + u.pm)); }
        if constexpr (KIND == GK_MOE) {
            if (u.k2 == 0) {
                asm volatile("s_waitcnt vmcnt(0)" ::: "memory");
                if ((threadIdx.x & 63) == 0) __hip_atomic_fetch_add((gu32*)(d.ws + WS_CTL) + CW_RDY + 64 * (d.layer * 256 + u.pm), 1u, RLX_AGENT);
            }
        }
    }
    __device__ __forceinline__ bool next(int i, Unit& u) const {
        unsigned char* ws = d.ws; int pm, pn, aux = 0; size_t ao, bo;
        switch (KIND) {
#if S1_IN_G1
        case GK_INPROJ: {
            const int nctx = d.layer == 0 ? 26 : 6, total = 64 * 13 + nctx, L = i * d.G + d.c;
            if (L >= total) { const int n1 = d.c < total ? (total - 1 - d.c) / d.G + 1 : 0, j = (i - n1) * d.G + (d.G - 1 - d.c); if (j >= NG * 3) return false;
                aux = j / 3; pm = j % 3; pn = 0;
                u.pm = pm; u.pn = pn; u.aux = aux; u.k2 = 1; u.A = (const char*)ws + B_A3 + (size_t)(aux * NCH + pm * 256) * 768 * 2; u.B = (const char*)ws + W_SE + (size_t)(aux * 256) * 512 * 2; return true; }
            if (L < nctx) { if (d.layer == 0) { pm = 64 + L / 13; pn = L % 13; } else { pm = 64 + L / 3; pn = 2 + L % 3; } }
            else pg8::tile_of(L - nctx, 64, 13, pm, pn);
            ao = WS_H + (size_t)pm * 256 * D * 2; bo = W_IN + (size_t)pn * 256 * D * 2; } break;
#else
        case GK_INPROJ: { const int L = i * d.G + d.c;
            if (L < 64 * 13) pg8::tile_of(L, 64, 13, pm, pn);
            else { const int k = L - 64 * 13; if (d.layer == 0) { if (k >= 26) return false; pm = 64 + k / 13; pn = k % 13; } else { if (k >= 6) return false; pm = 64 + k / 3; pn = 2 + k % 3; } }
            ao = WS_H + (size_t)pm * 256 * D * 2; bo = W_IN + (size_t)pn * 256 * D * 2; } break;
#endif
        case GK_S1: { const int L = i * d.G + (S2_FUSED ? (d.G - 1 - d.vc) : d.vc); if (L >= NG * 3) return false; aux = L / 3; pm = L % 3; pn = 0;
            ao = B_A3 + (size_t)(aux * NCH + pm * 256) * 768 * 2; bo = W_SE + (size_t)(aux * 256) * 512 * 2; } break;
        case GK_S3: { const int L = i * d.G + d.vc; if (L >= NG * 6) return false; aux = L / 6; const int rem = L % 6; pm = rem >> 1; pn = rem & 1;
            ao = B_A3 + (size_t)(aux * NCH + pm * 256) * 768 * 2; bo = W_S3 + (size_t)(aux * 512 + pn * 256) * 768 * 2; } break;
        case GK_GLU: { const int L = i * d.G + d.c; if (L >= d.nM * 2) return false; pg8::tile_of(L, d.nM, 2, pm, pn);
            ao = B_Z + (size_t)pm * 256 * 512 * 2; bo = W_GLU + (size_t)pn * 256 * 512 * 2; } break;
        case GK_BR: { const int Lp = (i >> 1) * d.G + d.c; aux = i & 1; if (Lp >= d.nM * 4) return false; pg8::tile_of(Lp, d.nM, 4, pm, pn);
            ao = (aux ? B_SG : B_ATT) + (size_t)pm * 256 * 512 * 2; bo = (aux ? W_BRS : W_BRA) + (size_t)pn * 256 * 512 * 2; } break;
        case GK_OUT: { const int L = i * d.G + d.c; if (L >= d.nM * 4) return false; pg8::tile_of(L, d.nM, 4, pm, pn);
            ao = B_MB + (size_t)pm * 256 * D * 2; bo = W_OUT + (size_t)pn * 256 * D * 2; } break;
        case GK_E2A: {
            const int G = d.G, c = d.c, NGL = d.nM * 2, nglu = c < NGL ? (NGL - 1 - c) / G + 1 : 0;
            if (i < nglu) { const int L = i * G + c; pg8::tile_of(L, d.nM, 2, pm, pn); aux = 0; ao = B_Z + (size_t)pm * 256 * 512 * 2; bo = W_GLU + (size_t)pn * 256 * 512 * 2; }
            else { const int k = i - nglu, Lp = (k >> 1) * G + c; if (Lp >= 256) return false; aux = 1 + (k & 1); pg8::tile_of(Lp, 64, 4, pm, pn);
                ao = (aux == 2 ? B_SG : B_ATT) + (size_t)pm * 256 * 512 * 2; bo = (aux == 2 ? W_BRS : W_BRA) + (size_t)pn * 256 * 512 * 2; } } break;
        case GK_E2B: { const int L = i * d.G + d.c; if (L >= 256) return false; pg8::tile_of(L, 64, 4, pm, pn);
            ao = B_MB + (size_t)pm * 256 * D * 2; bo = W_OUT + (size_t)pn * 256 * D * 2; } break;
        case GK_MOE: {
            const int G = d.G, vc = d.vc, U = tp[NE] * 4, q = U / G, r = U % G, nmu = q + (vc < r ? 1 : 0);
            int L, k2;
            if (i < nmu) { L = i * G + vc; k2 = 0; }
            else { const int k = i - nmu; int first = 2 * (G - r); if (first > U) first = U; k2 = 1;
                if (vc >= r && k < 2) { L = k * (G - r) + (vc - r); if (L >= first) return false; }
                else { const int kb = vc >= r ? k - 2 : k; L = first + kb * G + vc; if (L >= U) return false; } }
            pm = L >> 2; pn = L & 3;
            int e = 0;
#pragma unroll 1
            for (int kk = 1; kk < NE; ++kk) if (tp[kk] <= pm) e = kk;
            aux = e;
            if (k2 == 0) { ao = B_HS + (size_t)pm * 256 * D * 2; bo = W_GU + (size_t)e * 1024 * 1024 * 2 + (size_t)pn * 256 * D * 2; }
            else { ao = B_ACT + (size_t)pm * 256 * DE * 2; bo = W_DN + (size_t)e * 1024 * 512 * 2 + (size_t)pn * 256 * DE * 2; }
            u.pm = pm; u.pn = pn; u.aux = aux; u.k2 = k2; u.A = (const char*)ws + ao; u.B = (const char*)ws + bo; return true; }
        default: {
            const int L = i * d.G + d.vc, TT = tp[NE]; if (L >= TT * 4) return false; pm = L >> 2; pn = L & 3;
            int e = 0;
#pragma unroll 1
            for (int k = 1; k < NE; ++k) if (tp[k] <= pm) e = k;
            aux = e;
            if (KIND == GK_MU) { ao = B_HS + (size_t)pm * 256 * D * 2; bo = W_GU + (size_t)e * 1024 * 1024 * 2 + (size_t)pn * 256 * D * 2; }
            else { ao = B_ACT + (size_t)pm * 256 * DE * 2; bo = W_DN + (size_t)e * 1024 * 512 * 2 + (size_t)pn * 256 * DE * 2; } } break;
        }
        u.pm = pm; u.pn = pn; u.aux = aux; u.k2 = 0; u.A = (const char*)ws + ao; u.B = (const char*)ws + bo; return true;
    }
};

#ifndef PHMASK
#define PHMASK 0xFFFFFFFFu
#endif
#define PHON(b) (((PHMASK) >> (b)) & 1u)
struct Args { Inputs in; float* out; unsigned char* ws; int ph_lo, ph_hi; };
enum { T_P0 = 0, T_N1, T_G1, T_AT, T_S2, T_S3, T_GLU, T_BR, T_OUT, T_N2, T_MG, T_MU, T_MD, T_FINAL };
constexpr int PH_PER_LAYER = 12, PH_FINAL = 1 + 2 * PH_PER_LAYER, N_PHASES = PH_FINAL + 1;
__global__ void __launch_bounds__(NWAVES * 64, 2) mega_fwd(Args args) {
    extern __shared__ __attribute__((aligned(16))) unsigned char lds[];
    Frame F;
    F.lds = (LAS unsigned char*)lds;
    F.tid = threadIdx.x; F.lane = F.tid & 63; F.wave = __builtin_amdgcn_readfirstlane(F.tid >> 6);
    F.G = gridDim.x; { const int bx = blockIdx.x; F.vcu = (F.G % 8 == 0) ? (bx % 8) * (F.G / 8) + bx / 8 : bx; }
    F.ws = args.ws; F.ctl = (gu32*)(args.ws + WS_CTL); F.out = args.out;
    const Inputs& I = args.in;
    for (int u = F.tid; u < (LDS_BYTES - LDSCTL_OFF) / 4; u += NWAVES * 64) ((LAS unsigned*)(F.lds + LDSCTL_OFF))[u] = 0u;
    __syncthreads();
    const int lo = args.ph_lo & 0xff, hi = args.ph_hi, dbgf = args.ph_lo >> 8;
    XcdBarrier bar; bar.bar = (unsigned*)(F.ctl + CW_BAR); bar.x = 0; bar.st = nullptr;
    if (hi - lo > 1) bar = xcd_barrier_post((unsigned*)(F.ctl + CW_BAR), (volatile LAS unsigned*)(F.lds + L_BARST));
#ifdef TSTAMP
    if (blockIdx.x == 0 && threadIdx.x == 0) ((unsigned long long*)(F.ws + 131072))[0] = __builtin_amdgcn_s_memrealtime();
#endif
#pragma unroll 1
    for (int ph = lo; ph < hi; ++ph) {
        int t, l;
        { unsigned char* w_ = F.ws; gu32* c_ = F.ctl; float* o_ = F.out; LAS unsigned char* l_ = F.lds; int v_ = F.vcu, g_ = F.G;
          asm volatile("" : "+s"(w_), "+s"(c_), "+s"(o_), "+s"(l_), "+s"(v_), "+s"(g_)); F.ws = w_; F.ctl = c_; F.out = o_; F.lds = l_; F.vcu = v_; F.G = g_;
          int t_ = threadIdx.x; asm volatile("" : "+v"(t_)); F.tid = t_; F.lane = t_ & 63; F.wave = __builtin_amdgcn_readfirstlane(t_ >> 6); }
        if (ph == 0) { t = T_P0; l = 0; } else if (ph == PH_FINAL) { t = T_FINAL; l = 1; } else { l = (ph - 1) / PH_PER_LAYER; t = (ph - 1) % PH_PER_LAYER + 1; }
        if (t == T_P0 || (t == T_N1 && l == 1)) {
            if (PHON(0) && !(dbgf & 1) && F.vcu < NG) ssmgen_job(F, I, l, F.vcu);
            if (t == T_P0 && !(dbgf & 4)) { if (PHON(1) && F.vcu >= NG && F.vcu < NG + 192) mod_item(F, I, F.vcu - NG); if (PHON(2)) p0_small(F, I); }
            if (PHON(3) && !(dbgf & 2)) convert_weights(F, I, l);
        }
        if (t == T_N1) { if (PHON(4)) phase_norm1(F, I, l); }
        else if (t >= T_G1 && t <= T_MD && t != T_S2 && t != T_N2 && t != T_MG) {
            GemmDesc d; d.layer = l; d.G = F.G; d.c = (int)blockIdx.x; d.vc = F.vcu; d.nM = l == 0 ? 66 : 64; d.ws = F.ws;
            d.xlat = l == 0 ? I.x : (const float*)(F.ws + WS_XC); d.xctx = l == 0 ? I.ctx : (const float*)(F.ws + WS_XC) + (size_t)NTOK * D;
#ifdef SUBSTAMP
#define SUBST(id) do { if (l == 0 && threadIdx.x == 0 && (blockIdx.x == 0 || blockIdx.x == 255)) ((unsigned long long*)(F.ws + 131072 + 1024))[(blockIdx.x == 0 ? 0 : 16) + (id)] = __builtin_amdgcn_s_memrealtime(); } while (0)
#else
#define SUBST(id) do {} while (0)
#endif
            if (t == T_MU || (t == T_MD && !MOE_FUSED)) moe_tables(F, l);
            const volatile LAS int* tp = (const volatile LAS int*)(F.lds + L_MOETAB);
#define RUN_GEMM(KIND_, K_, LDA_, LDB_) do { d.kind = KIND_; SchedAll<KIND_> Sc{d, tp}; EpiAll<KIND_> E{d}; pg8::gemm_phase<EpiAll<KIND_>, SchedAll<KIND_>, GEMM_ALIGN, GEMM_SP2>(F.lds, K_, LDA_, LDB_, Sc, E); } while (0)
            switch (t) {
#if S1_IN_G1
            case T_G1: if (PHON(5)) { d.kind = GK_INPROJ; SchedAll<GK_INPROJ> Sc{d, tp}; EpiAll<GK_INPROJ> E{d}; pg8::gemm_phase<EpiAll<GK_INPROJ>, SchedAll<GK_INPROJ>, GEMM_ALIGN, true>(F.lds, D, D, D, Sc, E, 512, 768, 512); } break;
            case T_AT: break;
#else
            case T_G1: if (PHON(5)) RUN_GEMM(GK_INPROJ, D, D, D); break;
            case T_AT: SUBST(0); if (PHON(6)) RUN_GEMM(GK_S1, 512, 768, 512); SUBST(1); break;
#endif
            case T_S3: if (PHON(10)) RUN_GEMM(GK_S3, 768, 768, 768); break;
#if E2_FUSED
            case T_GLU: if (PHON(11)) { RUN_GEMM(GK_E2A, 512, 512, 512);
                    if (l == 0) { wg_wait_count(F.ws, CW_E2 + 64 * (0 * 160 + 64 + (F.vcu >> 7)), 16u); ctx_small_gemm(F, I, 0); }
                    RUN_GEMM(GK_E2B, D, D, D);
                    if (l == 0) { wg_wait_count(F.ws, CW_E2 + 64 * (0 * 160 + 130 + (F.vcu >> 4)), 32u); ctx_small_gemm(F, I, 1); } } break;
            case T_BR: case T_OUT: break;
#else
            case T_GLU: if (PHON(11)) RUN_GEMM(GK_GLU, 512, 512, 512); break;
            case T_BR: d.nM = 64; if (PHON(12)) RUN_GEMM(GK_BR, 512, 512, 512); if (l == 0) ctx_small_gemm(F, I, 0); break;
            case T_OUT: d.nM = 64; if (PHON(13)) RUN_GEMM(GK_OUT, D, D, D); if (l == 0) ctx_small_gemm(F, I, 1); break;
#endif
#if MOE_FUSED
            case T_MU: if (PHON(16)) { d.kind = GK_MOE; SchedAll<GK_MOE> Sc{d, tp}; EpiAll<GK_MOE> E{d}; pg8::gemm_phase<EpiAll<GK_MOE>, SchedAll<GK_MOE>, GEMM_ALIGN, true>(F.lds, D, D, D, Sc, E, DE, DE, DE); } break;
            default: break;
#else
            case T_MU: if (PHON(16)) RUN_GEMM(GK_MU, D, D, D); break;
            default: if (PHON(17)) RUN_GEMM(GK_MD, DE, DE, DE); break;
#endif
            }
#undef RUN_GEMM
            if (t == T_AT && PHON(7)) phase_attn_latent(F, I, l);
            if (t == T_AT) SUBST(2);
#if S2_FUSED
            if (t == T_AT) { if (F.vcu < 128) { if (!S1_IN_G1) wg_wait_count(F.ws, CW_S1 + 64 * (l * 32 + (F.vcu >> 2)), 24u); if (PHON(8)) phase_ssm_carry(F, l); } if (PHON(9) && l == 0) phase_attn_ctx(F, I, l, 128); SUBST(3); }
#endif
        }
        else if (t == T_S2) {
#if !S2_FUSED
            if (PHON(8)) phase_ssm_carry(F, l); if (PHON(9) && l == 0) phase_attn_ctx(F, I, l, 128);
#endif
        }
        else if (t == T_N2) { if (PHON(14)) phase_norm2_route(F, I, l, dbgf); }
        else if (t == T_MG) { if (PHON(15)) phase_gather(F, l); }
        else if (t == T_FINAL) { if (PHON(18)) phase_final(F, I); }
        if (ph + 1 < hi && !(MOE_FUSED && t == T_MD) && !(E2_FUSED && (t == T_BR || t == T_OUT)) && !(S2_FUSED && t == T_S2)) { bar.bar = (unsigned*)(F.ctl + CW_BAR); xcd_barrier(bar);
#ifdef DOUBLE_BAR
            xcd_barrier(bar); xcd_barrier(bar);
#endif
        }
#ifdef TSTAMP
        if (blockIdx.x == 0 && threadIdx.x == 0) ((unsigned long long*)(F.ws + 131072))[1 + ph] = __builtin_amdgcn_s_memrealtime();
#endif
    }
#if defined(TSTAMP) && defined(TS_SPIN_SET)
    if (blockIdx.x == 0 && threadIdx.x == 0) {
        const unsigned long long* ts = (const unsigned long long*)(F.ws + 131072); unsigned long long d = 0;
        for (int p = 0; p < N_PHASES; ++p) if (((unsigned long long)(TS_SPIN_SET) >> p) & 1ull) d += ts[1 + p] - ts[p];
#ifdef SUBSTAMP
        { const unsigned long long* t2 = (const unsigned long long*)(F.ws + 131072 + 1024); d += t2[SUB_B] - t2[SUB_A]; }
#endif
        const unsigned long long t0 = __builtin_amdgcn_s_memrealtime(), want = d * (TS_SPIN_K);
        while (__builtin_amdgcn_s_memrealtime() - t0 < want) __builtin_amdgcn_s_sleep(16);
    }
#endif
}

#ifdef DBG_STOP
__global__ void dbg_copy(const unsigned char* ws, float* out, size_t n) {
    for (size_t i = (size_t)blockIdx.x * blockDim.x + threadIdx.x; i < n; i += (size_t)gridDim.x * blockDim.x) {
        const size_t j = i % (size_t)(DBG_ELEMS);
#ifdef DBG_F32
        out[i] = ((const float*)(ws + (DBG_OFF)))[j];
#else
        out[i] = __uint_as_float((unsigned)((const unsigned short*)(ws + (DBG_OFF)))[j] << 16);
#endif
    }
}
#endif
#ifdef TSTAMP
__global__ void dbg_times(const unsigned char* ws, float* out, size_t n, unsigned set1, unsigned set2) {
    const unsigned long long* ts = (const unsigned long long*)(ws + 131072);
    unsigned long long s1 = 0, s2 = 0;
    for (int p = 0; p < N_PHASES; ++p) { const unsigned long long d = ts[1 + p] - ts[p]; if ((set1 >> p) & 1) s1 += d; if ((set2 >> p) & 1) s2 += d; }
    const float v1 = sqrtf((float)s1), v2 = (float)s2;
    for (size_t i = (size_t)blockIdx.x * blockDim.x + threadIdx.x; i < n; i += (size_t)gridDim.x * blockDim.x) out[i] = i == 0 ? v2 : v1;
}
#endif
#if defined(REP_SET) && defined(REP_FLUSH)
__global__ void dbg_flush(const float* p, size_t n, float* sink) {
    float a = 0.f;
    for (size_t i = (size_t)blockIdx.x * blockDim.x + threadIdx.x; i < n; i += (size_t)gridDim.x * blockDim.x) a += p[i];
    if (a == 12345.678f) sink[0] = a;
}
#endif
extern "C" void kernel_launch(void* const* d_in, const int* in_sizes, int n_in, void* d_out, int out_size, void* d_ws, size_t ws_size, hipStream_t stream) {
    static int grid = 0;
    if (grid == 0) {
        int dev = 0, cus = 0, per_cu = 0;
        if (n_in != 28 || out_size != NTOK * D || ws_size < WS_END) { grid = -1; return; }
        if (hipGetDevice(&dev) != hipSuccess || hipDeviceGetAttribute(&cus, hipDeviceAttributeMultiprocessorCount, dev) != hipSuccess) { grid = -1; return; }
        if (hipFuncSetAttribute((const void*)mega_fwd, hipFuncAttributeMaxDynamicSharedMemorySize, LDS_BYTES) != hipSuccess) { grid = -1; return; }
        if (hipOccupancyMaxActiveBlocksPerMultiprocessor(&per_cu, (const void*)mega_fwd, NWAVES * 64, LDS_BYTES) != hipSuccess || per_cu < 1) { (void)hipGetLastError(); grid = -1; return; }
        (void)hipGetLastError();
        grid = cus;
    }
    if (grid < 0) return;
    (void)hipMemsetAsync((char*)d_ws + WS_CTL, 0, CTL_ZERO_BYTES, stream);
    Args a{};
    const float** ip = (const float**)&a.in;
    for (int i = 0; i < 28; ++i) ip[i] = (const float*)d_in[i];
    a.out = (float*)d_out; a.ws = (unsigned char*)d_ws;
#ifdef DBG_STOP
    for (int p = 0; p <= (DBG_STOP); ++p) { a.ph_lo = p; a.ph_hi = p + 1; hipLaunchKernelGGL(mega_fwd, dim3(grid), dim3(NWAVES * 64), LDS_BYTES, stream, a); }
    hipLaunchKernelGGL(dbg_copy, dim3(2048), dim3(256), 0, stream, (const unsigned char*)d_ws, (float*)d_out, (size_t)out_size);
#elif defined(REP_SET)
#ifndef REP_FLAGS
#define REP_FLAGS 0
#endif
    for (int p = 0; p < N_PHASES; ++p) {
        const int n = (((unsigned long long)(REP_SET) >> p) & 1ull) ? 1 + (REP_N) : 1;
        for (int k = 0; k < n; ++k) {
            if (k > 0 && p == 0) (void)hipMemsetAsync((char*)d_ws + (CW_WORK) * 4, 0, 256, stream);
            if (k > 0 && (p == 9 || p == 21)) (void)hipMemsetAsync((char*)d_ws + (CW_CNT + 64 * (p == 21)) * 4, 0, 128, stream);
#ifdef REP_FLUSH
            if (n > 1 || (REP_FLUSH) == 2) for (int f_ = 24; f_ <= 26; ++f_) hipLaunchKernelGGL(dbg_flush, dim3(2048), dim3(256), 0, stream, (const float*)d_in[f_], (size_t)32 * 1024 * 1024, (float*)d_ws + 1000);
#endif
            a.ph_lo = p | (k > 0 ? ((REP_FLAGS) << 8) : 0); a.ph_hi = p + 1; hipLaunchKernelGGL(mega_fwd, dim3(grid), dim3(NWAVES * 64), LDS_BYTES, stream, a);
        }
    }
#elif MK_PER_PHASE
    for (int p = 0; p < N_PHASES; ++p) { a.ph_lo = p; a.ph_hi = p + 1; hipLaunchKernelGGL(mega_fwd, dim3(grid), dim3(NWAVES * 64), LDS_BYTES, stream, a); }
#else
    a.ph_lo = 0; a.ph_hi = N_PHASES;
    hipLaunchKernelGGL(mega_fwd, dim3(grid), dim3(NWAVES * 64), LDS_BYTES, stream, a);
#if defined(TSTAMP) && !defined(TS_SPIN_SET)
    hipLaunchKernelGGL(dbg_times, dim3(1024), dim3(256), 0, stream, (const unsigned char*)d_ws, (float*)d_out, (size_t)out_size, (unsigned)(TS_SET1), (unsigned)(TS_SET2));
#endif
#endif
}
```

```cpp
#include <hip/hip_runtime.h>
#include <cstdint>
#include <cmath>
#ifndef MK_PER_PHASE
#define MK_PER_PHASE 0
#endif
__device__ __forceinline__ int lane_now() { int l; asm volatile("v_mbcnt_lo_u32_b32 %0, -1, 0\n\tv_mbcnt_hi_u32_b32 %0, -1, %0" : "=v"(l)); return l; }
__device__ __forceinline__ float xor32_f(float x, int lane) { return __int_as_float(__builtin_amdgcn_ds_bpermute((lane ^ 32) << 2, __float_as_int(x))); }
namespace pg8 {
#define PG8_LAS __attribute__((address_space(3)))
typedef unsigned short bf16_t;
typedef short bf16x8 __attribute__((ext_vector_type(8)));
typedef float f32x4 __attribute__((ext_vector_type(4)));
typedef float f32x2 __attribute__((ext_vector_type(2)));
typedef unsigned u32x4 __attribute__((ext_vector_type(4)));
typedef unsigned u32x2 __attribute__((ext_vector_type(2)));
constexpr int BM = 256, BK = 64, HALF = 128, HTB = HALF * BK * 2, STAGE_BYTES = 8 * HTB, NXCD = 8, WGM = 8;

__host__ __device__ __forceinline__ int lds_byte(int r, int c) { const int st = (r >> 4) * 2 + (c >> 5), rr = r & 15, cc = c & 31, ob = rr * 64 + cc * 2; return st * 1024 + (ob ^ (((ob >> 9) & 1) << 5)); }
__host__ __device__ __forceinline__ void stage_rc(int b, int& R, int& C) { const int st = b / 1024, sb = b % 1024, swz = sb ^ (((sb >> 9) & 1) << 5); R = (st >> 1) * 16 + swz / 64; C = (st & 1) * 32 + (swz % 64) / 2; }
__host__ __device__ __forceinline__ int perm32(int rho) { const int n = rho >> 4, i = rho & 15; return 8 * (i >> 2) + 4 * n + (i & 3); }

struct Unit { const char* A; const char* B; int pm, pn, aux, k2; };
typedef __bf16 bf16x2_t __attribute__((ext_vector_type(2)));
__device__ __forceinline__ unsigned cvt_pk_bf16(float lo, float hi) { f32x2 v = {lo, hi}; bf16x2_t b = __builtin_convertvector(v, bf16x2_t); return __builtin_bit_cast(unsigned, b); }
__device__ __forceinline__ float bf_lo(unsigned w) { return __uint_as_float(w << 16); }
__device__ __forceinline__ float bf_hi(unsigned w) { return __uint_as_float(w & 0xffff0000u); }

__device__ __forceinline__ void tile_of(int L, int nM, int nN, int& pm, int& pn) {
    const int nwg = nM * nN; int wgid = L;
    { const int q = nwg / NXCD, r = nwg % NXCD, xcd = wgid % NXCD, off = wgid / NXCD; wgid = (xcd < r ? xcd * (q + 1) : r * (q + 1) + (xcd - r) * q) + off; }
    const int nig = WGM * nN, gid = wgid / nig, fm = gid * WGM, gsz = (nM - fm) < WGM ? (nM - fm) : WGM;
    pm = fm + ((wgid % nig) % gsz); pn = (wgid % nig) / gsz;
}

template <class Epi, class Sched, bool ALIGN_EPI, bool SP2>
__device__ __forceinline__ void gemm_phase(PG8_LAS unsigned char* lds, const int K, const int lda, const int ldb, const Sched& S, const Epi& E, const int K1 = 0, const int lda1 = 0, const int ldb1 = 0) {
    constexpr bool VARK = Sched::VARK;
    static_assert(!VARK || SP2, "variable-shape units use the SP2 loop");
    int tid_ = S.wave_index() * 64 + lane_now(); asm volatile("" : "+v"(tid_));
    const int tid = tid_, wid = __builtin_amdgcn_readfirstlane(tid >> 6), lane = tid & 63, wr = wid >> 2, wc = wid & 3, fr = lane & 15, fq = lane >> 4;
    unsigned voffA0[2], voffB0[2], voffA1[2], voffB1[2];
#pragma unroll
    for (int i = 0; i < 2; ++i) { int R, C; stage_rc(tid * 16 + i * 8192, R, C); const int Rb = Epi::PERM ? ((R & ~31) + perm32(R & 31)) : R;
        voffA0[i] = (unsigned)(R * lda + C) * 2u; voffB0[i] = (unsigned)(Rb * ldb + C) * 2u;
        voffA1[i] = VARK ? (unsigned)(R * lda1 + C) * 2u : 0u; voffB1[i] = VARK ? (unsigned)(Rb * ldb1 + C) * 2u : 0u; }
    const size_t kstep = (size_t)(BK * 2);
    const size_t hstepA0 = (size_t)HALF * lda * 2, hstepB0 = (size_t)HALF * ldb * 2, hstepA1 = (size_t)HALF * lda1 * 2, hstepB1 = (size_t)HALF * ldb1 * 2;
    const unsigned ldsw = (unsigned)wid * 1024u;
    const int aoff = lds_byte(wr * 64 + fr, fq * 8), boff = lds_byte(wc * 32 + fr, fq * 8);
#define PG8_SA(b, h) (((b) * 2 + (h)) * HTB)
#define PG8_SB(b, h) ((4 + (b) * 2 + (h)) * HTB)
#define PG8_STAGE(bufoff, gbase, voff) do { _Pragma("unroll") for (int _i = 0; _i < 2; ++_i) \
        __builtin_amdgcn_global_load_lds((const unsigned*)((const char*)(gbase) + (voff)[_i]), (PG8_LAS unsigned*)(lds + (bufoff) + ldsw + _i * 8192), 16, 0, 0); } while (0)
#define PG8_LDA(dst, b, h) do { _Pragma("unroll") for (int m = 0; m < 4; ++m) _Pragma("unroll") for (int k = 0; k < 2; ++k) dst[m][k] = *(const PG8_LAS bf16x8*)(lds + PG8_SA(b, h) + aoff + m * 2048 + k * 1024); } while (0)
#define PG8_LDB(dst, b, h) do { _Pragma("unroll") for (int n = 0; n < 2; ++n) _Pragma("unroll") for (int k = 0; k < 2; ++k) dst[n][k] = *(const PG8_LAS bf16x8*)(lds + PG8_SB(b, h) + boff + n * 2048 + k * 1024); } while (0)
#define PG8_MMA(ai, bj, At, Bt) do { __builtin_amdgcn_s_setprio(1); _Pragma("unroll") for (int m = 0; m < 4; ++m) _Pragma("unroll") for (int n = 0; n < 2; ++n) _Pragma("unroll") for (int k = 0; k < 2; ++k) \
        acc[ai][bj][m][n] = __builtin_amdgcn_mfma_f32_16x16x32_bf16(Bt[n][k], At[m][k], acc[ai][bj][m][n], 0, 0, 0); __builtin_amdgcn_s_setprio(0); } while (0)
#define PG8_WAIT_V(n) asm volatile("s_waitcnt vmcnt(" #n ")" ::: "memory")
#define PG8_WAIT_L(n) asm volatile("s_waitcnt lgkmcnt(" #n ")" ::: "memory")
#define PG8_BAR __builtin_amdgcn_s_barrier()
#define PG8_SCHED __builtin_amdgcn_sched_barrier(0)
    Unit cur, nxt; int ui = 0;
    if (!S.next(0, cur)) return;
    f32x4 acc[2][2][4][2];
#pragma unroll
    for (int a = 0; a < 2; ++a)
#pragma unroll
        for (int b = 0; b < 2; ++b)
#pragma unroll
            for (int m = 0; m < 4; ++m)
#pragma unroll
                for (int n = 0; n < 2; ++n) acc[a][b][m][n] = (f32x4){0.f, 0.f, 0.f, 0.f};
    bf16x8 At[4][2], B0[2][2], B1[2][2];
    const char* cA = cur.A; const char* cB = cur.B;
    S.a_ready(cur);
#define PG8_SEL(k2_, a0, a1) ((VARK && (k2_)) ? (a1) : (a0))
    unsigned voffA[2] = {PG8_SEL(cur.k2, voffA0[0], voffA1[0]), PG8_SEL(cur.k2, voffA0[1], voffA1[1])}, voffB[2] = {PG8_SEL(cur.k2, voffB0[0], voffB1[0]), PG8_SEL(cur.k2, voffB0[1], voffB1[1])};
    size_t hstepA = PG8_SEL(cur.k2, hstepA0, hstepA1), hstepB = PG8_SEL(cur.k2, hstepB0, hstepB1);
    int nt = PG8_SEL(cur.k2, K, K1) / BK;
    if constexpr (SP2) {
        PG8_STAGE(PG8_SB(0, 0), cB, voffB); PG8_STAGE(PG8_SB(0, 1), cB + hstepB, voffB); PG8_STAGE(PG8_SA(0, 0), cA, voffA); PG8_STAGE(PG8_SA(0, 1), cA + hstepA, voffA);
        if (wr == 1) PG8_BAR;
        PG8_WAIT_V(2); PG8_BAR;
        PG8_STAGE(PG8_SB(1, 0), cB + kstep, voffB); PG8_STAGE(PG8_SA(1, 0), cA + kstep, voffA); PG8_STAGE(PG8_SB(1, 1), cB + hstepB + kstep, voffB);
        PG8_WAIT_V(6); PG8_BAR;
    } else {
        PG8_STAGE(PG8_SB(0, 0), cB, voffB); PG8_STAGE(PG8_SA(0, 0), cA, voffA); PG8_STAGE(PG8_SB(0, 1), cB + hstepB, voffB); PG8_STAGE(PG8_SA(0, 1), cA + hstepA, voffA);
        if (wr == 1) PG8_BAR;
        PG8_WAIT_V(4); PG8_BAR;
        PG8_STAGE(PG8_SB(1, 0), cB + kstep, voffB); PG8_STAGE(PG8_SA(1, 0), cA + kstep, voffA); PG8_STAGE(PG8_SB(1, 1), cB + hstepB + kstep, voffB);
        PG8_WAIT_V(6); PG8_BAR;
    }
    for (;;) {
        const bool has_next = S.next(ui + 1, nxt);
        const char* nA = has_next ? nxt.A : cA; const char* nB = has_next ? nxt.B : cB;
        const int k2n = has_next ? nxt.k2 : cur.k2;
        for (int t = 0; t < nt; t += 2) {
            const bool last = (t == nt - 2);
            if (last && has_next) S.a_ready(nxt);
            unsigned voffAx[2], voffBx[2]; size_t hstepAx, hstepBx;
            if (VARK && last) { voffAx[0] = PG8_SEL(k2n, voffA0[0], voffA1[0]); voffAx[1] = PG8_SEL(k2n, voffA0[1], voffA1[1]); voffBx[0] = PG8_SEL(k2n, voffB0[0], voffB1[0]); voffBx[1] = PG8_SEL(k2n, voffB0[1], voffB1[1]);
                hstepAx = PG8_SEL(k2n, hstepA0, hstepA1); hstepBx = PG8_SEL(k2n, hstepB0, hstepB1); }
            else { voffAx[0] = voffA[0]; voffAx[1] = voffA[1]; voffBx[0] = voffB[0]; voffBx[1] = voffB[1]; hstepAx = hstepA; hstepBx = hstepB; }
            const char* a1 = cA + (size_t)(t + 1) * kstep;
            const char* a2 = last ? nA : cA + (size_t)(t + 2) * kstep; const char* b2 = last ? nB : cB + (size_t)(t + 2) * kstep;
            const char* a3 = a2 + kstep; const char* b3 = b2 + kstep;
            if constexpr (SP2) {
            PG8_LDB(B0, 0, 0); PG8_LDB(B1, 0, 1); PG8_SCHED; PG8_LDA(At, 0, 0); PG8_STAGE(PG8_SA(1, 1), a1 + hstepA, voffA);
            PG8_WAIT_V(8); PG8_WAIT_L(0); PG8_BAR; PG8_MMA(0, 0, At, B0); PG8_MMA(0, 1, At, B1); PG8_BAR; PG8_SCHED;
            PG8_LDA(At, 0, 1); PG8_STAGE(PG8_SB(0, 0), b2, voffBx); PG8_STAGE(PG8_SB(0, 1), b2 + hstepBx, voffBx); PG8_STAGE(PG8_SA(0, 0), a2, voffAx);
            PG8_WAIT_V(8); PG8_WAIT_L(0); PG8_BAR; PG8_MMA(1, 0, At, B0); PG8_MMA(1, 1, At, B1); PG8_BAR; PG8_SCHED;
            PG8_LDB(B0, 1, 0); PG8_LDB(B1, 1, 1); PG8_SCHED; PG8_LDA(At, 1, 0); PG8_STAGE(PG8_SA(0, 1), a2 + hstepAx, voffAx);
            PG8_WAIT_V(8); PG8_WAIT_L(0); PG8_BAR; PG8_MMA(0, 0, At, B0); PG8_MMA(0, 1, At, B1); PG8_BAR; PG8_SCHED;
            PG8_LDA(At, 1, 1); PG8_STAGE(PG8_SB(1, 0), b3, voffBx); PG8_STAGE(PG8_SB(1, 1), b3 + hstepBx, voffBx); PG8_STAGE(PG8_SA(1, 0), a3, voffAx);
            PG8_WAIT_V(8); PG8_WAIT_L(0); PG8_BAR; PG8_MMA(1, 0, At, B0); PG8_MMA(1, 1, At, B1); PG8_BAR; PG8_SCHED;
            } else {
            PG8_LDB(B0, 0, 0); PG8_SCHED; PG8_LDA(At, 0, 0); PG8_STAGE(PG8_SA(1, 1), a1 + hstepA, voffA);
            PG8_WAIT_L(8); PG8_BAR; PG8_WAIT_L(0); PG8_MMA(0, 0, At, B0); PG8_BAR; PG8_SCHED;
            PG8_LDB(B1, 0, 1); PG8_STAGE(PG8_SB(0, 0), b2, voffB);
            PG8_BAR; PG8_WAIT_L(0); PG8_MMA(0, 1, At, B1); PG8_BAR;
            PG8_LDA(At, 0, 1); PG8_STAGE(PG8_SA(0, 0), a2, voffA);
            PG8_BAR; PG8_WAIT_L(0); PG8_MMA(1, 0, At, B0); PG8_BAR; PG8_SCHED;
            PG8_STAGE(PG8_SB(0, 1), b2 + hstepB, voffB);
            PG8_WAIT_V(6); PG8_BAR; PG8_MMA(1, 1, At, B1); PG8_BAR;
            PG8_LDB(B0, 1, 0); PG8_SCHED; PG8_LDA(At, 1, 0); PG8_STAGE(PG8_SA(0, 1), a2 + hstepA, voffA);
            PG8_WAIT_L(8); PG8_BAR; PG8_WAIT_L(0); PG8_MMA(0, 0, At, B0); PG8_BAR; PG8_SCHED;
            PG8_LDB(B1, 1, 1); PG8_STAGE(PG8_SB(1, 0), b3, voffB);
            PG8_BAR; PG8_WAIT_L(0); PG8_MMA(0, 1, At, B1); PG8_BAR;
            PG8_LDA(At, 1, 1); PG8_STAGE(PG8_SA(1, 0), a3, voffA);
            PG8_BAR; PG8_WAIT_L(0); PG8_MMA(1, 0, At, B0); PG8_BAR; PG8_SCHED;
            PG8_STAGE(PG8_SB(1, 1), b3 + hstepB, voffB);
            PG8_WAIT_V(6); PG8_BAR; PG8_MMA(1, 1, At, B1); PG8_BAR;
            }
        }
        if constexpr (ALIGN_EPI) { if (wr == 0) PG8_BAR; }
        { int fr_ = fr, fq_ = fq, wr_ = wr, wc_ = wc; asm volatile("" : "+v"(fr_), "+v"(fq_), "+s"(wr_), "+s"(wc_));
          E(acc, cur, wr_, wc_, fr_, fq_); }
        S.done(cur);
        if (!has_next) break;
#pragma unroll
        for (int a = 0; a < 2; ++a)
#pragma unroll
            for (int b = 0; b < 2; ++b)
#pragma unroll
                for (int m = 0; m < 4; ++m)
#pragma unroll
                    for (int n = 0; n < 2; ++n) acc[a][b][m][n] = (f32x4){0.f, 0.f, 0.f, 0.f};
        cur = nxt; cA = nA; cB = nB; ++ui;
        if constexpr (VARK) { voffA[0] = PG8_SEL(cur.k2, voffA0[0], voffA1[0]); voffA[1] = PG8_SEL(cur.k2, voffA0[1], voffA1[1]); voffB[0] = PG8_SEL(cur.k2, voffB0[0], voffB1[0]); voffB[1] = PG8_SEL(cur.k2, voffB0[1], voffB1[1]);
            hstepA = PG8_SEL(cur.k2, hstepA0, hstepA1); hstepB = PG8_SEL(cur.k2, hstepB0, hstepB1); nt = PG8_SEL(cur.k2, K, K1) / BK; }
        if constexpr (ALIGN_EPI) { if (wr == 1) PG8_BAR; }
    }
    PG8_WAIT_V(0);
    if constexpr (!ALIGN_EPI) { if (wr == 0) PG8_BAR; }
    PG8_BAR;
#undef PG8_SEL
#undef PG8_SA
#undef PG8_SB
#undef PG8_STAGE
#undef PG8_LDA
#undef PG8_LDB
#undef PG8_MMA
#undef PG8_WAIT_V
#undef PG8_WAIT_L
#undef PG8_BAR
#undef PG8_SCHED
}
}
constexpr int D = 1024, NB = 2, S = 8192, CTX = 256, NTOK = NB * S, NCTX = NB * CTX, NALL = NTOK + NCTX;
constexpr int DIN = 3328;
constexpr int NH = 8, NKV = 2, HD = 64, DSSM = 512, NG = 32, GS = 16, NST = 64, TC = 32;
constexpr int NE = 32, DE = 512;
constexpr int NCH = 768;
constexpr int NCHV = 528;
constexpr float C2 = 0.125f * 1.4426950408889634f;
constexpr float LOG2E = 1.4426950408889634f;
constexpr int NWAVES = 8;
constexpr int MAXROWS = 41984;

constexpr size_t MiB = 1u << 20;
constexpr size_t WS_CTL = 0, CTL_ZERO_BYTES = 1 * MiB;
constexpr size_t WS_SMALL = 1 * MiB;
constexpr size_t SM_MOD = WS_SMALL + 0;
constexpr size_t SM_ROPE = WS_SMALL + 0x30000;
constexpr size_t SM_WRT = WS_SMALL + 0x40000;
constexpr size_t SM_SSMTAB = WS_SMALL + 0x90000;
constexpr size_t SM_RE = WS_SMALL + 0xC0000;
constexpr size_t SM_RW = SM_RE + (size_t)NALL * 8;
constexpr size_t SM_RSLOT = SM_RW + (size_t)NALL * 8;
constexpr size_t SM_RDEST = SM_RSLOT + (size_t)NALL * 8;
constexpr size_t SM_RWS = SM_RDEST + (size_t)NALL * 8;
static_assert(SM_RWS + (size_t)MAXROWS * 4 <= 8 * MiB, "small region");
constexpr size_t WS_W = 8 * MiB;
constexpr size_t W_IN = WS_W, W_GLU = W_IN + (size_t)DIN * D * 2, W_BRA = W_GLU + 512 * 512 * 2, W_BRS = W_BRA + 1024 * 512 * 2, W_OUT = W_BRS + 1024 * 512 * 2;
constexpr size_t W_S3 = W_OUT + 1024 * 1024 * 2, W_SE = W_S3 + (size_t)NG * 512 * 768 * 2, W_GU = W_SE + (size_t)NG * 256 * 512 * 2, W_DN = W_GU + (size_t)NE * 1024 * 1024 * 2;
constexpr size_t WS_XC = W_DN + (size_t)NE * 1024 * 512 * 2;
static_assert(WS_XC == 147 * MiB, "weights region");
constexpr size_t WS_H = WS_XC + (size_t)NALL * D * 4;
constexpr size_t WS_BIG = WS_H + (size_t)NALL * D * 2;
constexpr size_t B_Q = WS_BIG, B_K = B_Q + (size_t)NALL * 512 * 2, B_VT = B_K + (size_t)NALL * 128 * 2, B_A3 = B_VT + (size_t)NALL * 128 * 2;
constexpr size_t B_GA = B_A3 + (size_t)NG * NCH * 768 * 2, B_GS = B_GA + (size_t)NALL * D * 2, B_ATT = B_GS + (size_t)NALL * D * 2, B_SEND = B_ATT + (size_t)NALL * 512 * 2;
constexpr size_t B_Z = B_SEND + (size_t)NG * NCH * 256 * 4, B_SG = B_Z + (size_t)NALL * 512 * 2, B_T1 = B_SG + (size_t)NALL * 512 * 2, B_MB = B_T1 + (size_t)NALL * D * 2;
constexpr size_t B_END1 = B_MB + (size_t)NALL * D * 2;
constexpr size_t B_HS = WS_BIG, B_ACT = B_HS + (size_t)MAXROWS * D * 2, B_YE = B_ACT + (size_t)MAXROWS * DE * 2, B_END2 = B_YE + (size_t)MAXROWS * D * 2;
constexpr size_t WS_END = 544 * MiB;
static_assert(B_END1 <= WS_END && B_END2 <= WS_END, "d_ws map");
constexpr int CW_TMO = 0, CW_CODE = 1;
constexpr int CW_BAR = 4096;
constexpr int CW_CNT = 8192;
constexpr int CW_WORK = 8448;

constexpr int LDS_BYTES = 147456;
constexpr int LDSCTL_OFF = 143360;
constexpr int L_BARST = LDSCTL_OFF + 32;
constexpr int L_MOETAB = LDSCTL_OFF + 256;
constexpr int L_WGCNT = LDSCTL_OFF + 1024;
constexpr int L_MISC = LDSCTL_OFF + 2048;

#define GAS __attribute__((address_space(1)))
#define LAS __attribute__((address_space(3)))
typedef unsigned short bf16;
typedef unsigned v4u __attribute__((ext_vector_type(4)));
typedef unsigned v2u __attribute__((ext_vector_type(2)));
typedef float f32x4 __attribute__((ext_vector_type(4)));
typedef float f32x16 __attribute__((ext_vector_type(16)));
typedef short bf16x8 __attribute__((ext_vector_type(8)));
typedef short bf16x4 __attribute__((ext_vector_type(4)));
typedef GAS unsigned gu32;
#define RLX_AGENT __ATOMIC_RELAXED, __HIP_MEMORY_SCOPE_AGENT
#define LDS_WAIT() asm volatile("s_waitcnt lgkmcnt(0)" ::: "memory")
#define VM_WAIT() asm volatile("s_waitcnt vmcnt(0)" ::: "memory")
using pg8::cvt_pk_bf16; using pg8::bf_lo; using pg8::bf_hi;
__device__ __forceinline__ float sigmoid_f(float x) { return __builtin_amdgcn_rcpf(1.f + __expf(-x)); }
__device__ __forceinline__ float gelu_tanh_f(float x) {
    const float u = 0.7978845608028654f * (x + 0.044715f * x * x * x);
    return x * sigmoid_f(2.f * u);
}

#define XB_TMO      128
#define XB_XCNT(j)  (256  + 64 * (j))
#define XB_XSUB(j)  (1280 + 64 * (j))
#define XB_XGEN(j)  (2304 + 64 * (j))
#define XB_TOP      3328
#define XB_TOPGEN   3392
#define XCD_BAR_WORDS 3456
#define XB_SPIN_CAP (1u << 18)
__device__ __forceinline__ unsigned xb_ld(unsigned* p)              { return __hip_atomic_load(p, __ATOMIC_RELAXED, __HIP_MEMORY_SCOPE_AGENT); }
__device__ __forceinline__ unsigned xb_add(unsigned* p, unsigned v) { return __hip_atomic_fetch_add(p, v, __ATOMIC_RELAXED, __HIP_MEMORY_SCOPE_AGENT); }
__device__ __forceinline__ unsigned xb_xcc_id() { return (unsigned)__builtin_amdgcn_s_getreg((3 << 11) | 20) & 0xFu; }
#define XB_SPIN(cond, bar) do { unsigned _sp = 0; while (cond) { __builtin_amdgcn_s_sleep(1); \
    if ((++_sp & 255u) == 0u) { if (xb_ld(&(bar)[XB_TMO])) break; if (_sp > XB_SPIN_CAP) { atomicAdd(&(bar)[XB_TMO], 1u); break; } } } } while (0)
struct XcdBarrier { unsigned* bar; unsigned x; volatile LAS unsigned* st; };
__device__ __forceinline__ XcdBarrier xcd_barrier_post(unsigned* bar, volatile LAS unsigned* st) {
    XcdBarrier b; b.bar = bar; b.x = xb_xcc_id(); b.st = st;
    if (threadIdx.x == 0) (void)xb_add(&bar[XB_XCNT(b.x)], 1u);
    return b;
}
__device__ __forceinline__ void xcd_barrier_complete(unsigned* bar, unsigned x, unsigned& nloc, unsigned& nx) {
    const unsigned G = gridDim.x * gridDim.y * gridDim.z;
    unsigned sum, cnt, mine, sp = 0u;
    for (;;) {
        sum = 0u; cnt = 0u; mine = 0u;
#pragma unroll 1
        for (unsigned j = 0; j < 16; ++j) { const unsigned c = xb_ld(&bar[XB_XCNT(j)]); sum += c; cnt += (c > 0u) ? 1u : 0u; mine = (j == x) ? c : mine; }
        if (sum == G) break;
        __builtin_amdgcn_s_sleep(1);
        if ((++sp & 255u) == 0u) { if (xb_ld(&bar[XB_TMO])) break; if (sp > XB_SPIN_CAP) { atomicAdd(&bar[XB_TMO], 1u); break; } }
    }
    nloc = mine > 0u ? mine : 1u; nx = cnt > 0u ? cnt : 1u;
}
__device__ __forceinline__ void xcd_barrier(const XcdBarrier& b, const bool t0) {
    asm volatile("s_waitcnt vmcnt(0)" ::: "memory");
    __syncthreads();
    if (t0) {
        unsigned* bar = b.bar;
        __builtin_amdgcn_s_waitcnt(0);
        unsigned nloc = b.st[0], nx = b.st[1];
        if (nloc == 0u) { xcd_barrier_complete(bar, b.x, nloc, nx); b.st[0] = nloc; b.st[1] = nx; }
        const unsigned old = xb_add(&bar[XB_XSUB(b.x)], 1u);
        const unsigned gen = old / nloc;
        if (old + 1u == (gen + 1u) * nloc) {
            __builtin_amdgcn_fence(__ATOMIC_RELEASE, "agent");
            asm volatile("s_waitcnt vmcnt(0)" ::: "memory");
            const unsigned og = xb_add(&bar[XB_TOP], 1u);
            const unsigned tg = og / nx;
            if (og + 1u == (tg + 1u) * nx) xb_add(&bar[XB_TOPGEN], 1u);
            else XB_SPIN(xb_ld(&bar[XB_TOPGEN]) == tg, bar);
            __builtin_amdgcn_fence(__ATOMIC_ACQUIRE, "agent");
            xb_add(&bar[XB_XGEN(b.x)], 1u);
            asm volatile("s_waitcnt vmcnt(0)" ::: "memory");
        } else {
            XB_SPIN(xb_ld(&bar[XB_XGEN(b.x)]) == gen, bar);
            __builtin_amdgcn_fence(__ATOMIC_ACQUIRE, "agent");
            asm volatile("s_waitcnt vmcnt(0)" ::: "memory");
        }
    }
    __syncthreads();
}

struct Inputs {
    const float *x, *c, *ctx, *c_ctx, *w_mod, *b_mod, *g1, *g2, *w_in, *sink, *lam_re, *lam_im, *log_dt, *sb_re, *sb_im, *sc_re, *sc_im, *ssm_d,
        *w_glu, *w_bra, *w_brs, *w_out, *w_rg, *w_re, *w_eg, *w_eu, *w_ed, *g_final;
};
struct Frame {
    LAS unsigned char* lds;
    gu32* ctl;
    unsigned char* ws;
    int tid, lane, wave;
    int vcu, G;
    float* out;
};
__device__ __forceinline__ float row16_sum(float v) {
    v += __uint_as_float((unsigned)__builtin_amdgcn_update_dpp(0, (int)__float_as_uint(v), 0x128, 0xf, 0xf, false));
    v += __uint_as_float((unsigned)__builtin_amdgcn_update_dpp(0, (int)__float_as_uint(v), 0x124, 0xf, 0xf, false));
    v += __uint_as_float((unsigned)__builtin_amdgcn_update_dpp(0, (int)__float_as_uint(v), 0x122, 0xf, 0xf, false));
    v += __uint_as_float((unsigned)__builtin_amdgcn_update_dpp(0, (int)__float_as_uint(v), 0x121, 0xf, 0xf, false));
    return v; }
__device__ __forceinline__ float swap32_sum(float lo_keep, float hi_keep) {
    auto r = __builtin_amdgcn_permlane32_swap(__float_as_uint(lo_keep), __float_as_uint(hi_keep), false, false); return __uint_as_float(r[0]) + __uint_as_float(r[1]); }
__device__ __forceinline__ float swap16_sum(float even_keep, float odd_keep) {
    auto r = __builtin_amdgcn_permlane16_swap(__float_as_uint(even_keep), __float_as_uint(odd_keep), false, false); return __uint_as_float(r[0]) + __uint_as_float(r[1]); }
__device__ __forceinline__ float wave_sum(float v) { v = row16_sum(v); v = swap16_sum(v, v); return swap32_sum(v, v); }
__device__ __forceinline__ int which_of_row(int r) { return r < NTOK ? (r >> 13) : 2; }
__device__ __forceinline__ unsigned f2bf_rne(float f) { unsigned u = __builtin_bit_cast(unsigned, f); return (u + 0x7fffu + ((u >> 16) & 1u)) >> 16; }
__device__ __forceinline__ unsigned pk2(float lo, float hi) { return f2bf_rne(lo) | (f2bf_rne(hi) << 16); }
typedef float f32x2g __attribute__((ext_vector_type(2)));
#ifndef CHAIN
#define CHAIN 1
#endif
#define CHAIN_WMODE (CHAIN ? 3 : 0)
__device__ __forceinline__ void transpose_item(const float* W, int K, int N, bf16* WT, int mode, int item, int lane) {
    const int nblk = N / 128, kb = item / nblk, nb = item % nblk, k0 = 64 * kb, n = 128 * nb + 2 * lane;
    const int row = (mode == 0 || mode == 3) ? n : (8 * (n >> 2) + (n & 3) + (mode == 2 ? 4 : 0));
    const float* wp = W + (size_t)k0 * N + n;
    f32x2g v[64];
#pragma unroll
    for (int j = 0; j < 64; ++j) v[j] = __builtin_nontemporal_load((const f32x2g*)(wp + (size_t)j * N));
    if (mode == 3) {
        GAS v4u* ob = (GAS v4u*)WT + ((size_t)(row >> 4) * (K >> 5) + (k0 >> 5)) * 64 + (row & 15);
#pragma unroll
        for (int q = 0; q < 8; ++q) { v4u o; o.x = cvt_pk_bf16(v[8 * q].x, v[8 * q + 1].x); o.y = cvt_pk_bf16(v[8 * q + 2].x, v[8 * q + 3].x); o.z = cvt_pk_bf16(v[8 * q + 4].x, v[8 * q + 5].x); o.w = cvt_pk_bf16(v[8 * q + 6].x, v[8 * q + 7].x); ob[(q >> 2) * 64 + 16 * (q & 3)] = o; }
#pragma unroll
        for (int q = 0; q < 8; ++q) { v4u o; o.x = cvt_pk_bf16(v[8 * q].y, v[8 * q + 1].y); o.y = cvt_pk_bf16(v[8 * q + 2].y, v[8 * q + 3].y); o.z = cvt_pk_bf16(v[8 * q + 4].y, v[8 * q + 5].y); o.w = cvt_pk_bf16(v[8 * q + 6].y, v[8 * q + 7].y); ob[(q >> 2) * 64 + 16 * (q & 3) + 1] = o; }
        return;
    }
    GAS v4u* op0 = (GAS v4u*)(WT + (size_t)row * K + k0); GAS v4u* op1 = (GAS v4u*)(WT + (size_t)(row + 1) * K + k0);
#pragma unroll
    for (int q = 0; q < 8; ++q) { v4u o; o.x = cvt_pk_bf16(v[8 * q].x, v[8 * q + 1].x); o.y = cvt_pk_bf16(v[8 * q + 2].x, v[8 * q + 3].x); o.z = cvt_pk_bf16(v[8 * q + 4].x, v[8 * q + 5].x); o.w = cvt_pk_bf16(v[8 * q + 6].x, v[8 * q + 7].x); op0[q] = o; }
#pragma unroll
    for (int q = 0; q < 8; ++q) { v4u o; o.x = cvt_pk_bf16(v[8 * q].y, v[8 * q + 1].y); o.y = cvt_pk_bf16(v[8 * q + 2].y, v[8 * q + 3].y); o.z = cvt_pk_bf16(v[8 * q + 4].y, v[8 * q + 5].y); o.w = cvt_pk_bf16(v[8 * q + 6].y, v[8 * q + 7].y); op1[q] = o; }
}
constexpr int CV_IN = (D / 64) * (DIN / 128), CV_GLU = 8 * 4, CV_BR = 8 * 8, CV_OUT = 16 * 8, CV_G1 = 16 * 4, CV_D1 = 8 * 8;
constexpr int CV_TOTAL = CV_IN + CV_GLU + 2 * CV_BR + CV_OUT + NE * (2 * CV_G1 + CV_D1);
__device__ __forceinline__ void convert_item(const Inputs& I, unsigned char* ws, int l, int it, int lane) {
    int r = it;
    if (r < NE * CV_G1) { const int e = r / CV_G1; transpose_item(I.w_eg + ((size_t)l * NE + e) * D * DE, D, DE, (bf16*)(ws + W_GU) + (size_t)e * 1024 * 1024, 1, r % CV_G1, lane); return; } r -= NE * CV_G1;
    if (r < NE * CV_G1) { const int e = r / CV_G1; transpose_item(I.w_eu + ((size_t)l * NE + e) * D * DE, D, DE, (bf16*)(ws + W_GU) + (size_t)e * 1024 * 1024, 2, r % CV_G1, lane); return; } r -= NE * CV_G1;
    if (r < NE * CV_D1) { const int e = r / CV_D1; transpose_item(I.w_ed + ((size_t)l * NE + e) * DE * D, DE, D, (bf16*)(ws + W_DN) + (size_t)e * 1024 * 512, 0, r % CV_D1, lane); return; } r -= NE * CV_D1;
    if (r < CV_IN) { transpose_item(I.w_in + (size_t)l * D * DIN, D, DIN, (bf16*)(ws + W_IN), 0, r, lane); return; } r -= CV_IN;
    if (r < CV_GLU) { transpose_item(I.w_glu + (size_t)l * 512 * 512, 512, 512, (bf16*)(ws + W_GLU), CHAIN_WMODE, r, lane); return; } r -= CV_GLU;
    if (r < CV_BR) { transpose_item(I.w_bra + (size_t)l * 512 * D, 512, D, (bf16*)(ws + W_BRA), CHAIN_WMODE, r, lane); return; } r -= CV_BR;
    if (r < CV_BR) { transpose_item(I.w_brs + (size_t)l * 512 * D, 512, D, (bf16*)(ws + W_BRS), CHAIN_WMODE, r, lane); return; } r -= CV_BR;
    transpose_item(I.w_out + (size_t)l * D * D, D, D, (bf16*)(ws + W_OUT), CHAIN_WMODE, r, lane);
}
__device__ __forceinline__ void convert_weights(Frame& F, const Inputs& I, int l) {
    if (F.vcu < NG) return;
    const int gw = (F.vcu - NG) * NWAVES + F.wave, NGW = (F.G - NG) * NWAVES;
    for (int r = 0, base = 0; base < CV_TOTAL; ++r, base += NGW) {
        const int it = base + ((r & 1) ? (NGW - 1 - gw) : gw);
        if (it < CV_TOTAL) convert_item(I, F.ws, l, it, F.lane);
    }
}

__device__ __forceinline__ void ssm_cs(float li, float dt, int tau, float& c, float& s) {
    const double x = (double)tau * ((double)li * (double)dt);
    const double k = __builtin_rint(x * 0.15915494309189535);
    const float r = (float)(x - k * 6.283185307179586);
    c = cosf(r); s = sinf(r);
}
constexpr int APS = 130;
__device__ __forceinline__ void ssmgen_job(Frame& F, const Inputs& I, int l, int g) {
    LAS float* Kt = (LAS float*)(F.lds);
    LAS float* apw = (LAS float*)(F.lds + 65536);
    LAS float* Bb = (LAS float*)(F.lds + 99872);
    LAS float* Ct = (LAS float*)(F.lds + 116256);
    const int tid = F.tid, lane = tid & 63, wave = tid >> 6;
    __syncthreads();
    if (tid < 128) {
        const int dir = tid >> 6, p = tid & 63, pg = (l * 2 + dir) * NG + g;
        const float lr = I.lam_re[pg * NST + p], li = I.lam_im[pg * NST + p], dt = expf(I.log_dt[pg]);
        float c1, s1; ssm_cs(li, dt, 1, c1, s1);
        const float mag = expf(lr * dt), sh = sinf(0.5f * li * dt);
        const float aim = mag * s1, nr = expm1f(lr * dt) * c1 - 2.f * sh * sh, den = lr * lr + li * li;
        const float fre = (nr * lr + aim * li) / den, fim = (aim * lr - nr * li) / den;
#pragma unroll 4
        for (int m = 0; m < 16; ++m) {
            const float br = I.sb_re[((size_t)pg * NST + p) * GS + m], bi = I.sb_im[((size_t)pg * NST + p) * GS + m];
            Bb[((dir * 64 + p) * 16 + m) * 2 + 0] = fre * br - fim * bi;
            Bb[((dir * 64 + p) * 16 + m) * 2 + 1] = fre * bi + fim * br;
            Ct[((dir * 64 + p) * 16 + m) * 2 + 0] = I.sc_re[((size_t)pg * GS + m) * NST + p];
            Ct[((dir * 64 + p) * 16 + m) * 2 + 1] = I.sc_im[((size_t)pg * GS + m) * NST + p];
        }
        float* tab = (float*)(F.ws + SM_SSMTAB);
        float c32, s32; ssm_cs(li, dt, 32, c32, s32);
        const float m32 = expf(32.f * lr * dt), a32r = m32 * c32, a32i = m32 * s32;
        float pr = a32r, pi = a32i;
        float two = 2.f; asm volatile("" : "+v"(two));
#pragma unroll
        for (int q = 0; q < 5; ++q) { const float nr2 = pr * pr - pi * pi, ni2 = two * pr * pi; pr = nr2; pi = ni2; }
        const float sr = pr * a32r - pi * a32i, si = pr * a32i + pi * a32r;
        const size_t ti = ((((size_t)l * NG + g) * 2 + dir) * 64 + p) * 2;
        tab[ti] = a32r; tab[ti + 1] = a32i; tab[16384 + ti] = sr; tab[16384 + ti + 1] = si;
    }
    for (int idx = tid; idx < 2 * 33 * 64; idx += 512) {
        const int p = idx & 63, tau = (idx >> 6) % 33, dir = idx / (33 * 64), pg = (l * 2 + dir) * NG + g;
        const float lr = I.lam_re[pg * NST + p], li = I.lam_im[pg * NST + p], dt = expf(I.log_dt[pg]);
        float c, sn; ssm_cs(li, dt, tau, c, sn);
        const float mg = expf((float)tau * lr * dt);
        apw[(dir * 33 + tau) * APS + p * 2] = mg * c; apw[(dir * 33 + tau) * APS + p * 2 + 1] = mg * sn;
    }
    __syncthreads();
    for (int idx = tid; idx < 1024; idx += 512) {
        const int dir = idx >> 9, tau = (idx >> 4) & 31, mp = idx & 15;
        float acc[16];
#pragma unroll
        for (int m = 0; m < 16; ++m) acc[m] = 0.f;
        for (int p = 0; p < 64; ++p) {
            const float ar = apw[(dir * 33 + tau) * APS + p * 2], ai = apw[(dir * 33 + tau) * APS + p * 2 + 1];
            const float br = Bb[((dir * 64 + p) * 16 + mp) * 2], bi = Bb[((dir * 64 + p) * 16 + mp) * 2 + 1];
            const float tr = ar * br - ai * bi, ti = ar * bi + ai * br;
            const LAS f32x4* cp = (const LAS f32x4*)(Ct + (dir * 64 + p) * 32);
#pragma unroll
            for (int q = 0; q < 8; ++q) { const f32x4 cv = cp[q]; acc[2 * q] += cv.x * tr - cv.y * ti; acc[2 * q + 1] += cv.z * tr - cv.w * ti; }
        }
#pragma unroll
        for (int m = 0; m < 16; ++m) Kt[((dir * 16 + m) * 32 + tau) * 16 + mp] = acc[m];
    }
    __syncthreads();
    bf16* W3 = (bf16*)(F.ws + W_S3) + (size_t)g * 512 * 768;
    const float* dsk = I.ssm_d + l * DSSM + g * 16;
    for (int n = wave; n < 512; n += 8) {
        const int t = n >> 4, m = n & 15;
        {
            const int s_ = lane >> 1, mp0 = (lane & 1) * 8;
            float v[8];
            if (s_ != t) { const int dir = s_ < t ? 0 : 1, tau = s_ < t ? t - s_ : s_ - t; const LAS f32x4* kp = (const LAS f32x4*)(Kt + ((dir * 16 + m) * 32 + tau) * 16 + mp0);
                const f32x4 a = kp[0], b = kp[1]; v[0] = a.x; v[1] = a.y; v[2] = a.z; v[3] = a.w; v[4] = b.x; v[5] = b.y; v[6] = b.z; v[7] = b.w; }
            else { const LAS f32x4* k0p = (const LAS f32x4*)(Kt + ((0 * 16 + m) * 32 + 0) * 16 + mp0); const LAS f32x4* k1p = (const LAS f32x4*)(Kt + ((1 * 16 + m) * 32 + 0) * 16 + mp0); const float dv = dsk[m];
                const f32x4 a = k0p[0] + k1p[0], b = k0p[1] + k1p[1]; v[0] = a.x; v[1] = a.y; v[2] = a.z; v[3] = a.w; v[4] = b.x; v[5] = b.y; v[6] = b.z; v[7] = b.w;
#pragma unroll
                for (int j = 0; j < 8; ++j) v[j] += (mp0 + j) == m ? dv : 0.f; }
            v4u o; o.x = cvt_pk_bf16(v[0], v[1]); o.y = cvt_pk_bf16(v[2], v[3]); o.z = cvt_pk_bf16(v[4], v[5]); o.w = cvt_pk_bf16(v[6], v[7]);
            *(GAS v4u*)(W3 + (size_t)n * 768 + lane * 8) = o;
        }
        if (lane < 32) {
            const int dir = lane >> 4, ri = (lane >> 3) & 1, p0 = (lane & 7) * 8, tw = dir == 0 ? t + 1 : 32 - t, pg = (l * 2 + dir) * NG + g;
            const GAS f32x4* crp = (const GAS f32x4*)(I.sc_re + ((size_t)pg * GS + m) * NST + p0); const GAS f32x4* cip = (const GAS f32x4*)(I.sc_im + ((size_t)pg * GS + m) * NST + p0);
            const f32x4 cr0 = crp[0], cr1 = crp[1], ci0 = cip[0], ci1 = cip[1];
            const float crv[8] = {cr0.x, cr0.y, cr0.z, cr0.w, cr1.x, cr1.y, cr1.z, cr1.w}, civ[8] = {ci0.x, ci0.y, ci0.z, ci0.w, ci1.x, ci1.y, ci1.z, ci1.w};
            float v[8];
#pragma unroll
            for (int j = 0; j < 8; ++j) { const float ar = apw[(dir * 33 + tw) * APS + (p0 + j) * 2], ai = apw[(dir * 33 + tw) * APS + (p0 + j) * 2 + 1];
                v[j] = ri == 0 ? (crv[j] * ar - civ[j] * ai) : -(crv[j] * ai + civ[j] * ar); }
            v4u o; o.x = cvt_pk_bf16(v[0], v[1]); o.y = cvt_pk_bf16(v[2], v[3]); o.z = cvt_pk_bf16(v[4], v[5]); o.w = cvt_pk_bf16(v[6], v[7]);
            *(GAS v4u*)(W3 + (size_t)n * 768 + 512 + lane * 8) = o;
        }
    }
    bf16* E = (bf16*)(F.ws + W_SE) + (size_t)g * 256 * 512;
    for (int n = wave; n < 256; n += 8) {
        const int dir = n >> 7, ri = (n >> 6) & 1, p = n & 63, s_ = lane >> 1, mp0 = (lane & 1) * 8, te = dir == 0 ? 31 - s_ : s_;
        const float ar = apw[(dir * 33 + te) * APS + p * 2], ai = apw[(dir * 33 + te) * APS + p * 2 + 1];
        float v[8];
#pragma unroll
        for (int j = 0; j < 8; ++j) { const float br = Bb[((dir * 64 + p) * 16 + mp0 + j) * 2], bi = Bb[((dir * 64 + p) * 16 + mp0 + j) * 2 + 1];
            v[j] = ri == 0 ? (ar * br - ai * bi) : (ar * bi + ai * br); }
        v4u o; o.x = cvt_pk_bf16(v[0], v[1]); o.y = cvt_pk_bf16(v[2], v[3]); o.z = cvt_pk_bf16(v[4], v[5]); o.w = cvt_pk_bf16(v[6], v[7]);
        *(GAS v4u*)(E + (size_t)n * 512 + lane * 8) = o;
    }
    __syncthreads();
}

__device__ __forceinline__ void mod_item(Frame& F, const Inputs& I, int item) {
    LAS float* sl = (LAS float*)(F.lds);
    LAS float* part = (LAS float*)(F.lds + 16384);
    __syncthreads();
    for (int i = F.tid; i < 3 * 1024; i += 512) { const int w = i >> 10, k = i & 1023; const float v = w < 2 ? I.c[w * D + k] : I.c_ctx[k]; sl[i] = v / (1.f + expf(-v)); }
    __syncthreads();
    const int l = item / 96, cb = item % 96, col = cb * 64 + F.lane;
    const float* W = I.w_mod + (size_t)l * D * 6144;
    float a0 = 0.f, a1 = 0.f, a2 = 0.f;
#pragma unroll 16
    for (int kk = 0; kk < 128; ++kk) { const int k = F.wave * 128 + kk; const float wv = W[(size_t)k * 6144 + col]; a0 += sl[k] * wv; a1 += sl[1024 + k] * wv; a2 += sl[2048 + k] * wv; }
    part[(F.wave * 3 + 0) * 64 + F.lane] = a0; part[(F.wave * 3 + 1) * 64 + F.lane] = a1; part[(F.wave * 3 + 2) * 64 + F.lane] = a2;
    __syncthreads();
    if (F.tid < 192) { const int w = F.tid >> 6, c = F.tid & 63; float s = 0.f;
#pragma unroll
        for (int v = 0; v < 8; ++v) s += part[(v * 3 + w) * 64 + c];
        ((float*)(F.ws + SM_MOD))[(l * 3 + w) * 6144 + cb * 64 + c] = s + I.b_mod[l * 6144 + cb * 64 + c]; }
    __syncthreads();
}
__device__ __forceinline__ void p0_small(Frame& F, const Inputs& I) {
    const int b = F.vcu - 224;
    if (b < 0) return;
    const int t = b * 512 + F.tid, NT = 32 * 512;
    float* rope = (float*)(F.ws + SM_ROPE);
    for (int i = t; i < 128 * 16; i += NT) { const int pos = i >> 4, j = i & 15; const float freq = exp2f(-(float)j * (13.287712379549449f / 16.f)); const float ang = (float)pos * freq;
        const double x = (double)ang; const double k = __builtin_rint(x * 0.15915494309189535); const float r = (float)(x - k * 6.283185307179586);
        rope[i] = cosf(r); rope[2048 + i] = sinf(r); }
    float* wrt = (float*)(F.ws + SM_WRT);
    for (int i = t; i < 2 * 36 * 1024; i += NT) { const int k = i & 1023, j = (i >> 10) % 36, l = i / (36 * 1024);
        wrt[i] = j < 4 ? I.w_rg[((size_t)l * D + k) * 4 + j] : I.w_re[((size_t)l * D + k) * 32 + (j - 4)]; }
}
struct RowVec { f32x4 v[4]; };
__device__ __forceinline__ RowVec load_row_f32(const float* p, int lane) { RowVec r; const GAS f32x4* q = (const GAS f32x4*)p + lane;
#pragma unroll
    for (int j = 0; j < 4; ++j) r.v[j] = q[64 * j]; return r; }
__device__ __forceinline__ void store_row_f32(float* p, int lane, const RowVec& r) { GAS f32x4* q = (GAS f32x4*)p + lane;
#pragma unroll
    for (int j = 0; j < 4; ++j) q[64 * j] = r.v[j]; }
__device__ __forceinline__ RowVec load_row_bf16(const bf16* p, int lane) { RowVec r; const GAS v2u* q = (const GAS v2u*)p + lane;
#pragma unroll
    for (int j = 0; j < 4; ++j) { const v2u w = q[64 * j]; r.v[j] = (f32x4){bf_lo(w.x), bf_hi(w.x), bf_lo(w.y), bf_hi(w.y)}; } return r; }
__device__ __forceinline__ void store_row_bf16(bf16* p, int lane, const RowVec& r) { GAS v2u* q = (GAS v2u*)p + lane;
#pragma unroll
    for (int j = 0; j < 4; ++j) { v2u w; w.x = cvt_pk_bf16(r.v[j].x, r.v[j].y); w.y = cvt_pk_bf16(r.v[j].z, r.v[j].w); q[64 * j] = w; } }
__device__ __forceinline__ float row_rinv(const RowVec& r) { float s = 0.f;
#pragma unroll
    for (int j = 0; j < 4; ++j) s += (r.v[j].x * r.v[j].x + r.v[j].y * r.v[j].y) + (r.v[j].z * r.v[j].z + r.v[j].w * r.v[j].w);
    return rsqrtf(wave_sum(s) * (1.f / D) + 1e-6f); }
__device__ __forceinline__ RowVec norm_mod(const RowVec& x, float rinv, const float* g, const float* shift, const float* scale, int lane) {
    RowVec o; const GAS f32x4* gp = (const GAS f32x4*)g + lane; const GAS f32x4* sh = (const GAS f32x4*)shift + lane; const GAS f32x4* sc = (const GAS f32x4*)scale + lane;
#pragma unroll
    for (int j = 0; j < 4; ++j) o.v[j] = x.v[j] * rinv * gp[64 * j] * (1.f + sc[64 * j]) + sh[64 * j];
    return o; }
__device__ __forceinline__ void moe_combine(RowVec& x, const bf16* ye, const int* rdest, int row, const float* gate, int lane) {
    const int d0 = rdest[row * 2], d1 = rdest[row * 2 + 1];
    const RowVec a = load_row_bf16(ye + (size_t)d0 * D, lane), b = load_row_bf16(ye + (size_t)d1 * D, lane);
    const GAS f32x4* gp = (const GAS f32x4*)gate + lane;
#pragma unroll
    for (int j = 0; j < 4; ++j) x.v[j] = x.v[j] + gp[64 * j] * (a.v[j] + b.v[j]);
}
__device__ __forceinline__ void phase_norm1(Frame& F, const Inputs& I, int l) {
    const int gw = F.vcu * NWAVES + F.wave, NGW = F.G * NWAVES;
    const float* mod = (const float*)(F.ws + SM_MOD);
    float* XC = (float*)(F.ws + WS_XC); bf16* H = (bf16*)(F.ws + WS_H);
    const bf16* YE = (const bf16*)(F.ws + B_YE); const int* RD = (const int*)(F.ws + SM_RDEST);
    for (int r0 = gw; r0 < NALL; r0 += 2 * NGW) {
        const int r1 = r0 + NGW; const bool two = r1 < NALL; const int r1c = two ? r1 : r0;
        RowVec x0, x1;
        if (l == 0) { x0 = load_row_f32(r0 < NTOK ? I.x + (size_t)r0 * D : I.ctx + (size_t)(r0 - NTOK) * D, F.lane); x1 = load_row_f32(r1c < NTOK ? I.x + (size_t)r1c * D : I.ctx + (size_t)(r1c - NTOK) * D, F.lane); }
        else {
            const int d00 = RD[r0 * 2], d01 = RD[r0 * 2 + 1], d10 = RD[r1c * 2], d11 = RD[r1c * 2 + 1];
            x0 = load_row_f32(XC + (size_t)r0 * D, F.lane); x1 = load_row_f32(XC + (size_t)r1c * D, F.lane);
            const RowVec a0 = load_row_bf16(YE + (size_t)d00 * D, F.lane), b0 = load_row_bf16(YE + (size_t)d01 * D, F.lane), a1 = load_row_bf16(YE + (size_t)d10 * D, F.lane), b1 = load_row_bf16(YE + (size_t)d11 * D, F.lane);
            const GAS f32x4* g0 = (const GAS f32x4*)(mod + (0 * 3 + which_of_row(r0)) * 6144 + 5 * D) + F.lane; const GAS f32x4* g1p = (const GAS f32x4*)(mod + (0 * 3 + which_of_row(r1c)) * 6144 + 5 * D) + F.lane;
#pragma unroll
            for (int j = 0; j < 4; ++j) { x0.v[j] = x0.v[j] + g0[64 * j] * (a0.v[j] + b0.v[j]); x1.v[j] = x1.v[j] + g1p[64 * j] * (a1.v[j] + b1.v[j]); }
            store_row_f32(XC + (size_t)r0 * D, F.lane, x0); if (two) store_row_f32(XC + (size_t)r1 * D, F.lane, x1);
        }
        const float ri0 = row_rinv(x0), ri1 = row_rinv(x1);
        const float* m0 = mod + (l * 3 + which_of_row(r0)) * 6144; const float* m1 = mod + (l * 3 + which_of_row(r1c)) * 6144;
        const RowVec h0 = norm_mod(x0, ri0, I.g1 + l * D, m0 + 0 * D, m0 + 1 * D, F.lane), h1 = norm_mod(x1, ri1, I.g1 + l * D, m1 + 0 * D, m1 + 1 * D, F.lane);
        store_row_bf16(H + (size_t)r0 * D, F.lane, h0); if (two) store_row_bf16(H + (size_t)r1 * D, F.lane, h1);
    }
}
__device__ __forceinline__ void phase_final(Frame& F, const Inputs& I) {
    const int gw = F.vcu * NWAVES + F.wave, NGW = F.G * NWAVES;
    const float* mod = (const float*)(F.ws + SM_MOD);
    const float* XC = (const float*)(F.ws + WS_XC);
    const bf16* YE = (const bf16*)(F.ws + B_YE); const int* RD = (const int*)(F.ws + SM_RDEST);
    for (int r0 = gw; r0 < NTOK; r0 += 2 * NGW) {
        const int r1 = r0 + NGW; const bool two = r1 < NTOK; const int r1c = two ? r1 : r0;
        const int d00 = RD[r0 * 2], d01 = RD[r0 * 2 + 1], d10 = RD[r1c * 2], d11 = RD[r1c * 2 + 1];
        RowVec x0 = load_row_f32(XC + (size_t)r0 * D, F.lane), x1 = load_row_f32(XC + (size_t)r1c * D, F.lane);
        const RowVec a0 = load_row_bf16(YE + (size_t)d00 * D, F.lane), b0 = load_row_bf16(YE + (size_t)d01 * D, F.lane), a1 = load_row_bf16(YE + (size_t)d10 * D, F.lane), b1 = load_row_bf16(YE + (size_t)d11 * D, F.lane);
        const GAS f32x4* g0 = (const GAS f32x4*)(mod + (1 * 3 + which_of_row(r0)) * 6144 + 5 * D) + F.lane; const GAS f32x4* g1p = (const GAS f32x4*)(mod + (1 * 3 + which_of_row(r1c)) * 6144 + 5 * D) + F.lane;
#pragma unroll
        for (int j = 0; j < 4; ++j) { x0.v[j] = x0.v[j] + g0[64 * j] * (a0.v[j] + b0.v[j]); x1.v[j] = x1.v[j] + g1p[64 * j] * (a1.v[j] + b1.v[j]); }
        const float ri0 = row_rinv(x0), ri1 = row_rinv(x1);
        RowVec o0, o1; const GAS f32x4* gp = (const GAS f32x4*)I.g_final + F.lane;
#pragma unroll
        for (int j = 0; j < 4; ++j) { o0.v[j] = x0.v[j] * ri0 * gp[64 * j]; o1.v[j] = x1.v[j] * ri1 * gp[64 * j]; }
        store_row_f32(F.out + (size_t)r0 * D, F.lane, o0); if (two) store_row_f32(F.out + (size_t)r1 * D, F.lane, o1);
    }
}

__device__ __forceinline__ void phase_norm2_route(Frame& F, const Inputs& I, int l, int dbgf = 0) {
    const int nrows = l == 0 ? NALL : NTOK, R = nrows / 256, row_base = F.vcu * R, nextra = R - 64;
    const float* mod = (const float*)(F.ws + SM_MOD);
    const float* XC = (const float*)(F.ws + WS_XC); bf16* H = (bf16*)(F.ws + WS_H);
    const float* wrt = (const float*)(F.ws + SM_WRT) + (size_t)l * 36 * 1024;
    volatile LAS int* lcnt = (volatile LAS int*)(F.lds + L_WGCNT);
    LAS float* wt = (LAS float*)(F.lds);
    LAS float* lg = (LAS float*)(F.lds + 131072 + F.wave * 1296);
    int* RE = (int*)(F.ws + SM_RE); float* RW = (float*)(F.ws + SM_RW); int* RSLOT = (int*)(F.ws + SM_RSLOT);
    __syncthreads();
    if (F.tid < 64) lcnt[F.tid] = 0;
    { const GAS f32x4* src = (const GAS f32x4*)(wrt + 4 * 1024); LAS f32x4* dst = (LAS f32x4*)wt;
#pragma unroll 8
      for (int i = F.tid; i < 32 * 256; i += 512) dst[i] = src[i]; }
    __syncthreads();
    const int ngroups = F.wave < nextra ? 3 : 2;
#pragma unroll 1
    for (int grp = 0; grp < ngroups; ++grp) {
        RowVec h[4];
        const int rfirst = row_base + (grp < 2 ? F.wave * 8 + grp * 4 : 64 + F.wave), rstep = grp < 2 ? 1 : 0;
#pragma unroll
        for (int rr = 0; rr < 4; ++rr) h[rr] = load_row_f32(XC + (size_t)(rfirst + rr * rstep) * D, F.lane);
        const float* ml = mod + (l * 3 + which_of_row(rfirst)) * 6144;
        RowVec gsc, gsh;
        { const GAS f32x4* gp = (const GAS f32x4*)(I.g2 + l * D) + F.lane; const GAS f32x4* sc = (const GAS f32x4*)(ml + 4 * D) + F.lane; const GAS f32x4* sh = (const GAS f32x4*)(ml + 3 * D) + F.lane;
#pragma unroll
          for (int j = 0; j < 4; ++j) { gsc.v[j] = gp[64 * j] * (1.f + sc[64 * j]); gsh.v[j] = sh[64 * j]; } }
#pragma unroll
        for (int rr = 0; rr < 4; ++rr) {
            const int r = rfirst + rr * rstep;
            const float rinv = row_rinv(h[rr]);
            if (which_of_row(r) == which_of_row(rfirst)) {
#pragma unroll
                for (int j = 0; j < 4; ++j) h[rr].v[j] = h[rr].v[j] * rinv * gsc.v[j] + gsh.v[j];
            } else { const float* m2 = mod + (l * 3 + which_of_row(r)) * 6144; h[rr] = norm_mod(h[rr], rinv, I.g2 + l * D, m2 + 3 * D, m2 + 4 * D, F.lane); }
            if (grp < 2 || rr == 0) store_row_bf16(H + (size_t)r * D, F.lane, h[rr]);
        }
#pragma unroll
        for (int j = 0; j < 4; ++j) { const GAS f32x4* wp = (const GAS f32x4*)(wrt + j * 1024) + F.lane; f32x4 wv[4];
#pragma unroll
            for (int q = 0; q < 4; ++q) wv[q] = wp[64 * q];
            float a_[4];
#pragma unroll
            for (int rr = 0; rr < 4; ++rr) { f32x4 s4 = h[rr].v[0] * wv[0]; s4 = s4 + h[rr].v[1] * wv[1]; s4 = s4 + h[rr].v[2] * wv[2]; s4 = s4 + h[rr].v[3] * wv[3]; a_[rr] = (s4.x + s4.y) + (s4.z + s4.w); }
            const float c20 = swap32_sum(a_[0], a_[2]), c21 = swap32_sum(a_[1], a_[3]); float c1 = swap16_sum(c20, c21); c1 = row16_sum(c1);
            if ((F.lane & 15) == 0) { const int rr = F.lane >> 4; if (grp < 2) lg[(grp * 4 + rr) * 36 + j] = c1; else if (rr == 0) lg[8 * 36 + j] = c1; } }
        LDS_WAIT(); asm volatile("" ::: "memory");
#pragma unroll
        for (int rr = 0; rr < 4; ++rr) {
            if (grp == 2 && rr > 0) break;
            const int lrow = grp < 2 ? grp * 4 + rr : 8;
            const LAS float* q = lg + lrow * 36;
            int gi = 0; float gm = q[0];
#pragma unroll
            for (int i = 1; i < 4; ++i) { const float v = q[i]; if (v > gm) { gm = v; gi = i; } }
            gi = __builtin_amdgcn_readfirstlane(gi);
            float a_[8];
#pragma unroll
            for (int e = 0; e < 8; ++e) { const LAS f32x4* wp = (const LAS f32x4*)(wt + (gi * 8 + e) * 1024) + F.lane;
                f32x4 s4 = h[rr].v[0] * wp[0]; s4 = s4 + h[rr].v[1] * wp[64]; s4 = s4 + h[rr].v[2] * wp[128]; s4 = s4 + h[rr].v[3] * wp[192]; a_[e] = (s4.x + s4.y) + (s4.z + s4.w); }
            const float c40 = swap32_sum(a_[0], a_[4]), c41 = swap32_sum(a_[1], a_[5]), c42 = swap32_sum(a_[2], a_[6]), c43 = swap32_sum(a_[3], a_[7]);
            float c20 = swap16_sum(c40, c42), c21 = swap16_sum(c41, c43);
            c20 = row16_sum(c20); c21 = row16_sum(c21);
            if ((F.lane & 15) == 0) { const int e0 = (F.lane >> 4) * 2; lg[lrow * 36 + 4 + e0] = c20; lg[lrow * 36 + 4 + e0 + 1] = c21; }
        }
    }
    LDS_WAIT(); asm volatile("" ::: "memory");
    int my_e0 = 0, my_e1 = 0, my_l0 = 0, my_l1 = 0, my_row = -1;
    if (F.lane < 8 || (F.lane == 8 && F.wave < nextra)) {
        const LAS float* q = lg + F.lane * 36;
        int gi = 0; float gm = q[0];
#pragma unroll
        for (int i = 1; i < 4; ++i) if (q[i] > gm) { gm = q[i]; gi = i; }
        float gs = 0.f;
#pragma unroll
        for (int i = 0; i < 4; ++i) gs += expf(q[i] - gm);
        const float gprob = 1.f / gs;
        const LAS float* el = q + 4;
        int i1 = 0; float v1 = el[0];
#pragma unroll
        for (int i = 1; i < 8; ++i) if (el[i] > v1) { v1 = el[i]; i1 = i; }
        int i2 = 0; float v2 = -INFINITY;
#pragma unroll
        for (int i = 0; i < 8; ++i) if (i != i1 && el[i] > v2) { v2 = el[i]; i2 = i; }
        const float e2 = expf(v2 - v1), p1 = 1.f / (1.f + e2), p2 = e2 / (1.f + e2);
        const int r = row_base + (F.lane < 8 ? F.wave * 8 + F.lane : 64 + F.wave), e0 = gi * 8 + i1, e1 = gi * 8 + i2;
        RE[r * 2] = e0; RE[r * 2 + 1] = e1; RW[r * 2] = gprob * p1; RW[r * 2 + 1] = gprob * p2;
        my_row = r; my_e0 = e0; my_e1 = e1;
        my_l0 = __hip_atomic_fetch_add((LAS int*)(F.lds + L_WGCNT) + e0, 1, __ATOMIC_RELAXED, __HIP_MEMORY_SCOPE_WORKGROUP);
        my_l1 = __hip_atomic_fetch_add((LAS int*)(F.lds + L_WGCNT) + e1, 1, __ATOMIC_RELAXED, __HIP_MEMORY_SCOPE_WORKGROUP);
    }
    __syncthreads();
    if (F.tid < 32) { const int c = lcnt[F.tid]; int base = 0; if (c > 0) base = (int)__hip_atomic_fetch_add(F.ctl + CW_CNT + 64 * l + F.tid, (unsigned)c, RLX_AGENT); lcnt[32 + F.tid] = base; }
    __syncthreads();
    if (my_row >= 0) { RSLOT[my_row * 2] = lcnt[32 + my_e0] + my_l0; RSLOT[my_row * 2 + 1] = lcnt[32 + my_e1] + my_l1; }
    __syncthreads();
}

__device__ __forceinline__ void moe_tables(Frame& F, int l) {
    volatile LAS int* tp = (volatile LAS int*)(F.lds + L_MOETAB);
    __syncthreads();
    if (F.tid == 0) { int acc = 0;
        for (int e = 0; e < NE; ++e) { tp[e] = acc; const int c = (int)__hip_atomic_load(F.ctl + CW_CNT + 64 * l + e, RLX_AGENT); acc += (c + 255) >> 8; }
        tp[NE] = acc; }
    __syncthreads();
}
__device__ __forceinline__ void phase_gather(Frame& F, int l) {
    moe_tables(F, l);
    const volatile LAS int* tp = (const volatile LAS int*)(F.lds + L_MOETAB);
    const int nrows = l == 0 ? NALL : NTOK;
    const int gw = F.vcu * NWAVES + F.wave, NGW = F.G * NWAVES;
    const bf16* H = (const bf16*)(F.ws + WS_H); bf16* HS = (bf16*)(F.ws + B_HS);
    const int* RE = (const int*)(F.ws + SM_RE); const float* RW = (const float*)(F.ws + SM_RW); const int* RSLOT = (const int*)(F.ws + SM_RSLOT);
    int* RDEST = (int*)(F.ws + SM_RDEST); float* RWS = (float*)(F.ws + SM_RWS);
    for (int r0 = gw; r0 < nrows; r0 += 2 * NGW) {
        const int r1 = r0 + NGW; const bool two = r1 < nrows; const int r1c = two ? r1 : r0;
        const GAS v4u* s0 = (const GAS v4u*)(H + (size_t)r0 * D) + F.lane; const GAS v4u* s1 = (const GAS v4u*)(H + (size_t)r1c * D) + F.lane;
        const v4u a0 = s0[0], b0 = s0[64], a1 = s1[0], b1 = s1[64];
        const int e00 = RE[r0 * 2], e01 = RE[r0 * 2 + 1], e10 = RE[r1c * 2], e11 = RE[r1c * 2 + 1];
        const int dd[4] = {256 * tp[e00] + RSLOT[r0 * 2], 256 * tp[e01] + RSLOT[r0 * 2 + 1], 256 * tp[e10] + RSLOT[r1c * 2], 256 * tp[e11] + RSLOT[r1c * 2 + 1]};
#pragma unroll
        for (int k = 0; k < 4; ++k) {
            if (k >= 2 && !two) break;
            GAS v4u* dst = (GAS v4u*)(HS + (size_t)dd[k] * D) + F.lane;
            dst[0] = k < 2 ? a0 : a1; dst[64] = k < 2 ? b0 : b1;
            const int r = k < 2 ? r0 : r1;
            if (F.lane == 0) { RDEST[r * 2 + (k & 1)] = dd[k]; RWS[dd[k]] = RW[r * 2 + (k & 1)]; }
        }
    }
}
__device__ __forceinline__ int carry_cidx(int dir, int b, int v) { return dir == 0 ? (v < 8 ? 512 + b * 8 + v : b * 256 + (v - 8)) : (v < 8 ? 512 + b * 8 + (7 - v) : b * 256 + 255 - (v - 8)); }
template <bool WT> __device__ __forceinline__ void phase_ssm_carry(Frame& F, int l) {
    if (F.vcu >= 128) return;
    const int g = F.vcu >> 2, b = (F.vcu >> 1) & 1, dir = F.vcu & 1, seg = F.tid >> 6, p = F.tid & 63;
    const float* tab = (const float*)(F.ws + SM_SSMTAB);
    const size_t ti = ((((size_t)l * NG + g) * 2 + dir) * 64 + p) * 2;
    const float a32r = tab[ti], a32i = tab[ti + 1], asr = tab[16384 + ti], asi = tab[16384 + ti + 1];
    const float* send = (const float*)(F.ws + B_SEND) + (size_t)g * NCH * 256 + dir * 128 + p;
    bf16* A3 = (bf16*)(F.ws + B_A3) + (size_t)g * NCH * 768 + 512 + dir * 128 + p;
    LAS float* segend = (LAS float*)(F.lds);
    float xr = 0.f, xi = 0.f;
#pragma unroll 1
    for (int k0 = 0; k0 < 33; k0 += 11) {
        float sr[11], si[11];
#pragma unroll
        for (int k = 0; k < 11; ++k) { const unsigned c = (unsigned)carry_cidx(dir, b, seg * 33 + k0 + k); sr[k] = send[c * 256u]; si[k] = send[c * 256u + 64u]; }
#pragma unroll
        for (int k = 0; k < 11; ++k) { const float nr = a32r * xr - a32i * xi + sr[k], ni = a32r * xi + a32i * xr + si[k]; xr = nr; xi = ni; }
    }
    __syncthreads();
    segend[(seg * 64 + p) * 2] = xr; segend[(seg * 64 + p) * 2 + 1] = xi;
    __syncthreads();
    float cr = 0.f, ci = 0.f;
    for (int k = 0; k < seg; ++k) { const float er = segend[(k * 64 + p) * 2], ei = segend[(k * 64 + p) * 2 + 1]; const float nr = asr * cr - asi * ci + er, ni = asr * ci + asi * cr + ei; cr = nr; ci = ni; }
    xr = cr; xi = ci;
#pragma unroll 1
    for (int k0 = 0; k0 < 33; k0 += 11) {
        float sr[11], si[11];
#pragma unroll
        for (int k = 0; k < 11; ++k) { const unsigned c = (unsigned)carry_cidx(dir, b, seg * 33 + k0 + k); sr[k] = send[c * 256u]; si[k] = send[c * 256u + 64u]; }
#pragma unroll
        for (int k = 0; k < 11; ++k) { const unsigned c = (unsigned)carry_cidx(dir, b, seg * 33 + k0 + k);
            if constexpr (WT) { __hip_atomic_store((GAS unsigned short*)(A3 + c * 768u), (unsigned short)f2bf_rne(xr), __ATOMIC_RELAXED, __HIP_MEMORY_SCOPE_AGENT); __hip_atomic_store((GAS unsigned short*)(A3 + c * 768u + 64u), (unsigned short)f2bf_rne(xi), __ATOMIC_RELAXED, __HIP_MEMORY_SCOPE_AGENT); }
            else { A3[c * 768u] = (bf16)f2bf_rne(xr); A3[c * 768u + 64u] = (bf16)f2bf_rne(xi); }
            const float nr = a32r * xr - a32i * xi + sr[k], ni = a32r * xi + a32i * xr + si[k]; xr = nr; xi = ni; }
    }
    __syncthreads();
}
struct KFrag { bf16x8 k[4]; };
struct VFrag { bf16x8 v[2][2]; };
__device__ __forceinline__ void k_load(KFrag& f, const bf16* kp  , int lane) {
    const int r32 = lane & 31, hi = lane >> 5;
#pragma unroll
    for (int d0 = 0; d0 < 4; ++d0) f.k[d0] = *(const GAS bf16x8*)(kp + (size_t)r32 * 128 + d0 * 16 + hi * 8);
}
__device__ __forceinline__ void v_load(VFrag& f, const bf16* vp  , int vpitch, int lane) {
    const int r32 = lane & 31, hi = lane >> 5;
#pragma unroll
    for (int db = 0; db < 2; ++db)
#pragma unroll
        for (int ks = 0; ks < 2; ++ks) f.v[db][ks] = *(const GAS bf16x8*)(vp + (size_t)(32 * db + r32) * vpitch + 16 * ks + 8 * hi);
}
__device__ __forceinline__ void attn_tile(f32x16 (&o)[2], float& m_run, float& l_run, const bf16x8 (&qf)[4], const KFrag& fk, const VFrag& f, int mask_mode  , int lane) {
    const int r32 = lane & 31, hi = lane >> 5;
    f32x16 s = {};
#pragma unroll
    for (int d0 = 0; d0 < 4; ++d0) s = __builtin_amdgcn_mfma_f32_32x32x16_bf16(fk.k[d0], qf[d0], s, 0, 0, 0);
    __builtin_amdgcn_sched_barrier(0);
    if (mask_mode != 0) {
#pragma unroll
        for (int r = 0; r < 16; ++r) { const int kidx = (r & 3) + 8 * (r >> 2) + 4 * hi; const bool valid = mask_mode == 1 ? (kidx >= r32) : (kidx <= r32); if (!valid) s[r] = -INFINITY; }
    }
    float tm = s[0];
#pragma unroll
    for (int r = 1; r < 16; ++r) tm = fmaxf(tm, s[r]);
    { auto rr = __builtin_amdgcn_permlane32_swap(__float_as_uint(tm), __float_as_uint(tm), false, false); tm = fmaxf(__uint_as_float(rr[0]), __uint_as_float(rr[1])); }
    const float m_new = fmaxf(m_run, tm);
    const float alpha = __builtin_amdgcn_exp2f(m_run - m_new);
    m_run = m_new;
    float ps = 0.f;
#pragma unroll
    for (int r = 0; r < 16; ++r) { s[r] = __builtin_amdgcn_exp2f(s[r] - m_new); ps += s[r]; }
    l_run = l_run * alpha + ps;
    __builtin_amdgcn_sched_barrier(0);
#pragma unroll
    for (int db = 0; db < 2; ++db)
#pragma unroll
        for (int r = 0; r < 16; ++r) o[db][r] *= alpha;
    __builtin_amdgcn_sched_barrier(0);
    bf16x8 pf[2];
#pragma unroll
    for (int ks = 0; ks < 2; ++ks) {
        v4u w; w.x = cvt_pk_bf16(s[8 * ks + 0], s[8 * ks + 1]); w.y = cvt_pk_bf16(s[8 * ks + 2], s[8 * ks + 3]); w.z = cvt_pk_bf16(s[8 * ks + 4], s[8 * ks + 5]); w.w = cvt_pk_bf16(s[8 * ks + 6], s[8 * ks + 7]);
        pf[ks] = __builtin_bit_cast(bf16x8, w);
    }
#pragma unroll
    for (int db = 0; db < 2; ++db)
#pragma unroll
        for (int ks = 0; ks < 2; ++ks) o[db] = __builtin_amdgcn_mfma_f32_32x32x16_bf16(f.v[db][ks], pf[ks], o[db], 0, 0, 0);
}
__device__ __forceinline__ void tile_ptrs(int t, int nloc, int i_lo, int p0, const bf16* kl, const bf16* vl, const bf16* kc, const bf16* vc, const bf16*& kp, const bf16*& vp, int& vpitch, int& mm) {
    if (t < nloc) { const int i = i_lo + t, kt = p0 - 128 + 32 * i; kp = kl + (size_t)kt * 128; vp = vl + kt; vpitch = S; mm = i == 0 ? 1 : (i == 8 ? 2 : 0); }
    else { const int c = t - nloc; kp = kc + (size_t)(32 * c) * 128; vp = vc + 32 * c; vpitch = CTX; mm = 0; }
}
__device__ __forceinline__ void attn_wave(Frame& F, int qrow0, int h0, int b, int p0, float sink0, float sink1) {
    const int lane = F.lane, r32 = lane & 31, hi = lane >> 5, kvh = h0 >> 2;
    const bf16* Q = (const bf16*)(F.ws + B_Q); const bf16* KB = (const bf16*)(F.ws + B_K); const bf16* VT = (const bf16*)(F.ws + B_VT);
    bf16x8 qa[4], qb[4];
#pragma unroll
    for (int d0 = 0; d0 < 4; ++d0) { qa[d0] = *(const GAS bf16x8*)(Q + (size_t)(qrow0 + r32) * 512 + h0 * 64 + d0 * 16 + hi * 8); qb[d0] = *(const GAS bf16x8*)(Q + (size_t)(qrow0 + r32) * 512 + (h0 + 1) * 64 + d0 * 16 + hi * 8); }
    f32x16 oa[2], ob[2]; oa[0] = f32x16{}; oa[1] = f32x16{}; ob[0] = f32x16{}; ob[1] = f32x16{};
    float ma = sink0 * LOG2E, mb = sink1 * LOG2E, la = hi == 0 ? 1.f : 0.f, lb = la;
    const bf16* kl = KB + (size_t)(b * S) * 128 + kvh * 64; const bf16* vl = VT + (size_t)((b * 2 + kvh) * 64) * S;
    const bf16* kc = KB + (size_t)(NTOK + b * CTX) * 128 + kvh * 64; const bf16* vc = VT + (size_t)NTOK * 128 + (size_t)((b * 2 + kvh) * 64) * CTX;
    int i_lo = 0, nloc = 0;
    if (p0 >= 0) { i_lo = 4 - (p0 >> 5); if (i_lo < 0) i_lo = 0; int i_hi = (S + 128 - p0) >> 5; if (i_hi > 9) i_hi = 9; nloc = i_hi - i_lo; }
    const int nt = nloc + 8;
    KFrag ka, kb; VFrag vv;
    { const bf16* kp; const bf16* vp; int vpitch, mm; tile_ptrs(0, nloc, i_lo, p0, kl, vl, kc, vc, kp, vp, vpitch, mm); k_load(ka, kp, lane); }
#pragma unroll 1
    for (int t = 0; t < nt; t += 2) {
        const bf16* kp; const bf16* vp; int vpitch, mm0, mm1 = 0, mmx;
        tile_ptrs(t, nloc, i_lo, p0, kl, vl, kc, vc, kp, vp, vpitch, mm0); v_load(vv, vp, vpitch, lane);
        if (t + 1 < nt) { tile_ptrs(t + 1, nloc, i_lo, p0, kl, vl, kc, vc, kp, vp, vpitch, mm1); k_load(kb, kp, lane); }
        attn_tile(oa, ma, la, qa, ka, vv, mm0, lane); attn_tile(ob, mb, lb, qb, ka, vv, mm0, lane);
        if (t + 1 < nt) {
            v_load(vv, vp, vpitch, lane);
            if (t + 2 < nt) { tile_ptrs(t + 2, nloc, i_lo, p0, kl, vl, kc, vc, kp, vp, vpitch, mmx); k_load(ka, kp, lane); }
            attn_tile(oa, ma, la, qa, kb, vv, mm1, lane); attn_tile(ob, mb, lb, qb, kb, vv, mm1, lane);
        }
    }
    bf16* O = (bf16*)(F.ws + B_ATT) + (size_t)(qrow0 + r32) * 512 + h0 * 64;
    { const float inv = 1.f / (la + xor32_f(la, lane));
#pragma unroll
      for (int db = 0; db < 2; ++db)
#pragma unroll
        for (int g4 = 0; g4 < 4; ++g4) { v2u w; w.x = cvt_pk_bf16(oa[db][4 * g4 + 0] * inv, oa[db][4 * g4 + 1] * inv); w.y = cvt_pk_bf16(oa[db][4 * g4 + 2] * inv, oa[db][4 * g4 + 3] * inv); *(GAS v2u*)(O + 32 * db + 8 * g4 + 4 * hi) = w; } }
    { const float inv = 1.f / (lb + xor32_f(lb, lane));
#pragma unroll
      for (int db = 0; db < 2; ++db)
#pragma unroll
        for (int g4 = 0; g4 < 4; ++g4) { v2u w; w.x = cvt_pk_bf16(ob[db][4 * g4 + 0] * inv, ob[db][4 * g4 + 1] * inv); w.y = cvt_pk_bf16(ob[db][4 * g4 + 2] * inv, ob[db][4 * g4 + 3] * inv); *(GAS v2u*)(O + 64 + 32 * db + 8 * g4 + 4 * hi) = w; } }
}
constexpr int ATT_V_OFF = 49152;
__device__ __forceinline__ void lds_frag_load(KFrag& kf, VFrag& vf, const LAS unsigned char* kt, const LAS unsigned char* vt, int lane) {
    const int r32 = lane & 31, hi = lane >> 5;
#pragma unroll
    for (int d0 = 0; d0 < 4; ++d0) kf.k[d0] = *(const LAS bf16x8*)(kt + r32 * 128 + (((2 * d0 + hi) ^ ((r32 >> 1) & 7)) * 16));
#pragma unroll
    for (int db = 0; db < 2; ++db)
#pragma unroll
        for (int ks = 0; ks < 2; ++ks) { const int d = 32 * db + r32; vf.v[db][ks] = *(const LAS bf16x8*)(vt + d * 64 + (((2 * ks + hi) ^ ((d >> 2) & 3)) * 16)); }
}
__device__ __forceinline__ void attn_wg_task(Frame& F, const Inputs& I, int l, int v) {
    int lane_ = F.lane, wave_ = F.wave; asm volatile("" : "+v"(lane_), "+s"(wave_));
    const int lane = lane_, wave = wave_, r32 = lane & 31, hi = lane >> 5;
    const int bk = v >> 6, b = bk >> 1, kvh = bk & 1, q0 = (v & 63) * 128, h0 = kvh * 4 + 2 * (wave & 1), qt = wave >> 1, p0 = q0 + 32 * qt, kb0 = q0 - 128;
    const bf16* Q = (const bf16*)(F.ws + B_Q); const bf16* KB = (const bf16*)(F.ws + B_K); const bf16* VT = (const bf16*)(F.ws + B_VT);
    const bf16* kl = KB + (size_t)(b * S) * 128 + kvh * 64; const bf16* vl = VT + (size_t)((b * 2 + kvh) * 64) * S;
    const bf16* kc = KB + (size_t)(NTOK + b * CTX) * 128 + kvh * 64; const bf16* vc = VT + (size_t)NTOK * 128 + (size_t)((b * 2 + kvh) * 64) * CTX;
    LAS unsigned char* L = F.lds;
    {
        v4u kr[6], vr[6];
#pragma unroll
        for (int j = 0; j < 6; ++j) { const int slot = wave * 6 + j, T = slot >> 2, part = slot & 3, kt = kb0 + 32 * T; const bool ok = kt >= 0 && kt < S;
            kr[j] = (v4u){0u, 0u, 0u, 0u}; vr[j] = kr[j];
            if (ok) { kr[j] = *(const GAS v4u*)(kl + (unsigned)((kt + 8 * part + (lane >> 3)) * 128 + (lane & 7) * 8)); vr[j] = *(const GAS v4u*)(vl + (unsigned)((16 * part + (lane >> 2)) * S + kt + (lane & 3) * 8)); } }
#pragma unroll
        for (int j = 0; j < 6; ++j) { const int slot = wave * 6 + j, T = slot >> 2, part = slot & 3, kq = 8 * part + (lane >> 3), d = 16 * part + (lane >> 2);
            *(LAS v4u*)(L + T * 4096 + kq * 128 + (((lane & 7) ^ ((kq >> 1) & 7)) * 16)) = kr[j];
            *(LAS v4u*)(L + ATT_V_OFF + T * 4096 + d * 64 + (((lane & 3) ^ ((d >> 2) & 3)) * 16)) = vr[j]; }
    }
    asm volatile("" ::: "memory");
    {
        v4u ckr[4];
#pragma unroll
        for (int j = 0; j < 4; ++j) { const int slot = wave * 4 + j, T = slot >> 2, part = slot & 3; ckr[j] = *(const GAS v4u*)(kc + (unsigned)((32 * T + 8 * part + (lane >> 3)) * 128 + (lane & 7) * 8)); }
#pragma unroll
        for (int j = 0; j < 4; ++j) { const int slot = wave * 4 + j, T = slot >> 2, part = slot & 3, kq = 8 * part + (lane >> 3);
            *(LAS v4u*)(L + 98304 + T * 4096 + kq * 128 + (((lane & 7) ^ ((kq >> 1) & 7)) * 16)) = ckr[j]; }
    }
    asm volatile("" ::: "memory");
    bf16x8 qa[4], qb[4];
#pragma unroll
    for (int d0 = 0; d0 < 4; ++d0) { qa[d0] = *(const GAS bf16x8*)(Q + (size_t)(b * S + p0 + r32) * 512 + h0 * 64 + d0 * 16 + hi * 8); qb[d0] = *(const GAS bf16x8*)(Q + (size_t)(b * S + p0 + r32) * 512 + (h0 + 1) * 64 + d0 * 16 + hi * 8); }
    __syncthreads();
    f32x16 oa[2], ob[2]; oa[0] = f32x16{}; oa[1] = f32x16{}; ob[0] = f32x16{}; ob[1] = f32x16{};
    float ma = I.sink[l * NH + h0] * LOG2E, mb = I.sink[l * NH + h0 + 1] * LOG2E, la = hi == 0 ? 1.f : 0.f, lb = la;
#pragma unroll 1
    for (int i = 0; i < 9; ++i) {
        const int kt = p0 - 128 + 32 * i; if (kt < 0 || kt >= S) continue;
        const int T = qt + i; KFrag kf; VFrag vf;
        lds_frag_load(kf, vf, L + T * 4096, L + ATT_V_OFF + T * 4096, lane);
        const int mm = i == 0 ? 1 : (i == 8 ? 2 : 0);
        attn_tile(oa, ma, la, qa, kf, vf, mm, lane); __builtin_amdgcn_sched_barrier(0); attn_tile(ob, mb, lb, qb, kf, vf, mm, lane); __builtin_amdgcn_sched_barrier(0);
    }
    { v4u cvr[4];
#pragma unroll
      for (int j = 0; j < 4; ++j) { const int slot = wave * 4 + j, T = slot >> 2, part = slot & 3; cvr[j] = *(const GAS v4u*)(vc + (unsigned)((16 * part + (lane >> 2)) * CTX + 32 * T + (lane & 3) * 8)); }
      __syncthreads();
#pragma unroll
      for (int j = 0; j < 4; ++j) { const int slot = wave * 4 + j, T = slot >> 2, part = slot & 3, d = 16 * part + (lane >> 2);
        *(LAS v4u*)(L + T * 4096 + d * 64 + (((lane & 3) ^ ((d >> 2) & 3)) * 16)) = cvr[j]; } }
    __syncthreads();
#pragma unroll 1
    for (int T = 0; T < 8; ++T) { KFrag kf; VFrag vf; lds_frag_load(kf, vf, L + 98304 + T * 4096, L + T * 4096, lane);
        attn_tile(oa, ma, la, qa, kf, vf, 0, lane); __builtin_amdgcn_sched_barrier(0); attn_tile(ob, mb, lb, qb, kf, vf, 0, lane); __builtin_amdgcn_sched_barrier(0); }
    __syncthreads();
    bf16* O = (bf16*)(F.ws + B_ATT) + (size_t)(b * S + p0 + r32) * 512 + h0 * 64;
    { const float inv = 1.f / (la + xor32_f(la, lane));
#pragma unroll
      for (int db = 0; db < 2; ++db)
#pragma unroll
        for (int g4 = 0; g4 < 4; ++g4) { v2u w; w.x = cvt_pk_bf16(oa[db][4 * g4 + 0] * inv, oa[db][4 * g4 + 1] * inv); w.y = cvt_pk_bf16(oa[db][4 * g4 + 2] * inv, oa[db][4 * g4 + 3] * inv); *(GAS v2u*)(O + 32 * db + 8 * g4 + 4 * hi) = w; } }
    { const float inv = 1.f / (lb + xor32_f(lb, lane));
#pragma unroll
      for (int db = 0; db < 2; ++db)
#pragma unroll
        for (int g4 = 0; g4 < 4; ++g4) { v2u w; w.x = cvt_pk_bf16(ob[db][4 * g4 + 0] * inv, ob[db][4 * g4 + 1] * inv); w.y = cvt_pk_bf16(ob[db][4 * g4 + 2] * inv, ob[db][4 * g4 + 3] * inv); *(GAS v2u*)(O + 64 + 32 * db + 8 * g4 + 4 * hi) = w; } }
}
__device__ __forceinline__ void phase_attn_latent(Frame& F, const Inputs& I, int l) {
    __syncthreads();
    for (int v = F.vcu; v < 256; v += F.G) attn_wg_task(F, I, l, v);
}
__device__ __forceinline__ void phase_attn_ctx(Frame& F, const Inputs& I, int l, int first_wg) {
    const int wv = (F.vcu - first_wg) * NWAVES + F.wave;
    if (F.vcu < first_wg || wv >= 64) return;
    const int b = wv >> 5, h0 = ((wv >> 3) & 3) * 2, qt = wv & 7;
    attn_wave(F, NTOK + b * CTX + qt * 32, h0, b, -1, I.sink[l * NH + h0], I.sink[l * NH + h0 + 1]);
}
__device__ __forceinline__ f32x16 small_prod(const bf16* A, int lda, const bf16* Bt, int ldb, int kbeg, int ksteps, int lane) {
    const int r32 = lane & 31, hi = lane >> 5;
    const bf16* ap = A + (size_t)r32 * lda + kbeg + hi * 8; const bf16* bp = Bt + (size_t)r32 * ldb + kbeg + hi * 8;
    f32x16 acc = {};
#pragma unroll 1
    for (int k0 = 0; k0 < ksteps; k0 += 8) {
        bf16x8 af[8], bf_[8];
#pragma unroll
        for (int j = 0; j < 8; ++j) { af[j] = *(const GAS bf16x8*)(ap + (k0 + j) * 16); bf_[j] = *(const GAS bf16x8*)(bp + (k0 + j) * 16); }
#pragma unroll
        for (int j = 0; j < 8; ++j) acc = __builtin_amdgcn_mfma_f32_32x32x16_bf16(af[j], bf_[j], acc, 0, 0, 0);
    }
    return acc;
}
__device__ __forceinline__ void ctx_small_gemm(Frame& F, const Inputs& I, int kind) {
    if (F.vcu >= 256) return;
    const int tm = F.vcu >> 4, tn = F.vcu & 15, nb = F.wave & 1, kq = F.wave >> 1, lane = F.lane, r32 = lane & 31, hi = lane >> 5;
    const int row0 = NTOK + 32 * tm, col0 = 64 * tn + 32 * nb;
    LAS float* red = (LAS float*)(F.lds);
    f32x16 p1, p2 = {};
    if (kind == 0) {
        p1 = small_prod((const bf16*)(F.ws + B_ATT) + (size_t)row0 * 512, 512, (const bf16*)(F.ws + W_BRA) + (size_t)col0 * 512, 512, kq * 128, 8, lane);
        p2 = small_prod((const bf16*)(F.ws + B_SG) + (size_t)row0 * 512, 512, (const bf16*)(F.ws + W_BRS) + (size_t)col0 * 512, 512, kq * 128, 8, lane);
    } else p1 = small_prod((const bf16*)(F.ws + B_MB) + (size_t)row0 * D, D, (const bf16*)(F.ws + W_OUT) + (size_t)col0 * D, D, kq * 256, 16, lane);
    __syncthreads();
#pragma unroll
    for (int r = 0; r < 16; ++r) { red[((0 * 8 + F.wave) * 16 + r) * 64 + lane] = p1[r]; if (kind == 0) red[((1 * 8 + F.wave) * 16 + r) * 64 + lane] = p2[r]; }
    __syncthreads();
    if (F.wave < 2) {
        const int col = col0 + r32;
#pragma unroll
        for (int r = 0; r < 16; ++r) {
            const int row = row0 + (r & 3) + 8 * (r >> 2) + 4 * hi;
            float s1 = 0.f, s2 = 0.f;
#pragma unroll
            for (int q = 0; q < 4; ++q) { s1 += red[((0 * 8 + 2 * q + nb) * 16 + r) * 64 + lane]; if (kind == 0) s2 += red[((1 * 8 + 2 * q + nb) * 16 + r) * 64 + lane]; }
            if (kind == 0) {
                const float ga = bf_lo((unsigned)((const bf16*)(F.ws + B_GA))[(size_t)row * D + col]), gs = bf_lo((unsigned)((const bf16*)(F.ws + B_GS))[(size_t)row * D + col]);
                __hip_atomic_store((GAS unsigned short*)((bf16*)(F.ws + B_MB) + (size_t)row * D + col), (unsigned short)f2bf_rne(ga * s1 + gs * s2), __ATOMIC_RELAXED, __HIP_MEMORY_SCOPE_AGENT);
            } else {
                const float gate = ((const float*)(F.ws + SM_MOD))[(0 * 3 + 2) * 6144 + 2 * D + col];
                ((float*)(F.ws + WS_XC))[(size_t)row * D + col] = I.ctx[(size_t)(row - NTOK) * D + col] + gate * s1;
            }
        }
        if (kind == 0) { asm volatile("s_waitcnt vmcnt(0)" ::: "memory"); if (lane == 0) __hip_atomic_fetch_add((gu32*)(F.ws + WS_CTL) + 49152 + 64 * (0 * 160 + 130 + tm), 1u, RLX_AGENT); }
    }
    __syncthreads();
}
#define CH_LD(dst, ptr, off) if (!(dry & 2)) asm volatile("global_load_dwordx4 %0, %1, off offset:%2" : "=v"(dst) : "v"(ptr), "n"(off) : "memory")
#define CH_WAIT(n, g) asm volatile("s_waitcnt vmcnt(" #n ")" : "+v"(g[0][0]), "+v"(g[0][1]), "+v"(g[1][0]), "+v"(g[1][1]) :: "memory")
#define CH_FILL(s, P, off) do { CH_LD(Bq[s][P][0][0], pb[2 * (P)], (off)); CH_LD(Bq[s][P][0][1], pb[2 * (P)], (off) + 1024); CH_LD(Bq[s][P][1][0], pb[2 * (P) + 1], (off)); CH_LD(Bq[s][P][1][1], pb[2 * (P) + 1], (off) + 1024); } while (0)
template <int MT, int KS>
__device__ __forceinline__ void chain_mma(f32x4 (&acc)[MT][4], const LAS unsigned char* A, const unsigned (&rb)[MT], const unsigned (&rs)[MT], const int kq, const char* wl  , const int tn0  , const int dry = 0) {
    bf16x8 Bq[2][2][2][2];
    const char* pb[4];
#pragma unroll
    for (int nt = 0; nt < 4; ++nt) pb[nt] = wl + (size_t)(tn0 + nt) * (KS * 2) * 1024;
    CH_FILL(0, 0, 0); CH_FILL(0, 1, 0); CH_FILL(1, 0, 2048); CH_FILL(1, 1, 2048);
#pragma unroll
    for (int nt = 0; nt < 4; ++nt) pb[nt] += 4096;
#define CH_HALF(s, P, W, REFILL) do { CH_WAIT(W, Bq[s][P]); \
        _Pragma("unroll") for (int j = 0; j < 2; ++j) _Pragma("unroll") for (int h = 0; h < 2; ++h) _Pragma("unroll") for (int mt = 0; mt < MT; ++mt) \
            acc[mt][2 * (P) + j] = __builtin_amdgcn_mfma_f32_16x16x32_bf16(Bq[s][P][j][h], Af[h][mt], acc[mt][2 * (P) + j], 0, 0, 0); \
        if (REFILL) CH_FILL(s, P, (s) * 2048); } while (0)
#define CH_STEP(s, k, W0, W1, REFILL) do { bf16x8 Af[2][MT]; \
        _Pragma("unroll") for (int h = 0; h < 2; ++h) _Pragma("unroll") for (int mt = 0; mt < MT; ++mt) Af[h][mt] = *(const LAS bf16x8*)(A + rb[mt] + ((unsigned)(((k) * 8 + h * 4 + kq) ^ rs[mt]) << 4)); \
        CH_HALF(s, 0, W0, REFILL); CH_HALF(s, 1, W1, REFILL); } while (0)
#pragma unroll 1
    for (int k0 = 0; k0 < KS - 2; k0 += 2) {
        CH_STEP(0, k0, 12, 12, true); CH_STEP(1, k0 + 1, 12, 12, true);
#pragma unroll
        for (int nt = 0; nt < 4; ++nt) pb[nt] += 4096;
    }
    CH_STEP(0, KS - 2, 12, 8, false); CH_STEP(1, KS - 1, 4, 0, false);
#undef CH_STEP
#undef CH_HALF
}
__device__ __forceinline__ f32x4 unpack4(const v2u w) { return (f32x4){bf_lo(w.x), bf_hi(w.x), bf_lo(w.y), bf_hi(w.y)}; }
__device__ __forceinline__ v2u pack4(const f32x4& a) { v2u w; w.x = cvt_pk_bf16(a.x, a.y); w.y = cvt_pk_bf16(a.z, a.w); return w; }

__device__ __forceinline__ f32x4 ch_perm(const f32x4& v, int idx4) {
    f32x4 o; o.x = __int_as_float(__builtin_amdgcn_ds_bpermute(idx4, __float_as_int(v.x))); o.y = __int_as_float(__builtin_amdgcn_ds_bpermute(idx4, __float_as_int(v.y)));
    o.z = __int_as_float(__builtin_amdgcn_ds_bpermute(idx4, __float_as_int(v.z))); o.w = __int_as_float(__builtin_amdgcn_ds_bpermute(idx4, __float_as_int(v.w))); return o; }
template <int MT, int DRY = 0>
__device__ __forceinline__ void phase_chain(Frame& F, const Inputs& I, int l) {
    constexpr int dry = DRY;
    constexpr int RP = MT == 5 ? 66 : 64;
    const int w = F.wave, r0 = RP * F.vcu;
    LAS unsigned char* lds = F.lds;
    unsigned char* ws = F.ws;
#define CH_LANE(PITCH) const int ln_ = lane_now(), i = ln_ & 15, q = ln_ >> 4; unsigned rb[MT], rs[MT]; bool ok[MT]; \
    _Pragma("unroll") for (int mt = 0; mt < MT; ++mt) { const int r = 16 * mt + i, rc = r < RP ? r : RP - 1; ok[mt] = r < RP; rb[mt] = (unsigned)rc * (PITCH); rs[mt] = (unsigned)(rc & 15); }
#define CH_ZERO() do { _Pragma("unroll") for (int mt = 0; mt < MT; ++mt) _Pragma("unroll") for (int nt = 0; nt < 4; ++nt) acc[mt][nt] = (f32x4){0.f, 0.f, 0.f, 0.f}; } while (0)
    {
        const bf16* Zg = (const bf16*)(ws + B_Z) + (size_t)r0 * 512; const bf16* Ag = (const bf16*)(ws + B_ATT) + (size_t)r0 * 512;
#pragma unroll 1
        for (int idx = w * 64 + lane_now(); idx < RP * 64; idx += 512) { const int row = idx >> 6, ch = idx & 63;
            const v4u z = *(const GAS v4u*)(Zg + (size_t)row * 512 + ch * 8), a = *(const GAS v4u*)(Ag + (size_t)row * 512 + ch * 8);
            const unsigned o = (unsigned)(row * 1024 + ((ch ^ (row & 15)) << 4));
            *(LAS v4u*)(lds + o) = z; *(LAS v4u*)(lds + RP * 1024 + o) = a; }
    }
    __syncthreads();
    f32x4 acc[MT][4];
    {
        CH_LANE(1024u);
        CH_ZERO();
        chain_mma<MT, 8>(acc, lds, rb, rs, q, (const char*)(ws + W_GLU) + ln_ * 16, 4 * w, dry);
        __syncthreads();
#pragma unroll
        for (int mt = 0; mt < MT; ++mt)
#pragma unroll
            for (int nt = 0; nt < 4; ++nt) if (ok[mt]) {
                const int c = 64 * w + 16 * nt + 4 * q; LAS v2u* p = (LAS v2u*)(lds + rb[mt] + ((unsigned)((c >> 3) ^ rs[mt]) << 4) + (c & 7) * 2);
                const f32x4 z = unpack4(*p), a = acc[mt][nt];
                *p = pack4((f32x4){z.x * sigmoid_f(a.x), z.y * sigmoid_f(a.y), z.z * sigmoid_f(a.z), z.w * sigmoid_f(a.w)});
            }
    }
    __syncthreads();
#ifndef CH_STAG_BR
#define CH_STAG_BR 0
#endif
#ifndef CH_STAG_OUT
#define CH_STAG_OUT 0
#endif
    if (CH_STAG_BR > 0 && w >= 4) __builtin_amdgcn_s_sleep(CH_STAG_BR);
#pragma unroll 1
    for (int p = 0; p < 2; ++p) {
        const int cb = 512 * p + 64 * w;
        CH_LANE(1024u);
        CH_ZERO();
        chain_mma<MT, 8>(acc, lds + RP * 1024, rb, rs, q, (const char*)(ws + W_BRA) + ln_ * 16, cb >> 4, dry);
        __builtin_amdgcn_sched_barrier(0);
        {
            const int sr = ln_ >> 2, sa = ln_ & 3, inv4 = (4 * (ln_ & 15) + (ln_ >> 4)) << 2;
            v2u gaq[2][4], gsq[2][4];
#define CH_E1_LOAD(mt_) do { const int R_ = 16 * (mt_) + sr, rc_ = (MT == 4 || R_ < RP) ? R_ : RP - 1; const size_t ro_ = (size_t)(r0 + rc_) * D + cb + 4 * sa; \
                _Pragma("unroll") for (int nt = 0; nt < 4; ++nt) { gaq[(mt_) & 1][nt] = (dry & 1) ? (v2u){0x3f803f80u, 0x3f803f80u} : *(const GAS v2u*)((const bf16*)(ws + B_GA) + ro_ + 16 * nt); \
                    gsq[(mt_) & 1][nt] = (dry & 1) ? (v2u){0x3f803f80u, 0x3f803f80u} : *(const GAS v2u*)((const bf16*)(ws + B_GS) + ro_ + 16 * nt); } } while (0)
            CH_E1_LOAD(0);
#pragma unroll
            for (int mt = 0; mt < MT; ++mt) {
                if (mt + 1 < MT) CH_E1_LOAD(mt + 1);
#pragma unroll
                for (int nt = 0; nt < 4; ++nt) { const f32x4 ga = unpack4(gaq[mt & 1][nt]), gs = unpack4(gsq[mt & 1][nt]);
                    f32x4 rt; rt.x = ga.x * __builtin_amdgcn_rcpf(fmaxf(gs.x, 0x1p-100f)); rt.y = ga.y * __builtin_amdgcn_rcpf(fmaxf(gs.y, 0x1p-100f));
                    rt.z = ga.z * __builtin_amdgcn_rcpf(fmaxf(gs.z, 0x1p-100f)); rt.w = ga.w * __builtin_amdgcn_rcpf(fmaxf(gs.w, 0x1p-100f));
                    acc[mt][nt] = acc[mt][nt] * ch_perm(rt, inv4); } }
#undef CH_E1_LOAD
        }
        __builtin_amdgcn_sched_barrier(0);
        chain_mma<MT, 8>(acc, lds, rb, rs, q, (const char*)(ws + W_BRS) + ln_ * 16, cb >> 4, dry);
        int r0e = r0; asm volatile("" : "+s"(r0e));
        {
            const int sr = ln_ >> 2, sa = ln_ & 3, fwd4 = ((ln_ >> 2) + 16 * (ln_ & 3)) << 2;
            v2u gsq[2][4];
#define CH_E2_LOAD(mt_) do { const int R_ = 16 * (mt_) + sr, rc_ = (MT == 4 || R_ < RP) ? R_ : RP - 1; const size_t ro_ = (size_t)(r0e + rc_) * D + cb + 4 * sa; \
                _Pragma("unroll") for (int nt = 0; nt < 4; ++nt) gsq[(mt_) & 1][nt] = (dry & 1) ? (v2u){0x3f803f80u, 0x3f803f80u} : *(const GAS v2u*)((const bf16*)(ws + B_GS) + ro_ + 16 * nt); } while (0)
            CH_E2_LOAD(0);
#pragma unroll
            for (int mt = 0; mt < MT; ++mt) { const int R = 16 * mt + sr; const size_t ro = (size_t)(r0e + R) * D + cb + 4 * sa;
                if (mt + 1 < MT) CH_E2_LOAD(mt + 1);
#pragma unroll
                for (int nt = 0; nt < 4; ++nt) { const f32x4 a = ch_perm(acc[mt][nt], fwd4), gs = unpack4(gsq[mt & 1][nt]);
                    if ((MT == 4 || R < RP) && !(dry & 1))
                        *(GAS v2u*)((bf16*)(ws + B_MB) + ro + 16 * nt) = pack4((f32x4){a.x * fmaxf(gs.x, 0x1p-100f), a.y * fmaxf(gs.y, 0x1p-100f), a.z * fmaxf(gs.z, 0x1p-100f), a.w * fmaxf(gs.w, 0x1p-100f)}); } }
#undef CH_E2_LOAD
        }
    }
    asm volatile("s_waitcnt vmcnt(0)" ::: "memory");
    __syncthreads();
    {
        const bf16* Mg = (const bf16*)(ws + B_MB) + (size_t)r0 * D;
#pragma unroll 1
        for (int idx = w * 64 + lane_now(); idx < RP * 128; idx += 512) { const int row = idx >> 7, ch = idx & 127;
            *(LAS v4u*)(lds + row * 2048 + ((ch ^ (row & 15)) << 4)) = *(const GAS v4u*)(Mg + (size_t)row * D + ch * 8); }
    }
    __syncthreads();
    if (CH_STAG_OUT > 0 && w >= 4) __builtin_amdgcn_s_sleep(CH_STAG_OUT);
#pragma unroll 1
    for (int p = 0; p < 2; ++p) {
        const int cb = 512 * p + 64 * w;
        CH_LANE(2048u);
        CH_ZERO();
        chain_mma<MT, 16>(acc, lds, rb, rs, q, (const char*)(ws + W_OUT) + ln_ * 16, cb >> 4, dry);
        int r0e = r0; asm volatile("" : "+s"(r0e));
        {
            const int sr = ln_ >> 2, sa = ln_ & 3, fwd4 = ((ln_ >> 2) + 16 * (ln_ & 3)) << 2;
            f32x4 xq[2][4], gq[2][4];
#define CH_E3_LOAD(mt_) do { const int R_ = 16 * (mt_) + sr, rc_ = (MT == 4 || R_ < RP) ? R_ : RP - 1, r_ = r0e + rc_, ws_ = r_ < S ? 0 : r_ < NTOK ? 1 : 2; \
                const float* xin_ = (l == 0 ? (r_ < NTOK ? I.x + (size_t)r_ * D : I.ctx + (size_t)(r_ - NTOK) * D) : (const float*)(ws + WS_XC) + (size_t)r_ * D) + cb + 4 * sa; \
                const float* gate_ = (const float*)(ws + SM_MOD) + (l * 3 + ws_) * 6144 + 2 * D + cb + 4 * sa; \
                _Pragma("unroll") for (int nt = 0; nt < 4; ++nt) { xq[(mt_) & 1][nt] = (dry & 1) ? (f32x4){0.f, 0.f, 0.f, 0.f} : *(const GAS f32x4*)(xin_ + 16 * nt); gq[(mt_) & 1][nt] = (dry & 1) ? (f32x4){0.f, 0.f, 0.f, 0.f} : *(const GAS f32x4*)(gate_ + 16 * nt); } } while (0)
            CH_E3_LOAD(0);
#pragma unroll
            for (int mt = 0; mt < MT; ++mt) { const int R = 16 * mt + sr, r = r0e + R;
                float* xo = (float*)(ws + WS_XC) + (size_t)r * D + cb + 4 * sa;
                if (mt + 1 < MT) CH_E3_LOAD(mt + 1);
#pragma unroll
                for (int nt = 0; nt < 4; ++nt) { const f32x4 a = ch_perm(acc[mt][nt], fwd4);
                    if ((MT == 4 || R < RP) && !(dry & 1)) *(GAS f32x4*)(xo + 16 * nt) = xq[mt & 1][nt] + gq[mt & 1][nt] * a; } }
#undef CH_E3_LOAD
        }
    }
#undef CH_ZERO
#undef CH_LANE
    __syncthreads();
}
using pg8::Unit;
#ifndef GEMM_ALIGN
#define GEMM_ALIGN true
#endif
#ifndef MOE_FUSED
#define MOE_FUSED 1
#endif
#ifndef E2_FUSED
#define E2_FUSED 0
#endif
#ifndef S1_IN_G1
#define S1_IN_G1 1
#endif
constexpr int CW_U = 94208;
#ifndef CHAIN
#define CHAIN 1
#endif
#ifndef S3_IN_AT
#define S3_IN_AT 1
#endif
#ifndef S2_FUSED
#define S2_FUSED 1
#endif
constexpr int CW_S1 = 90112;
#ifndef GEMM_SP2
#define GEMM_SP2 true
#endif
__device__ __forceinline__ v4u pack8(const f32x4& a, const f32x4& b) { v4u w; w.x = cvt_pk_bf16(a.x, a.y); w.y = cvt_pk_bf16(a.z, a.w); w.z = cvt_pk_bf16(b.x, b.y); w.w = cvt_pk_bf16(b.z, b.w); return w; }
__device__ __forceinline__ void unpack8(const v4u w, f32x4& a, f32x4& b) { a = (f32x4){bf_lo(w.x), bf_hi(w.x), bf_lo(w.y), bf_hi(w.y)}; b = (f32x4){bf_lo(w.z), bf_hi(w.z), bf_lo(w.w), bf_hi(w.w)}; }
__device__ __forceinline__ f32x4 sig4(const f32x4& v) { return (f32x4){sigmoid_f(v.x), sigmoid_f(v.y), sigmoid_f(v.z), sigmoid_f(v.w)}; }
__device__ __forceinline__ f32x4 gelu4(const f32x4& v) { return (f32x4){gelu_tanh_f(v.x), gelu_tanh_f(v.y), gelu_tanh_f(v.z), gelu_tanh_f(v.w)}; }

enum GemmKind { GK_INPROJ = 0, GK_S1, GK_S3, GK_GLU, GK_BR, GK_OUT, GK_MU, GK_MD, GK_MOE, GK_E2A, GK_E2B };
constexpr int CW_E2 = 49152;
__device__ __forceinline__ void store16_wt(unsigned char* ws, size_t byte_off, const v4u w) {
    const __amdgpu_buffer_rsrc_t rs = __builtin_amdgcn_make_buffer_rsrc(ws, 0, (int)WS_END, 0x00020000);
    __builtin_amdgcn_raw_buffer_store_b128(w, rs, (int)byte_off, 0, 16); }
__device__ __forceinline__ void wg_wait_count(unsigned char* ws, int word, unsigned need, int wv) {
    if (wv == 0) { gu32* w = (gu32*)(ws + WS_CTL) + word; unsigned sp = 0;
        while ((unsigned)__builtin_amdgcn_readfirstlane((int)__hip_atomic_load(w, RLX_AGENT)) < need) { __builtin_amdgcn_s_sleep(2);
            if (++sp > (1u << 20)) { if (lane_now() == 0) __hip_atomic_store((gu32*)(ws + WS_CTL) + CW_TMO, 1u, RLX_AGENT); break; } }
        __builtin_amdgcn_fence(__ATOMIC_ACQUIRE, "agent"); asm volatile("s_waitcnt vmcnt(0)" ::: "memory"); }
    asm volatile("" ::: "memory"); __builtin_amdgcn_s_barrier(); asm volatile("" ::: "memory"); }
__device__ __forceinline__ void wave_arrive(unsigned char* ws, int word) { asm volatile("s_waitcnt vmcnt(0)" ::: "memory"); if (lane_now() == 0) __hip_atomic_fetch_add((gu32*)(ws + WS_CTL) + word, 1u, RLX_AGENT); }
constexpr int CW_RDY = 16384;
struct GemmDesc { int kind, layer, G, c, vc, nM, wv; unsigned char* ws; const float* xlat; const float* xctx; };

template <int KIND> struct EpiAll {
    static constexpr bool PERM = true;
    GemmDesc d;
    typedef const f32x4 (&Acc)[2][2][4][2];
    __device__ __forceinline__ void inproj(Acc acc, const Unit& u, int wr, int wc, int fr, int fq) const {
        unsigned char* ws = d.ws;
        const int pn = u.pn, pm = u.pm, r0 = pm * 256 + wr * 64 + fr;
        const bool latent = pm < 64;
        if (pn <= 2) {
            const float* rope = (const float*)(ws + SM_ROPE);
            bf16* Q = (bf16*)(ws + B_Q); bf16* KB = (bf16*)(ws + B_K); bf16* VT = (bf16*)(ws + B_VT);
            const int jb = 8 * (fq & 1); const float sgn = fq < 2 ? -1.f : 1.f;
#pragma unroll
            for (int ai = 0; ai < 2; ++ai)
#pragma unroll
                for (int m = 0; m < 4; ++m) {
                    const int r = r0 + ai * 128 + m * 16;
                    f32x4 c0 = {1.f, 1.f, 1.f, 1.f}, c1 = c0, s0 = {0.f, 0.f, 0.f, 0.f}, s1 = s0;
                    if (latent) { const int s = r & 8191, pos = (wc & 1) ? (s & 63) : (s >> 6); const float* rp = rope + pos * 16 + jb;
                        c0 = *(const GAS f32x4*)rp; c1 = *(const GAS f32x4*)(rp + 4); s0 = *(const GAS f32x4*)(rp + 2048); s1 = *(const GAS f32x4*)(rp + 2052); }
#pragma unroll
                    for (int bj = 0; bj < 2; ++bj) {
                        f32x4 v0 = acc[ai][bj][m][0], v1 = acc[ai][bj][m][1];
                        if (pn == 2 && bj == 1) {
                            const int dd = 32 * (wc & 1) + 8 * fq, kvh = wc >> 1; bf16* vt; size_t pitch;
                            if (latent) { const int b = r >> 13, k_ = r & 8191, key = (k_ & ~12) | ((k_ & 4) << 1) | ((k_ & 8) >> 1); vt = VT + (size_t)((b * 2 + kvh) * 64 + dd) * S + key; pitch = S; }
                            else { const int rc = r - NTOK, b = rc >> 8, k_ = rc & 255, key = (k_ & ~12) | ((k_ & 4) << 1) | ((k_ & 8) >> 1); vt = VT + (size_t)NTOK * 128 + (size_t)((b * 2 + kvh) * 64 + dd) * CTX + key; pitch = CTX; }
                            vt[0] = (bf16)f2bf_rne(v0.x); vt[pitch] = (bf16)f2bf_rne(v0.y); vt[2 * pitch] = (bf16)f2bf_rne(v0.z); vt[3 * pitch] = (bf16)f2bf_rne(v0.w);
                            vt[4 * pitch] = (bf16)f2bf_rne(v1.x); vt[5 * pitch] = (bf16)f2bf_rne(v1.y); vt[6 * pitch] = (bf16)f2bf_rne(v1.z); vt[7 * pitch] = (bf16)f2bf_rne(v1.w);
                            continue;
                        }
                        if (latent) {
                            f32x4 p0, p1;
                            const int ln = fq * 16 + fr;
                            p0.x = xor32_f(v0.x, ln); p0.y = xor32_f(v0.y, ln); p0.z = xor32_f(v0.z, ln); p0.w = xor32_f(v0.w, ln);
                            p1.x = xor32_f(v1.x, ln); p1.y = xor32_f(v1.y, ln); p1.z = xor32_f(v1.z, ln); p1.w = xor32_f(v1.w, ln);
                            v0 = v0 * c0 + (p0 * s0) * sgn; v1 = v1 * c1 + (p1 * s1) * sgn;
                        }
                        if (pn < 2) { v0 = v0 * C2; v1 = v1 * C2; *(GAS v4u*)(Q + (size_t)r * 512 + pn * 256 + bj * 128 + wc * 32 + 8 * fq) = pack8(v0, v1); }
                        else *(GAS v4u*)(KB + (size_t)r * 128 + wc * 32 + 8 * fq) = pack8(v0, v1);
                    }
                }
        } else if (pn <= 4) {
            bf16* A3 = (bf16*)(ws + B_A3);
#pragma unroll
            for (int ai = 0; ai < 2; ++ai)
#pragma unroll
                for (int m = 0; m < 4; ++m) {
                    const int r = r0 + ai * 128 + m * 16, cidx = r >> 5, s = r & 31;
#pragma unroll
                    for (int bj = 0; bj < 2; ++bj) { const int c = 256 * (pn - 3) + 128 * bj + 32 * wc + 8 * fq, g = c >> 4, mp0 = c & 15;
#if S1_IN_G1
                        store16_wt(ws, B_A3 + ((size_t)(g * NCH + cidx) * 768 + s * 16 + mp0) * 2, pack8(acc[ai][bj][m][0], acc[ai][bj][m][1])); }
#else
                        *(GAS v4u*)(A3 + ((size_t)(g * NCH + cidx) * 768 + s * 16 + mp0)) = pack8(acc[ai][bj][m][0], acc[ai][bj][m][1]); }
#endif
                }
        } else {
            bf16* Gt = (bf16*)(ws + (pn <= 8 ? B_GA : B_GS)); const int cb = 256 * (pn <= 8 ? pn - 5 : pn - 9);
#pragma unroll
            for (int ai = 0; ai < 2; ++ai)
#pragma unroll
                for (int m = 0; m < 4; ++m) {
                    const int r = r0 + ai * 128 + m * 16;
#pragma unroll
                    for (int bj = 0; bj < 2; ++bj) *(GAS v4u*)(Gt + (size_t)r * D + cb + 128 * bj + 32 * wc + 8 * fq) = pack8(sig4(acc[ai][bj][m][0]), sig4(acc[ai][bj][m][1]));
                }
        }
    }
    __device__ __forceinline__ void operator()(Acc acc, const Unit& u, int wr, int wc, int fr, int fq) const {
        unsigned char* ws = d.ws;
        if constexpr (KIND == GK_INPROJ) {
            if (S1_IN_G1 && u.k2 == 1) {
                float* send = (float*)(ws + B_SEND) + (size_t)(u.aux * NCH + u.pm * 256 + wr * 64 + fr) * 256 + wc * 32 + 8 * fq;
#pragma unroll
                for (int ai = 0; ai < 2; ++ai)
#pragma unroll
                    for (int m = 0; m < 4; ++m)
#pragma unroll
                        for (int bj = 0; bj < 2; ++bj) { float* o = send + (size_t)(ai * 128 + m * 16) * 256 + bj * 128; *(GAS f32x4*)o = acc[ai][bj][m][0]; *(GAS f32x4*)(o + 4) = acc[ai][bj][m][1]; }
                return;
            }
            inproj(acc, u, wr, wc, fr, fq); return; }
        const int r0 = u.pm * 256 + wr * 64 + fr, c0 = u.pn * 256 + wc * 32 + 8 * fq;
        f32x4 og[2][2] = {};
        if constexpr (KIND == GK_OUT || KIND == GK_E2B) { const int w = u.pm < 64 ? (u.pm >> 5) : 2; const float* gate = (const float*)(ws + SM_MOD) + (d.layer * 3 + w) * 6144 + 2 * D + c0;
#pragma unroll
            for (int bj = 0; bj < 2; ++bj) { og[bj][0] = *(const GAS f32x4*)(gate + bj * 128); og[bj][1] = *(const GAS f32x4*)(gate + bj * 128 + 4); } }
#pragma unroll
        for (int aq = 0; aq < 4; ++aq) { const int ai = aq >> 1, mb = (aq & 1) * 2;
            v4u LA[4][2] = {}, LB[4][2] = {}; float LW[4] = {};
#pragma unroll
            for (int m = mb; m < mb + 2; ++m) {
                const int r = r0 + ai * 128 + m * 16;
                if constexpr (KIND == GK_MD) LW[m] = ((const float*)(ws + SM_RWS))[r];
                if constexpr (KIND == GK_MOE) { if (u.k2 == 1) LW[m] = ((const float*)(ws + SM_RWS))[r]; }
#pragma unroll
                for (int bj = 0; bj < 2; ++bj) { const int c = c0 + bj * 128;
                    if constexpr (KIND == GK_GLU) LA[m][bj] = *(const GAS v4u*)((const bf16*)(ws + B_Z) + (size_t)r * 512 + c);
                    if constexpr (KIND == GK_BR) { const size_t o = (size_t)r * D + c; if (u.aux == 0) LA[m][bj] = *(const GAS v4u*)((const bf16*)(ws + B_GA) + o); else { LA[m][bj] = *(const GAS v4u*)((const bf16*)(ws + B_GS) + o); LB[m][bj] = *(const GAS v4u*)((const bf16*)(ws + B_T1) + o); } }
                    if constexpr (KIND == GK_OUT || KIND == GK_E2B) { const float* xin = (r < NTOK ? d.xlat + (size_t)r * D : d.xctx + (size_t)(r - NTOK) * D) + c; LA[m][bj] = *(const GAS v4u*)xin; LB[m][bj] = *(const GAS v4u*)(xin + 4); }
                }
            }
#pragma unroll
            for (int m = mb; m < mb + 2; ++m) {
                const int r = r0 + ai * 128 + m * 16;
#pragma unroll
                for (int bj = 0; bj < 2; ++bj) {
                    const int c = c0 + bj * 128;
                    const f32x4 v0 = acc[ai][bj][m][0], v1 = acc[ai][bj][m][1];
                    switch (KIND) {
                    case GK_S1: {
                        const size_t o = B_SEND + ((size_t)(u.aux * NCH + r) * 256 + c) * 4;
#if S2_FUSED
                        store16_wt(ws, o, __builtin_bit_cast(v4u, v0)); store16_wt(ws, o + 16, __builtin_bit_cast(v4u, v1));
#else
                        *(GAS f32x4*)(ws + o) = v0; *(GAS f32x4*)(ws + o + 16) = v1;
#endif
                        } break;
                    case GK_S3: {
                        const int t = c >> 4, m0 = c & 15; *(GAS v4u*)((bf16*)(ws + B_Z) + (size_t)(r * 32 + t) * 512 + u.aux * 16 + m0) = pack8(gelu4(v0), gelu4(v1)); } break;
                    case GK_GLU: {
                        const size_t o = (size_t)r * 512 + c; f32x4 z0, z1; unpack8(LA[m][bj], z0, z1);
                        *(GAS v4u*)((bf16*)(ws + B_SG) + o) = pack8(z0 * sig4(v0), z1 * sig4(v1)); } break;
                    case GK_BR: {
                        const size_t o = (size_t)r * D + c;
                        if (u.aux == 0) { f32x4 g0, g1; unpack8(LA[m][bj], g0, g1); *(GAS v4u*)((bf16*)(ws + B_T1) + o) = pack8(g0 * v0, g1 * v1); }
                        else { f32x4 g0, g1, t0, t1; unpack8(LA[m][bj], g0, g1); unpack8(LB[m][bj], t0, t1);
                            *(GAS v4u*)((bf16*)(ws + B_MB) + o) = pack8(t0 + g0 * v0, t1 + g1 * v1); } } break;
                    case GK_E2B:
                    case GK_OUT: {
                        float* xo = (float*)(ws + WS_XC) + (size_t)r * D + c;
                        *(GAS f32x4*)xo = __builtin_bit_cast(f32x4, LA[m][bj]) + og[bj][0] * v0; *(GAS f32x4*)(xo + 4) = __builtin_bit_cast(f32x4, LB[m][bj]) + og[bj][1] * v1; } break;
                    case GK_MU: {
                        const f32x4 a = v0 * sig4(v0) * v1; v2u w; w.x = cvt_pk_bf16(a.x, a.y); w.y = cvt_pk_bf16(a.z, a.w);
                        *(GAS v2u*)((bf16*)(ws + B_ACT) + (size_t)r * DE + (c >> 1)) = w; } break;
                    case GK_E2A: {
                        if (u.aux == 0) { const size_t o = (size_t)r * 512 + c; f32x4 z0, z1; unpack8(*(const GAS v4u*)((const bf16*)(ws + B_Z) + o), z0, z1); store16_wt(ws, B_SG + o * 2, pack8(z0 * sig4(v0), z1 * sig4(v1))); }
                        else { const size_t o = (size_t)r * D + c;
                            if (u.aux == 1) { f32x4 g0, g1; unpack8(*(const GAS v4u*)((const bf16*)(ws + B_GA) + o), g0, g1); *(GAS v4u*)((bf16*)(ws + B_T1) + o) = pack8(g0 * v0, g1 * v1); }
                            else { f32x4 g0, g1, t0, t1; unpack8(*(const GAS v4u*)((const bf16*)(ws + B_GS) + o), g0, g1); unpack8(*(const GAS v4u*)((const bf16*)(ws + B_T1) + o), t0, t1); store16_wt(ws, B_MB + o * 2, pack8(t0 + g0 * v0, t1 + g1 * v1)); } } } break;
                    case GK_MOE: {
                        if (u.k2 == 0) { const f32x4 a = v0 * sig4(v0) * v1; const unsigned long long w = (unsigned long long)cvt_pk_bf16(a.x, a.y) | ((unsigned long long)cvt_pk_bf16(a.z, a.w) << 32);
                            __hip_atomic_store((GAS unsigned long long*)((bf16*)(ws + B_ACT) + (size_t)r * DE + (c >> 1)), w, __ATOMIC_RELAXED, __HIP_MEMORY_SCOPE_AGENT); }
                        else { const float w = LW[m]; *(GAS v4u*)((bf16*)(ws + B_YE) + (size_t)r * D + c) = pack8(v0 * w, v1 * w); } } break;
                    default: {
                        const float w = LW[m]; *(GAS v4u*)((bf16*)(ws + B_YE) + (size_t)r * D + c) = pack8(v0 * w, v1 * w); } break;
                    }
                }
            }
        }
    }
};
template <int KIND> struct SchedAll {
    static constexpr bool VARK = (KIND == GK_MOE) || (KIND == GK_INPROJ && S1_IN_G1);
    GemmDesc d; const volatile LAS int* tp;
    __device__ __forceinline__ int wave_index() const { return d.wv; }
    __device__ __forceinline__ void a_ready(const Unit& u) const {
        if constexpr (KIND == GK_INPROJ && S1_IN_G1) { if (u.k2 == 1) wg_wait_count(d.ws, CW_U + 64 * (d.layer * 8 + u.pm * 2 + (u.aux >> 4)), u.pm < 2 ? 256u : 16u, d.wv); }
        if constexpr (KIND == GK_S3 && S3_IN_AT) wg_wait_count(d.ws, CW_S1 + 64 * (d.layer * 32 + u.aux), 32u, d.wv);
        if constexpr (KIND == GK_E2A) { if (u.aux == 2) wg_wait_count(d.ws, CW_E2 + 64 * (d.layer * 160 + u.pm), 16u, d.wv); }
        if constexpr (KIND == GK_E2B) wg_wait_count(d.ws, CW_E2 + 64 * (d.layer * 160 + 66 + u.pm), 32u, d.wv);
        if constexpr (KIND == GK_MOE) {
            if (u.k2 == 1) {
                if (d.wv == 0) {
                    gu32* w = (gu32*)(d.ws + WS_CTL) + CW_RDY + 64 * (d.layer * 256 + u.pm); unsigned sp = 0;
                    while ((unsigned)__builtin_amdgcn_readfirstlane((int)__hip_atomic_load(w, RLX_AGENT)) < 32u) {
                        __builtin_amdgcn_s_sleep(2);
                        if (++sp > (1u << 20)) { if (lane_now() == 0) __hip_atomic_store((gu32*)(d.ws + WS_CTL) + CW_TMO, 1u, RLX_AGENT); break; } }
                    __builtin_amdgcn_fence(__ATOMIC_ACQUIRE, "agent");
                    asm volatile("s_waitcnt vmcnt(0)" ::: "memory");
                }
                asm volatile("" ::: "memory"); __builtin_amdgcn_s_barrier(); asm volatile("" ::: "memory");
            }
        }
    }
    __device__ __forceinline__ void done(const Unit& u) const {
        if constexpr (KIND == GK_INPROJ && S1_IN_G1) { if (u.k2 == 0 && (u.pn == 3 || u.pn == 4)) wave_arrive(d.ws, CW_U + 64 * (d.layer * 8 + (u.pm < 32 ? 0 : u.pm < 64 ? 1 : 2) * 2 + (u.pn - 3))); }
        if constexpr (KIND == GK_S1 && S2_FUSED) wave_arrive(d.ws, CW_S1 + 64 * (d.layer * 32 + u.aux));
        if constexpr (KIND == GK_E2A) { if (u.aux == 0) wave_arrive(d.ws, CW_E2 + 64 * (d.layer * 160 + u.pm)); else if (u.aux == 2) wave_arrive(d.ws, CW_E2 + 64 * (d.layer * 160 + 66 + u.pm)); }
        if constexpr (KIND == GK_MOE) {
            if (u.k2 == 0) {
                asm volatile("s_waitcnt vmcnt(0)" ::: "memory");
                if (lane_now() == 0) __hip_atomic_fetch_add((gu32*)(d.ws + WS_CTL) + CW_RDY + 64 * (d.layer * 256 + u.pm), 1u, RLX_AGENT);
            }
        }
    }
    __device__ __forceinline__ bool next(int i, Unit& u) const {
        unsigned char* ws = d.ws; int pm, pn, aux = 0; size_t ao, bo;
        switch (KIND) {
#if S1_IN_G1
        case GK_INPROJ: {
            const int nctx = d.layer == 0 ? 26 : 6, total = 64 * 13 + nctx, L = i * d.G + d.c;
            if (L >= total) { const int n1 = d.c < total ? (total - 1 - d.c) / d.G + 1 : 0, j = (i - n1) * d.G + (d.G - 1 - d.c); if (j >= NG * 3) return false;
                aux = j / 3; pm = j % 3; pn = 0;
                u.pm = pm; u.pn = pn; u.aux = aux; u.k2 = 1; u.A = (const char*)ws + B_A3 + (size_t)(aux * NCH + pm * 256) * 768 * 2; u.B = (const char*)ws + W_SE + (size_t)(aux * 256) * 512 * 2; return true; }
            if (L < nctx) { if (d.layer == 0) { pm = 64 + L / 13; pn = L % 13; } else { pm = 64 + L / 3; pn = 2 + L % 3; } }
            else pg8::tile_of(L - nctx, 64, 13, pm, pn);
            ao = WS_H + (size_t)pm * 256 * D * 2; bo = W_IN + (size_t)pn * 256 * D * 2; } break;
#else
        case GK_INPROJ: { const int L = i * d.G + d.c;
            if (L < 64 * 13) pg8::tile_of(L, 64, 13, pm, pn);
            else { const int k = L - 64 * 13; if (d.layer == 0) { if (k >= 26) return false; pm = 64 + k / 13; pn = k % 13; } else { if (k >= 6) return false; pm = 64 + k / 3; pn = 2 + k % 3; } }
            ao = WS_H + (size_t)pm * 256 * D * 2; bo = W_IN + (size_t)pn * 256 * D * 2; } break;
#endif
        case GK_S1: { const int L = i * d.G + (S2_FUSED ? (d.G - 1 - d.vc) : d.vc); if (L >= NG * 3) return false; aux = L / 3; pm = L % 3; pn = 0;
            ao = B_A3 + (size_t)(aux * NCH + pm * 256) * 768 * 2; bo = W_SE + (size_t)(aux * 256) * 512 * 2; } break;
#if S3_IN_AT
        case GK_S3: {
            const int v = d.vc - 128; if (v < 0 || i > 1) return false;
            if (i == 0) { aux = v >> 2; pm = (v >> 1) & 1; pn = v & 1; } else { if (d.layer != 0 || v < 64) return false; aux = (v - 64) >> 1; pm = 2; pn = v & 1; }
#else
        case GK_S3: { const int L = i * d.G + d.vc; if (L >= NG * 6) return false; aux = L / 6; const int rem = L % 6; pm = rem >> 1; pn = rem & 1;
#endif
            ao = B_A3 + (size_t)(aux * NCH + pm * 256) * 768 * 2; bo = W_S3 + (size_t)(aux * 512 + pn * 256) * 768 * 2; } break;
        case GK_GLU: { const int L = i * d.G + d.c; if (L >= d.nM * 2) return false; pg8::tile_of(L, d.nM, 2, pm, pn);
            ao = B_Z + (size_t)pm * 256 * 512 * 2; bo = W_GLU + (size_t)pn * 256 * 512 * 2; } break;
        case GK_BR: { const int Lp = (i >> 1) * d.G + d.c; aux = i & 1; if (Lp >= d.nM * 4) return false; pg8::tile_of(Lp, d.nM, 4, pm, pn);
            ao = (aux ? B_SG : B_ATT) + (size_t)pm * 256 * 512 * 2; bo = (aux ? W_BRS : W_BRA) + (size_t)pn * 256 * 512 * 2; } break;
        case GK_OUT: { const int L = i * d.G + d.c; if (L >= d.nM * 4) return false; pg8::tile_of(L, d.nM, 4, pm, pn);
            ao = B_MB + (size_t)pm * 256 * D * 2; bo = W_OUT + (size_t)pn * 256 * D * 2; } break;
        case GK_E2A: {
            const int G = d.G, c = d.c, NGL = d.nM * 2, nglu = c < NGL ? (NGL - 1 - c) / G + 1 : 0;
            if (i < nglu) { const int L = i * G + c; pg8::tile_of(L, d.nM, 2, pm, pn); aux = 0; ao = B_Z + (size_t)pm * 256 * 512 * 2; bo = W_GLU + (size_t)pn * 256 * 512 * 2; }
            else { const int k = i - nglu, Lp = (k >> 1) * G + c; if (Lp >= 256) return false; aux = 1 + (k & 1); pg8::tile_of(Lp, 64, 4, pm, pn);
                ao = (aux == 2 ? B_SG : B_ATT) + (size_t)pm * 256 * 512 * 2; bo = (aux == 2 ? W_BRS : W_BRA) + (size_t)pn * 256 * 512 * 2; } } break;
        case GK_E2B: { const int L = i * d.G + d.c; if (L >= 256) return false; pg8::tile_of(L, 64, 4, pm, pn);
            ao = B_MB + (size_t)pm * 256 * D * 2; bo = W_OUT + (size_t)pn * 256 * D * 2; } break;
        case GK_MOE: {
            const int G = d.G, vc = d.vc, U = tp[NE] * 4, q = U / G, r = U % G, nmu = q + (vc < r ? 1 : 0);
            int L, k2;
            if (i < nmu) { L = i * G + vc; k2 = 0; }
            else { const int k = i - nmu; int first = 2 * (G - r); if (first > U) first = U; k2 = 1;
                if (vc >= r && k < 2) { L = k * (G - r) + (vc - r); if (L >= first) return false; }
                else { const int kb = vc >= r ? k - 2 : k; L = first + kb * G + vc; if (L >= U) return false; } }
            pm = L >> 2; pn = L & 3;
            int e = 0;
#pragma unroll 1
            for (int kk = 1; kk < NE; ++kk) if (tp[kk] <= pm) e = kk;
            aux = e;
            if (k2 == 0) { ao = B_HS + (size_t)pm * 256 * D * 2; bo = W_GU + (size_t)e * 1024 * 1024 * 2 + (size_t)pn * 256 * D * 2; }
            else { ao = B_ACT + (size_t)pm * 256 * DE * 2; bo = W_DN + (size_t)e * 1024 * 512 * 2 + (size_t)pn * 256 * DE * 2; }
            u.pm = pm; u.pn = pn; u.aux = aux; u.k2 = k2; u.A = (const char*)ws + ao; u.B = (const char*)ws + bo; return true; }
        default: {
            const int L = i * d.G + d.vc, TT = tp[NE]; if (L >= TT * 4) return false; pm = L >> 2; pn = L & 3;
            int e = 0;
#pragma unroll 1
            for (int k = 1; k < NE; ++k) if (tp[k] <= pm) e = k;
            aux = e;
            if (KIND == GK_MU) { ao = B_HS + (size_t)pm * 256 * D * 2; bo = W_GU + (size_t)e * 1024 * 1024 * 2 + (size_t)pn * 256 * D * 2; }
            else { ao = B_ACT + (size_t)pm * 256 * DE * 2; bo = W_DN + (size_t)e * 1024 * 512 * 2 + (size_t)pn * 256 * DE * 2; } } break;
        }
        u.pm = pm; u.pn = pn; u.aux = aux; u.k2 = 0; u.A = (const char*)ws + ao; u.B = (const char*)ws + bo; return true;
    }
};

#ifndef PHMASK
#define PHMASK 0xFFFFFFFFu
#endif
#define PHON(b) (((PHMASK) >> (b)) & 1u)
struct Args { Inputs in; float* out; unsigned char* ws; int ph_lo, ph_hi; };
enum { T_P0 = 0, T_N1, T_G1, T_AT, T_S2, T_S3, T_GLU, T_BR, T_OUT, T_N2, T_MG, T_MU, T_MD, T_FINAL };
constexpr int PH_PER_LAYER = 12, PH_FINAL = 1 + 2 * PH_PER_LAYER, N_PHASES = PH_FINAL + 1;
__global__ void __launch_bounds__(NWAVES * 64, 2) mega_fwd(Args args) {
    extern __shared__ __attribute__((aligned(16))) unsigned char lds[];
    Frame F;
    F.lds = (LAS unsigned char*)lds;
    F.tid = threadIdx.x; F.lane = F.tid & 63; F.wave = __builtin_amdgcn_readfirstlane(F.tid >> 6);
    F.G = gridDim.x; { const int bx = blockIdx.x; F.vcu = (F.G % 8 == 0) ? (bx % 8) * (F.G / 8) + bx / 8 : bx; }
    F.ws = args.ws; F.ctl = (gu32*)(args.ws + WS_CTL); F.out = args.out;
    const Inputs& I = args.in;
    for (int u = F.tid; u < (LDS_BYTES - LDSCTL_OFF) / 4; u += NWAVES * 64) ((LAS unsigned*)(F.lds + LDSCTL_OFF))[u] = 0u;
    __syncthreads();
    const int lo = args.ph_lo & 0xff, hi = args.ph_hi, dbgf = args.ph_lo >> 8;
    XcdBarrier bar; bar.bar = (unsigned*)(F.ctl + CW_BAR); bar.x = 0; bar.st = nullptr;
    if (hi - lo > 1) bar = xcd_barrier_post((unsigned*)(F.ctl + CW_BAR), (volatile LAS unsigned*)(F.lds + L_BARST));
#ifdef TSTAMP
    if (blockIdx.x == 0 && threadIdx.x == 0) ((unsigned long long*)(F.ws + 131072))[0] = __builtin_amdgcn_s_memrealtime();
#endif
#pragma unroll 1
    for (int ph = lo; ph < hi; ++ph) {
        int t, l;
        { unsigned char* w_ = F.ws; gu32* c_ = F.ctl; float* o_ = F.out; LAS unsigned char* l_ = F.lds; int v_ = F.vcu, g_ = F.G;
          asm volatile("" : "+s"(w_), "+s"(c_), "+s"(o_), "+s"(l_), "+s"(v_), "+s"(g_)); F.ws = w_; F.ctl = c_; F.out = o_; F.lds = l_; F.vcu = v_; F.G = g_;
          int wv_ = F.wave; asm volatile("" : "+s"(wv_)); F.wave = wv_; F.lane = lane_now(); F.tid = wv_ * 64 + F.lane; }
        if (ph == 0) { t = T_P0; l = 0; } else if (ph == PH_FINAL) { t = T_FINAL; l = 1; } else { l = (ph - 1) / PH_PER_LAYER; t = (ph - 1) % PH_PER_LAYER + 1; }
        if (t == T_P0 || (t == T_N1 && l == 1)) {
            if (PHON(0) && !(dbgf & 1) && F.vcu < NG) ssmgen_job(F, I, l, F.vcu);
            if (t == T_P0 && !(dbgf & 4)) { if (PHON(1) && F.vcu >= NG && F.vcu < NG + 192) mod_item(F, I, F.vcu - NG); if (PHON(2)) p0_small(F, I); }
            if (PHON(3) && !(dbgf & 2)) convert_weights(F, I, l);
        }
        if (t == T_N1) { if (PHON(4)) phase_norm1(F, I, l); }
#if CHAIN
#ifdef PROBE_DRY
        else if (t == T_GLU) { if (PHON(11)) { if (l == 0) {
                    phase_chain<5, (PROBE_DRY)>(F, I, 0); phase_chain<5>(F, I, 0); } else phase_chain<4>(F, I, 1); } }
#else
        else if (t == T_GLU) { if (PHON(11)) { if (l == 0) phase_chain<5>(F, I, 0); else phase_chain<4>(F, I, 1); } }
#endif
        else if (t == T_BR || t == T_OUT) {}
#endif
        else if (t >= T_G1 && t <= T_MD && t != T_S2 && t != T_N2 && t != T_MG) {
            GemmDesc d; d.layer = l; d.G = F.G; d.c = (int)blockIdx.x; d.vc = F.vcu; d.nM = l == 0 ? 66 : 64; d.ws = F.ws; d.wv = F.wave;
            d.xlat = l == 0 ? I.x : (const float*)(F.ws + WS_XC); d.xctx = l == 0 ? I.ctx : (const float*)(F.ws + WS_XC) + (size_t)NTOK * D;
#ifdef SUBSTAMP
#define SUBST(id) do { if (l == 0 && F.tid == 0 && (blockIdx.x == 0 || blockIdx.x == 255)) ((unsigned long long*)(F.ws + 131072 + 1024))[(blockIdx.x == 0 ? 0 : 16) + (id)] = __builtin_amdgcn_s_memrealtime(); } while (0)
#else
#define SUBST(id) do {} while (0)
#endif
            if (t == T_MU || (t == T_MD && !MOE_FUSED)) moe_tables(F, l);
            const volatile LAS int* tp = (const volatile LAS int*)(F.lds + L_MOETAB);
#define RUN_GEMM(KIND_, K_, LDA_, LDB_) do { d.kind = KIND_; SchedAll<KIND_> Sc{d, tp}; EpiAll<KIND_> E{d}; pg8::gemm_phase<EpiAll<KIND_>, SchedAll<KIND_>, GEMM_ALIGN, GEMM_SP2>(F.lds, K_, LDA_, LDB_, Sc, E); } while (0)
#define RUN_GEMM2 RUN_GEMM
            switch (t) {
#if S1_IN_G1
            case T_G1: if (PHON(5)) { d.kind = GK_INPROJ; SchedAll<GK_INPROJ> Sc{d, tp}; EpiAll<GK_INPROJ> E{d}; pg8::gemm_phase<EpiAll<GK_INPROJ>, SchedAll<GK_INPROJ>, GEMM_ALIGN, true>(F.lds, D, D, D, Sc, E, 512, 768, 512); } break;
            case T_AT: break;
            case T_S3: if (!S3_IN_AT && PHON(10)) RUN_GEMM(GK_S3, 768, 768, 768); break;
#else
            case T_G1: if (PHON(5)) RUN_GEMM(GK_INPROJ, D, D, D); break;
            case T_AT: SUBST(0); if (PHON(6)) RUN_GEMM(GK_S1, 512, 768, 512); SUBST(1); break;
#endif
#if !S1_IN_G1
            case T_S3: if (PHON(10)) RUN_GEMM(GK_S3, 768, 768, 768); break;
#endif
#if E2_FUSED
            case T_GLU: if (PHON(11)) { RUN_GEMM(GK_E2A, 512, 512, 512);
                    if (l == 0) { wg_wait_count(F.ws, CW_E2 + 64 * (0 * 160 + 64 + (F.vcu >> 7)), 16u, F.wave); ctx_small_gemm(F, I, 0); }
                    RUN_GEMM(GK_E2B, D, D, D);
                    if (l == 0) { wg_wait_count(F.ws, CW_E2 + 64 * (0 * 160 + 130 + (F.vcu >> 4)), 32u, F.wave); ctx_small_gemm(F, I, 1); } } break;
            case T_BR: case T_OUT: break;
#else
            case T_GLU: if (PHON(11)) RUN_GEMM(GK_GLU, 512, 512, 512); break;
            case T_BR: d.nM = 64; if (PHON(12)) RUN_GEMM(GK_BR, 512, 512, 512); if (l == 0) ctx_small_gemm(F, I, 0); break;
            case T_OUT: d.nM = 64; if (PHON(13)) RUN_GEMM(GK_OUT, D, D, D); if (l == 0) ctx_small_gemm(F, I, 1); break;
#endif
#if MOE_FUSED
            case T_MU: if (PHON(16)) { d.kind = GK_MOE; SchedAll<GK_MOE> Sc{d, tp}; EpiAll<GK_MOE> E{d}; pg8::gemm_phase<EpiAll<GK_MOE>, SchedAll<GK_MOE>, GEMM_ALIGN, true>(F.lds, D, D, D, Sc, E, DE, DE, DE); } break;
            default: break;
#else
            case T_MU: if (PHON(16)) RUN_GEMM(GK_MU, D, D, D); break;
            default: if (PHON(17)) RUN_GEMM(GK_MD, DE, DE, DE); break;
#endif
            }
#if S3_IN_AT
            if (t == T_AT) {
                if (F.vcu < 128) { if (PHON(8)) phase_ssm_carry<true>(F, l); wave_arrive(F.ws, CW_S1 + 64 * (l * 32 + (F.vcu >> 2))); }
                if (PHON(7)) phase_attn_latent(F, I, l);
                if (PHON(9) && l == 0) phase_attn_ctx(F, I, l, 128);
                __syncthreads();
                if (PHON(10)) RUN_GEMM2(GK_S3, 768, 768, 768);
            }
#else
            if (t == T_AT && PHON(7)) phase_attn_latent(F, I, l);
            if (t == T_AT) SUBST(2);
#endif
#if S2_FUSED && !S3_IN_AT
            if (t == T_AT) { if (F.vcu < 128) { if (!S1_IN_G1) wg_wait_count(F.ws, CW_S1 + 64 * (l * 32 + (F.vcu >> 2)), 24u, F.wave); if (PHON(8)) phase_ssm_carry<false>(F, l); } if (PHON(9) && l == 0) phase_attn_ctx(F, I, l, 128); SUBST(3); }
#endif
        }
        else if (t == T_S2) {
#if !S2_FUSED
            if (PHON(8)) phase_ssm_carry<false>(F, l); if (PHON(9) && l == 0) phase_attn_ctx(F, I, l, 128);
#endif
        }
        else if (t == T_N2) { if (PHON(14)) phase_norm2_route(F, I, l, dbgf); }
        else if (t == T_MG) { if (PHON(15)) phase_gather(F, l); }
        else if (t == T_FINAL) { if (PHON(18)) phase_final(F, I); }
        if (ph + 1 < hi && !(MOE_FUSED && t == T_MD) && !(E2_FUSED && (t == T_BR || t == T_OUT)) && !(S2_FUSED && t == T_S2) && !(S3_IN_AT && t == T_S3) && !(CHAIN && (t == T_BR || t == T_OUT))) { bar.bar = (unsigned*)(F.ctl + CW_BAR); xcd_barrier(bar, F.wave * 64 + lane_now() == 0);
#ifdef DOUBLE_BAR
            xcd_barrier(bar, F.wave * 64 + lane_now() == 0); xcd_barrier(bar, F.wave * 64 + lane_now() == 0);
#endif
        }
#ifdef TSTAMP
        if (blockIdx.x == 0 && F.wave * 64 + lane_now() == 0) ((unsigned long long*)(F.ws + 131072))[1 + ph] = __builtin_amdgcn_s_memrealtime();
#endif
    }
#if defined(TSTAMP) && defined(TS_SPIN_SET)
    if (blockIdx.x == 0 && F.wave * 64 + lane_now() == 0) {
        const unsigned long long* ts = (const unsigned long long*)(F.ws + 131072); unsigned long long d = 0;
        for (int p = 0; p < N_PHASES; ++p) if (((unsigned long long)(TS_SPIN_SET) >> p) & 1ull) d += ts[1 + p] - ts[p];
#ifdef SUBSTAMP
        { const unsigned long long* t2 = (const unsigned long long*)(F.ws + 131072 + 1024); d += t2[SUB_B] - t2[SUB_A]; }
#endif
        const unsigned long long t0 = __builtin_amdgcn_s_memrealtime(), want = d * (TS_SPIN_K);
        while (__builtin_amdgcn_s_memrealtime() - t0 < want) __builtin_amdgcn_s_sleep(16);
    }
#endif
}

#ifdef DBG_STOP
__global__ void dbg_copy(const unsigned char* ws, float* out, size_t n) {
    for (size_t i = (size_t)blockIdx.x * blockDim.x + threadIdx.x; i < n; i += (size_t)gridDim.x * blockDim.x) {
        const size_t j = i % (size_t)(DBG_ELEMS);
#ifdef DBG_F32
        out[i] = ((const float*)(ws + (DBG_OFF)))[j];
#else
        out[i] = __uint_as_float((unsigned)((const unsigned short*)(ws + (DBG_OFF)))[j] << 16);
#endif
    }
}
#endif
#ifdef TSTAMP
__global__ void dbg_times(const unsigned char* ws, float* out, size_t n, unsigned set1, unsigned set2) {
    const unsigned long long* ts = (const unsigned long long*)(ws + 131072);
    unsigned long long s1 = 0, s2 = 0;
    for (int p = 0; p < N_PHASES; ++p) { const unsigned long long d = ts[1 + p] - ts[p]; if ((set1 >> p) & 1) s1 += d; if ((set2 >> p) & 1) s2 += d; }
    const float v1 = sqrtf((float)s1), v2 = (float)s2;
    for (size_t i = (size_t)blockIdx.x * blockDim.x + threadIdx.x; i < n; i += (size_t)gridDim.x * blockDim.x) out[i] = i == 0 ? v2 : v1;
}
#endif
#if defined(REP_SET) && defined(REP_FLUSH)
__global__ void dbg_flush(const float* p, size_t n, float* sink) {
    float a = 0.f;
    for (size_t i = (size_t)blockIdx.x * blockDim.x + threadIdx.x; i < n; i += (size_t)gridDim.x * blockDim.x) a += p[i];
    if (a == 12345.678f) sink[0] = a;
}
#endif
extern "C" void kernel_launch(void* const* d_in, const int* in_sizes, int n_in, void* d_out, int out_size, void* d_ws, size_t ws_size, hipStream_t stream) {
    static int grid = 0;
    if (grid == 0) {
        int dev = 0, cus = 0, per_cu = 0;
        if (n_in != 28 || out_size != NTOK * D || ws_size < WS_END) { grid = -1; return; }
        if (hipGetDevice(&dev) != hipSuccess || hipDeviceGetAttribute(&cus, hipDeviceAttributeMultiprocessorCount, dev) != hipSuccess) { grid = -1; return; }
        if (hipFuncSetAttribute((const void*)mega_fwd, hipFuncAttributeMaxDynamicSharedMemorySize, LDS_BYTES) != hipSuccess) { grid = -1; return; }
        if (hipOccupancyMaxActiveBlocksPerMultiprocessor(&per_cu, (const void*)mega_fwd, NWAVES * 64, LDS_BYTES) != hipSuccess || per_cu < 1) { (void)hipGetLastError(); grid = -1; return; }
        (void)hipGetLastError();
        grid = cus;
    }
    if (grid < 0) return;
    (void)hipMemsetAsync((char*)d_ws + WS_CTL, 0, CTL_ZERO_BYTES, stream);
    Args a{};
    const float** ip = (const float**)&a.in;
    for (int i = 0; i < 28; ++i) ip[i] = (const float*)d_in[i];
    a.out = (float*)d_out; a.ws = (unsigned char*)d_ws;
#ifdef DBG_STOP
    for (int p = 0; p <= (DBG_STOP); ++p) { a.ph_lo = p; a.ph_hi = p + 1; hipLaunchKernelGGL(mega_fwd, dim3(grid), dim3(NWAVES * 64), LDS_BYTES, stream, a); }
    hipLaunchKernelGGL(dbg_copy, dim3(2048), dim3(256), 0, stream, (const unsigned char*)d_ws, (float*)d_out, (size_t)out_size);
#elif defined(REP_SET)
#ifndef REP_FLAGS
#define REP_FLAGS 0
#endif
    for (int p = 0; p < N_PHASES; ++p) {
        const int n = (((unsigned long long)(REP_SET) >> p) & 1ull) ? 1 + (REP_N) : 1;
        for (int k = 0; k < n; ++k) {
            if (k > 0 && p == 0) (void)hipMemsetAsync((char*)d_ws + (CW_WORK) * 4, 0, 256, stream);
            if (k > 0 && (p == 9 || p == 21)) (void)hipMemsetAsync((char*)d_ws + (CW_CNT + 64 * (p == 21)) * 4, 0, 128, stream);
#ifdef REP_FLUSH
            if (n > 1 || (REP_FLUSH) == 2) for (int f_ = 24; f_ <= 26; ++f_) hipLaunchKernelGGL(dbg_flush, dim3(2048), dim3(256), 0, stream, (const float*)d_in[f_], (size_t)32 * 1024 * 1024, (float*)d_ws + 1000);
#endif
            a.ph_lo = p | (k > 0 ? ((REP_FLAGS) << 8) : 0); a.ph_hi = p + 1; hipLaunchKernelGGL(mega_fwd, dim3(grid), dim3(NWAVES * 64), LDS_BYTES, stream, a);
        }
    }
#elif MK_PER_PHASE
    for (int p = 0; p < N_PHASES; ++p) { a.ph_lo = p; a.ph_hi = p + 1; hipLaunchKernelGGL(mega_fwd, dim3(grid), dim3(NWAVES * 64), LDS_BYTES, stream, a); }
#else
    a.ph_lo = 0; a.ph_hi = N_PHASES;
    hipLaunchKernelGGL(mega_fwd, dim3(grid), dim3(NWAVES * 64), LDS_BYTES, stream, a);
#if defined(TSTAMP) && !defined(TS_SPIN_SET)
    hipLaunchKernelGGL(dbg_times, dim3(1024), dim3(256), 0, stream, (const unsigned char*)d_ws, (float*)d_out, (size_t)out_size, (unsigned)(TS_SET1), (unsigned)(TS_SET2));
#endif
#endif
}
```

```cpp
#include <hip/hip_runtime.h>
#include <cstdint>
#include <cmath>
#ifndef MK_PER_PHASE
#define MK_PER_PHASE 0
#endif
__device__ __forceinline__ int lane_now() { int l; asm volatile("v_mbcnt_lo_u32_b32 %0, -1, 0\n\tv_mbcnt_hi_u32_b32 %0, -1, %0" : "=v"(l)); return l; }
__device__ __forceinline__ float xor32_f(float x, int lane) { return __int_as_float(__builtin_amdgcn_ds_bpermute((lane ^ 32) << 2, __float_as_int(x))); }
namespace pg8 {
#define PG8_LAS __attribute__((address_space(3)))
typedef unsigned short bf16_t;
typedef short bf16x8 __attribute__((ext_vector_type(8)));
typedef float f32x4 __attribute__((ext_vector_type(4)));
typedef float f32x2 __attribute__((ext_vector_type(2)));
typedef unsigned u32x4 __attribute__((ext_vector_type(4)));
typedef unsigned u32x2 __attribute__((ext_vector_type(2)));
constexpr int BM = 256, BK = 64, HALF = 128, HTB = HALF * BK * 2, STAGE_BYTES = 8 * HTB, NXCD = 8, WGM = 8;

__host__ __device__ __forceinline__ int lds_byte(int r, int c) { const int st = (r >> 4) * 2 + (c >> 5), rr = r & 15, cc = c & 31, ob = rr * 64 + cc * 2; return st * 1024 + (ob ^ (((ob >> 9) & 1) << 5)); }
__host__ __device__ __forceinline__ void stage_rc(int b, int& R, int& C) { const int st = b / 1024, sb = b % 1024, swz = sb ^ (((sb >> 9) & 1) << 5); R = (st >> 1) * 16 + swz / 64; C = (st & 1) * 32 + (swz % 64) / 2; }
__host__ __device__ __forceinline__ int perm32(int rho) { const int n = rho >> 4, i = rho & 15; return 8 * (i >> 2) + 4 * n + (i & 3); }

struct Unit { const char* A; const char* B; int pm, pn, aux, k2; };
typedef __bf16 bf16x2_t __attribute__((ext_vector_type(2)));
__device__ __forceinline__ unsigned cvt_pk_bf16(float lo, float hi) { f32x2 v = {lo, hi}; bf16x2_t b = __builtin_convertvector(v, bf16x2_t); return __builtin_bit_cast(unsigned, b); }
__device__ __forceinline__ float bf_lo(unsigned w) { return __uint_as_float(w << 16); }
__device__ __forceinline__ float bf_hi(unsigned w) { return __uint_as_float(w & 0xffff0000u); }

__device__ __forceinline__ void tile_of(int L, int nM, int nN, int& pm, int& pn) {
    const int nwg = nM * nN; int wgid = L;
    { const int q = nwg / NXCD, r = nwg % NXCD, xcd = wgid % NXCD, off = wgid / NXCD; wgid = (xcd < r ? xcd * (q + 1) : r * (q + 1) + (xcd - r) * q) + off; }
    const int nig = WGM * nN, gid = wgid / nig, fm = gid * WGM, gsz = (nM - fm) < WGM ? (nM - fm) : WGM;
    pm = fm + ((wgid % nig) % gsz); pn = (wgid % nig) / gsz;
}

template <class Epi, class Sched, bool ALIGN_EPI, bool SP2>
__device__ __forceinline__ void gemm_phase(PG8_LAS unsigned char* lds, const int K, const int lda, const int ldb, const Sched& S, const Epi& E, const int K1 = 0, const int lda1 = 0, const int ldb1 = 0) {
    constexpr bool VARK = Sched::VARK;
    constexpr bool GATHER = Sched::GATHER;
    static_assert(!VARK || SP2, "variable-shape units use the SP2 loop");
    int tid_ = S.wave_index() * 64 + lane_now(); asm volatile("" : "+v"(tid_));
    const int tid = tid_, wid = __builtin_amdgcn_readfirstlane(tid >> 6), lane = tid & 63, wr = wid >> 2, wc = wid & 3, fr = lane & 15, fq = lane >> 4;
    struct VoffTab { int tid; int lda, ldb, lda1, ldb1;
        __device__ __forceinline__ unsigned get(int i, int ld, bool b) const { int t_ = tid; asm volatile("" : "+v"(t_)); int R, C; stage_rc(t_ * 16 + i * 8192, R, C); const int Rb = (b && Epi::PERM) ? ((R & ~31) + perm32(R & 31)) : R; return (unsigned)(Rb * ld + C) * 2u; } };
    const VoffTab VT{tid, lda, ldb, lda1, ldb1};
    struct VoffArr { const VoffTab& T; int ld; bool b; __device__ __forceinline__ unsigned operator[](int i) const { return T.get(i, ld, b); } };
    const VoffArr voffA0{VT, lda, false}, voffB0{VT, ldb, true}, voffA1{VT, lda1, false}, voffB1{VT, ldb1, true};
    const size_t kstep = (size_t)(BK * 2);
    const size_t hstepA0 = (size_t)HALF * lda * 2, hstepB0 = (size_t)HALF * ldb * 2, hstepA1 = (size_t)HALF * lda1 * 2, hstepB1 = (size_t)HALF * ldb1 * 2;
    const unsigned ldsw = (unsigned)wid * 1024u;
    const int aoff = lds_byte(wr * 64 + fr, fq * 8), boff = lds_byte(wc * 32 + fr, fq * 8);
#define PG8_SA(b, h) (((b) * 2 + (h)) * HTB)
#define PG8_SB(b, h) ((4 + (b) * 2 + (h)) * HTB)
#define PG8_STAGE(bufoff, gbase, voff) do { _Pragma("unroll") for (int _i = 0; _i < 2; ++_i) \
        __builtin_amdgcn_global_load_lds((const unsigned*)((const char*)(gbase) + (voff)[_i]), (PG8_LAS unsigned*)(lds + (bufoff) + ldsw + _i * 8192), 16, 0, 0); } while (0)
#define PG8_LDA(dst, b, h) do { _Pragma("unroll") for (int m = 0; m < 4; ++m) _Pragma("unroll") for (int k = 0; k < 2; ++k) dst[m][k] = *(const PG8_LAS bf16x8*)(lds + PG8_SA(b, h) + aoff + m * 2048 + k * 1024); } while (0)
#define PG8_LDB(dst, b, h) do { _Pragma("unroll") for (int n = 0; n < 2; ++n) _Pragma("unroll") for (int k = 0; k < 2; ++k) dst[n][k] = *(const PG8_LAS bf16x8*)(lds + PG8_SB(b, h) + boff + n * 2048 + k * 1024); } while (0)
#define PG8_MMA(ai, bj, At, Bt) do { __builtin_amdgcn_s_setprio(1); _Pragma("unroll") for (int m = 0; m < 4; ++m) _Pragma("unroll") for (int n = 0; n < 2; ++n) _Pragma("unroll") for (int k = 0; k < 2; ++k) \
        acc[ai][bj][m][n] = __builtin_amdgcn_mfma_f32_16x16x32_bf16(Bt[n][k], At[m][k], acc[ai][bj][m][n], 0, 0, 0); __builtin_amdgcn_s_setprio(0); } while (0)
#define PG8_WAIT_V(n) asm volatile("s_waitcnt vmcnt(" #n ")" ::: "memory")
#define PG8_WAIT_L(n) asm volatile("s_waitcnt lgkmcnt(" #n ")" ::: "memory")
#define PG8_BAR __builtin_amdgcn_s_barrier()
#define PG8_SCHED __builtin_amdgcn_sched_barrier(0)
    Unit cur, nxt; int ui = 0;
    if (!S.next(0, cur)) return;
#define gpark ((PG8_LAS u32x4*)(lds + STAGE_BYTES) + ({ int t_ = tid; asm volatile("" : "+v"(t_)); t_; }))
#define PG8_GOFF(G_, u_) do { _Pragma("unroll") for (int h_ = 0; h_ < 2; ++h_) _Pragma("unroll") for (int i_ = 0; i_ < 2; ++i_) { int R_, C_; stage_rc(tid * 16 + i_ * 8192, R_, C_); \
        G_[h_ * 2 + i_] = (unsigned)(S.goff(u_, h_ * HALF + R_) * lda + C_) * 2u; } } while (0)
    f32x4 acc[2][2][4][2];
#pragma unroll
    for (int a = 0; a < 2; ++a)
#pragma unroll
        for (int b = 0; b < 2; ++b)
#pragma unroll
            for (int m = 0; m < 4; ++m)
#pragma unroll
                for (int n = 0; n < 2; ++n) acc[a][b][m][n] = (f32x4){0.f, 0.f, 0.f, 0.f};
    bf16x8 At[4][2], B0[2][2], B1[2][2];
    const char* cA = cur.A; const char* cB = cur.B;
    S.a_ready(cur);
#define PG8_SEL(k2_, a0, a1) ((VARK && (k2_)) ? (a1) : (a0))
    unsigned voffA[2] = {PG8_SEL(cur.k2, voffA0[0], voffA1[0]), PG8_SEL(cur.k2, voffA0[1], voffA1[1])}, voffB[2] = {PG8_SEL(cur.k2, voffB0[0], voffB1[0]), PG8_SEL(cur.k2, voffB0[1], voffB1[1])};
    size_t hstepA = PG8_SEL(cur.k2, hstepA0, hstepA1), hstepB = PG8_SEL(cur.k2, hstepB0, hstepB1);
    unsigned voffA2[2] = {voffA[0], voffA[1]};
    if (GATHER && cur.k2 == 0) { u32x4 g_; PG8_GOFF(g_, cur); voffA[0] = g_[0]; voffA[1] = g_[1]; voffA2[0] = g_[2]; voffA2[1] = g_[3]; hstepA = 0; }
    int nt = PG8_SEL(cur.k2, K, K1) / BK;
    if constexpr (SP2) {
        PG8_STAGE(PG8_SB(0, 0), cB, voffB); PG8_STAGE(PG8_SB(0, 1), cB + hstepB, voffB); PG8_STAGE(PG8_SA(0, 0), cA, voffA); PG8_STAGE(PG8_SA(0, 1), cA + hstepA, voffA2);
        if (wr == 1) PG8_BAR;
        PG8_WAIT_V(2); PG8_BAR;
        PG8_STAGE(PG8_SB(1, 0), cB + kstep, voffB); PG8_STAGE(PG8_SA(1, 0), cA + kstep, voffA); PG8_STAGE(PG8_SB(1, 1), cB + hstepB + kstep, voffB);
        PG8_WAIT_V(6); PG8_BAR;
    } else {
        PG8_STAGE(PG8_SB(0, 0), cB, voffB); PG8_STAGE(PG8_SA(0, 0), cA, voffA); PG8_STAGE(PG8_SB(0, 1), cB + hstepB, voffB); PG8_STAGE(PG8_SA(0, 1), cA + hstepA, voffA);
        if (wr == 1) PG8_BAR;
        PG8_WAIT_V(4); PG8_BAR;
        PG8_STAGE(PG8_SB(1, 0), cB + kstep, voffB); PG8_STAGE(PG8_SA(1, 0), cA + kstep, voffA); PG8_STAGE(PG8_SB(1, 1), cB + hstepB + kstep, voffB);
        PG8_WAIT_V(6); PG8_BAR;
    }
    for (;;) {
        const bool has_next = S.next(ui + 1, nxt);
        const char* nA = has_next ? nxt.A : cA; const char* nB = has_next ? nxt.B : cB;
        const int k2n = has_next ? nxt.k2 : cur.k2;
        if (GATHER && has_next && nxt.k2 == 0) { u32x4 g_; PG8_GOFF(g_, nxt); *gpark = g_; }
        for (int t = 0; t < nt; t += 2) {
            const bool last = (t == nt - 2);
            if (last && has_next) S.a_ready(nxt);
            unsigned voffAx[2], voffAx2[2], voffBx[2]; size_t hstepAx, hstepBx;
            if (VARK && last) { voffAx[0] = PG8_SEL(k2n, voffA0[0], voffA1[0]); voffAx[1] = PG8_SEL(k2n, voffA0[1], voffA1[1]); voffBx[0] = PG8_SEL(k2n, voffB0[0], voffB1[0]); voffBx[1] = PG8_SEL(k2n, voffB0[1], voffB1[1]);
                hstepAx = PG8_SEL(k2n, hstepA0, hstepA1); hstepBx = PG8_SEL(k2n, hstepB0, hstepB1); voffAx2[0] = voffAx[0]; voffAx2[1] = voffAx[1];
                if (GATHER && has_next && k2n == 0) { const u32x4 g_ = *gpark; voffAx[0] = g_[0]; voffAx[1] = g_[1]; voffAx2[0] = g_[2]; voffAx2[1] = g_[3]; hstepAx = 0; } }
            else { voffAx[0] = voffA[0]; voffAx[1] = voffA[1]; voffAx2[0] = voffA2[0]; voffAx2[1] = voffA2[1]; voffBx[0] = voffB[0]; voffBx[1] = voffB[1]; hstepAx = hstepA; hstepBx = hstepB; }
            const char* a1 = cA + (size_t)(t + 1) * kstep;
            const char* a2 = last ? nA : cA + (size_t)(t + 2) * kstep; const char* b2 = last ? nB : cB + (size_t)(t + 2) * kstep;
            const char* a3 = a2 + kstep; const char* b3 = b2 + kstep;
            if constexpr (SP2) {
            PG8_LDB(B0, 0, 0); PG8_LDB(B1, 0, 1); PG8_SCHED; PG8_LDA(At, 0, 0); PG8_STAGE(PG8_SA(1, 1), a1 + hstepA, voffA2);
            PG8_WAIT_V(8); PG8_WAIT_L(0); PG8_BAR; PG8_MMA(0, 0, At, B0); PG8_MMA(0, 1, At, B1); PG8_BAR; PG8_SCHED;
            PG8_LDA(At, 0, 1); PG8_STAGE(PG8_SB(0, 0), b2, voffBx); PG8_STAGE(PG8_SB(0, 1), b2 + hstepBx, voffBx); PG8_STAGE(PG8_SA(0, 0), a2, voffAx);
            PG8_WAIT_V(8); PG8_WAIT_L(0); PG8_BAR; PG8_MMA(1, 0, At, B0); PG8_MMA(1, 1, At, B1); PG8_BAR; PG8_SCHED;
            PG8_LDB(B0, 1, 0); PG8_LDB(B1, 1, 1); PG8_SCHED; PG8_LDA(At, 1, 0); PG8_STAGE(PG8_SA(0, 1), a2 + hstepAx, voffAx2);
            PG8_WAIT_V(8); PG8_WAIT_L(0); PG8_BAR; PG8_MMA(0, 0, At, B0); PG8_MMA(0, 1, At, B1); PG8_BAR; PG8_SCHED;
            PG8_LDA(At, 1, 1); PG8_STAGE(PG8_SB(1, 0), b3, voffBx); PG8_STAGE(PG8_SB(1, 1), b3 + hstepBx, voffBx); PG8_STAGE(PG8_SA(1, 0), a3, voffAx);
            PG8_WAIT_V(8); PG8_WAIT_L(0); PG8_BAR; PG8_MMA(1, 0, At, B0); PG8_MMA(1, 1, At, B1); PG8_BAR; PG8_SCHED;
            } else {
            PG8_LDB(B0, 0, 0); PG8_SCHED; PG8_LDA(At, 0, 0); PG8_STAGE(PG8_SA(1, 1), a1 + hstepA, voffA);
            PG8_WAIT_L(8); PG8_BAR; PG8_WAIT_L(0); PG8_MMA(0, 0, At, B0); PG8_BAR; PG8_SCHED;
            PG8_LDB(B1, 0, 1); PG8_STAGE(PG8_SB(0, 0), b2, voffB);
            PG8_BAR; PG8_WAIT_L(0); PG8_MMA(0, 1, At, B1); PG8_BAR;
            PG8_LDA(At, 0, 1); PG8_STAGE(PG8_SA(0, 0), a2, voffA);
            PG8_BAR; PG8_WAIT_L(0); PG8_MMA(1, 0, At, B0); PG8_BAR; PG8_SCHED;
            PG8_STAGE(PG8_SB(0, 1), b2 + hstepB, voffB);
            PG8_WAIT_V(6); PG8_BAR; PG8_MMA(1, 1, At, B1); PG8_BAR;
            PG8_LDB(B0, 1, 0); PG8_SCHED; PG8_LDA(At, 1, 0); PG8_STAGE(PG8_SA(0, 1), a2 + hstepA, voffA);
            PG8_WAIT_L(8); PG8_BAR; PG8_WAIT_L(0); PG8_MMA(0, 0, At, B0); PG8_BAR; PG8_SCHED;
            PG8_LDB(B1, 1, 1); PG8_STAGE(PG8_SB(1, 0), b3, voffB);
            PG8_BAR; PG8_WAIT_L(0); PG8_MMA(0, 1, At, B1); PG8_BAR;
            PG8_LDA(At, 1, 1); PG8_STAGE(PG8_SA(1, 0), a3, voffA);
            PG8_BAR; PG8_WAIT_L(0); PG8_MMA(1, 0, At, B0); PG8_BAR; PG8_SCHED;
            PG8_STAGE(PG8_SB(1, 1), b3 + hstepB, voffB);
            PG8_WAIT_V(6); PG8_BAR; PG8_MMA(1, 1, At, B1); PG8_BAR;
            }
        }
        if constexpr (ALIGN_EPI) { if (wr == 0) PG8_BAR; }
        { int fr_ = fr, fq_ = fq, wr_ = wr, wc_ = wc; asm volatile("" : "+v"(fr_), "+v"(fq_), "+s"(wr_), "+s"(wc_));
          E(acc, cur, wr_, wc_, fr_, fq_); }
        S.done(cur);
        if (!has_next) break;
#pragma unroll
        for (int a = 0; a < 2; ++a)
#pragma unroll
            for (int b = 0; b < 2; ++b)
#pragma unroll
                for (int m = 0; m < 4; ++m)
#pragma unroll
                    for (int n = 0; n < 2; ++n) acc[a][b][m][n] = (f32x4){0.f, 0.f, 0.f, 0.f};
        cur = nxt; cA = nA; cB = nB; ++ui;
        if constexpr (VARK) { voffA[0] = PG8_SEL(cur.k2, voffA0[0], voffA1[0]); voffA[1] = PG8_SEL(cur.k2, voffA0[1], voffA1[1]); voffB[0] = PG8_SEL(cur.k2, voffB0[0], voffB1[0]); voffB[1] = PG8_SEL(cur.k2, voffB0[1], voffB1[1]);
            hstepA = PG8_SEL(cur.k2, hstepA0, hstepA1); hstepB = PG8_SEL(cur.k2, hstepB0, hstepB1); nt = PG8_SEL(cur.k2, K, K1) / BK; voffA2[0] = voffA[0]; voffA2[1] = voffA[1];
            if (GATHER && cur.k2 == 0) { const u32x4 g_ = *gpark; voffA[0] = g_[0]; voffA[1] = g_[1]; voffA2[0] = g_[2]; voffA2[1] = g_[3]; hstepA = 0; } }
        if constexpr (ALIGN_EPI) { if (wr == 1) PG8_BAR; }
    }
    PG8_WAIT_V(0);
    if constexpr (!ALIGN_EPI) { if (wr == 0) PG8_BAR; }
    PG8_BAR;
#undef PG8_SEL
#undef PG8_GOFF
#undef gpark
#undef PG8_SA
#undef PG8_SB
#undef PG8_STAGE
#undef PG8_LDA
#undef PG8_LDB
#undef PG8_MMA
#undef PG8_WAIT_V
#undef PG8_WAIT_L
#undef PG8_BAR
#undef PG8_SCHED
}
}
constexpr int D = 1024, NB = 2, S = 8192, CTX = 256, NTOK = NB * S, NCTX = NB * CTX, NALL = NTOK + NCTX;
constexpr int DIN = 3328;
constexpr int NH = 8, NKV = 2, HD = 64, DSSM = 512, NG = 32, GS = 16, NST = 64, TC = 32;
constexpr int NE = 32, DE = 512;
constexpr int NCH = 768;
constexpr int NCHV = 528;
constexpr float C2 = 0.125f * 1.4426950408889634f;
constexpr float LOG2E = 1.4426950408889634f;
constexpr int NWAVES = 8;
constexpr int MAXROWS = 41984;

constexpr size_t MiB = 1u << 20;
constexpr size_t WS_CTL = 0, CTL_ZERO_BYTES = 1 * MiB;
constexpr size_t WS_SMALL = 1 * MiB;
constexpr size_t SM_MOD = WS_SMALL + 0;
constexpr size_t SM_ROPE = WS_SMALL + 0x30000;
constexpr size_t SM_WRT = WS_SMALL + 0x40000;
constexpr size_t SM_SSMTAB = WS_SMALL + 0x90000;
constexpr size_t SM_RE = WS_SMALL + 0xC0000;
constexpr size_t SM_RW = SM_RE + (size_t)NALL * 8;
constexpr size_t SM_RSLOT = SM_RW + (size_t)NALL * 8;
constexpr size_t SM_RDEST = SM_RSLOT + (size_t)NALL * 8;
constexpr size_t SM_RWS = SM_RDEST + (size_t)NALL * 8;
static_assert(SM_RWS + (size_t)MAXROWS * 4 <= 8 * MiB, "small region");
constexpr size_t WS_W = 8 * MiB;
constexpr size_t W_IN = WS_W, W_GLU = W_IN + (size_t)DIN * D * 2, W_BRA = W_GLU + 512 * 512 * 2, W_BRS = W_BRA + 1024 * 512 * 2, W_OUT = W_BRS + 1024 * 512 * 2;
constexpr size_t W_S3 = W_OUT + 1024 * 1024 * 2, W_SE = W_S3 + (size_t)NG * 512 * 768 * 2, W_GU = W_SE + (size_t)NG * 256 * 512 * 2, W_DN = W_GU + (size_t)NE * 1024 * 1024 * 2;
constexpr size_t WS_XC = W_DN + (size_t)NE * 1024 * 512 * 2;
static_assert(WS_XC == 147 * MiB, "weights region");
constexpr size_t WS_H = WS_XC + (size_t)NALL * D * 4;
constexpr size_t WS_BIG = WS_H + (size_t)NALL * D * 2;
constexpr size_t B_Q = WS_BIG, B_K = B_Q + (size_t)NALL * 512 * 2, B_VT = B_K + (size_t)NALL * 128 * 2, B_A3 = B_VT + (size_t)NALL * 128 * 2;
constexpr size_t B_GA = B_A3 + (size_t)NG * NCH * 768 * 2, B_GS = B_GA + (size_t)NALL * D * 2, B_ATT = B_GS + (size_t)NALL * D * 2, B_SEND = B_ATT + (size_t)NALL * 512 * 2;
constexpr size_t B_Z = B_SEND + (size_t)NG * NCH * 256 * 4, B_SG = B_Z + (size_t)NALL * 512 * 2, B_T1 = B_SG + (size_t)NALL * 512 * 2, B_MB = B_T1 + (size_t)NALL * D * 2;
constexpr size_t B_END1 = B_MB + (size_t)NALL * D * 2;
constexpr size_t B_HS = WS_BIG, B_ACT = B_HS + (size_t)MAXROWS * D * 2, B_YE = B_ACT + (size_t)MAXROWS * DE * 2, B_END2 = B_YE + (size_t)MAXROWS * D * 2;
constexpr size_t WS_END = 544 * MiB;
static_assert(B_END1 <= WS_END && B_END2 <= WS_END, "d_ws map");
constexpr int CW_TMO = 0, CW_CODE = 1;
constexpr int CW_BAR = 4096;
constexpr int CW_CNT = 8192;
constexpr int CW_WORK = 8448;

constexpr int LDS_BYTES = 147456;
constexpr int CAPL = 17152;
constexpr size_t B_LIST = B_HS, B_LISTW = B_LIST + (size_t)NE * CAPL * 4;
constexpr int LDSCTL_OFF = 143360;
constexpr int L_BARST = LDSCTL_OFF + 32;
constexpr int L_MOETAB = LDSCTL_OFF + 256;
constexpr int L_WGCNT = LDSCTL_OFF + 1024;
constexpr int L_MISC = LDSCTL_OFF + 2048;

#define GAS __attribute__((address_space(1)))
#define LAS __attribute__((address_space(3)))
typedef unsigned short bf16;
typedef unsigned v4u __attribute__((ext_vector_type(4)));
typedef unsigned v2u __attribute__((ext_vector_type(2)));
typedef float f32x4 __attribute__((ext_vector_type(4)));
typedef float f32x16 __attribute__((ext_vector_type(16)));
typedef short bf16x8 __attribute__((ext_vector_type(8)));
typedef short bf16x4 __attribute__((ext_vector_type(4)));
typedef GAS unsigned gu32;
#define RLX_AGENT __ATOMIC_RELAXED, __HIP_MEMORY_SCOPE_AGENT
#define LDS_WAIT() asm volatile("s_waitcnt lgkmcnt(0)" ::: "memory")
#define VM_WAIT() asm volatile("s_waitcnt vmcnt(0)" ::: "memory")
using pg8::cvt_pk_bf16; using pg8::bf_lo; using pg8::bf_hi;
__device__ __forceinline__ float sigmoid_f(float x) { return __builtin_amdgcn_rcpf(1.f + __expf(-x)); }
__device__ __forceinline__ float gelu_tanh_f(float x) {
    const float u = 0.7978845608028654f * (x + 0.044715f * x * x * x);
    return x * sigmoid_f(2.f * u);
}

#define XB_TMO      128
#define XB_XCNT(j)  (256  + 64 * (j))
#define XB_XSUB(j)  (1280 + 64 * (j))
#define XB_XGEN(j)  (2304 + 64 * (j))
#define XB_TOP      3328
#define XB_TOPGEN   3392
#define XCD_BAR_WORDS 3456
#define XB_SPIN_CAP (1u << 18)
__device__ __forceinline__ unsigned xb_ld(unsigned* p)              { return __hip_atomic_load(p, __ATOMIC_RELAXED, __HIP_MEMORY_SCOPE_AGENT); }
__device__ __forceinline__ unsigned xb_add(unsigned* p, unsigned v) { return __hip_atomic_fetch_add(p, v, __ATOMIC_RELAXED, __HIP_MEMORY_SCOPE_AGENT); }
__device__ __forceinline__ unsigned xb_xcc_id() { return (unsigned)__builtin_amdgcn_s_getreg((3 << 11) | 20) & 0xFu; }
#define XB_SPIN(cond, bar) do { unsigned _sp = 0; while (cond) { __builtin_amdgcn_s_sleep(1); \
    if ((++_sp & 255u) == 0u) { if (xb_ld(&(bar)[XB_TMO])) break; if (_sp > XB_SPIN_CAP) { atomicAdd(&(bar)[XB_TMO], 1u); break; } } } } while (0)
struct XcdBarrier { unsigned* bar; unsigned x; volatile LAS unsigned* st; };
__device__ __forceinline__ XcdBarrier xcd_barrier_post(unsigned* bar, volatile LAS unsigned* st) {
    XcdBarrier b; b.bar = bar; b.x = xb_xcc_id(); b.st = st;
    if (threadIdx.x == 0) (void)xb_add(&bar[XB_XCNT(b.x)], 1u);
    return b;
}
__device__ __forceinline__ void xcd_barrier_complete(unsigned* bar, unsigned x, unsigned& nloc, unsigned& nx) {
    const unsigned G = gridDim.x * gridDim.y * gridDim.z;
    unsigned sum, cnt, mine, sp = 0u;
    for (;;) {
        sum = 0u; cnt = 0u; mine = 0u;
#pragma unroll 1
        for (unsigned j = 0; j < 16; ++j) { const unsigned c = xb_ld(&bar[XB_XCNT(j)]); sum += c; cnt += (c > 0u) ? 1u : 0u; mine = (j == x) ? c : mine; }
        if (sum == G) break;
        __builtin_amdgcn_s_sleep(1);
        if ((++sp & 255u) == 0u) { if (xb_ld(&bar[XB_TMO])) break; if (sp > XB_SPIN_CAP) { atomicAdd(&bar[XB_TMO], 1u); break; } }
    }
    nloc = mine > 0u ? mine : 1u; nx = cnt > 0u ? cnt : 1u;
}
__device__ __forceinline__ void xcd_barrier(const XcdBarrier& b, const bool t0) {
    asm volatile("s_waitcnt vmcnt(0)" ::: "memory");
    __syncthreads();
    if (t0) {
        unsigned* bar = b.bar;
        __builtin_amdgcn_s_waitcnt(0);
        unsigned nloc = b.st[0], nx = b.st[1];
        if (nloc == 0u) { xcd_barrier_complete(bar, b.x, nloc, nx); b.st[0] = nloc; b.st[1] = nx; }
        const unsigned old = xb_add(&bar[XB_XSUB(b.x)], 1u);
        const unsigned gen = old / nloc;
        if (old + 1u == (gen + 1u) * nloc) {
            __builtin_amdgcn_fence(__ATOMIC_RELEASE, "agent");
            asm volatile("s_waitcnt vmcnt(0)" ::: "memory");
            const unsigned og = xb_add(&bar[XB_TOP], 1u);
            const unsigned tg = og / nx;
            if (og + 1u == (tg + 1u) * nx) xb_add(&bar[XB_TOPGEN], 1u);
            else XB_SPIN(xb_ld(&bar[XB_TOPGEN]) == tg, bar);
            __builtin_amdgcn_fence(__ATOMIC_ACQUIRE, "agent");
            xb_add(&bar[XB_XGEN(b.x)], 1u);
            asm volatile("s_waitcnt vmcnt(0)" ::: "memory");
        } else {
            XB_SPIN(xb_ld(&bar[XB_XGEN(b.x)]) == gen, bar);
            __builtin_amdgcn_fence(__ATOMIC_ACQUIRE, "agent");
            asm volatile("s_waitcnt vmcnt(0)" ::: "memory");
        }
    }
    __syncthreads();
}

struct Inputs {
    const float *x, *c, *ctx, *c_ctx, *w_mod, *b_mod, *g1, *g2, *w_in, *sink, *lam_re, *lam_im, *log_dt, *sb_re, *sb_im, *sc_re, *sc_im, *ssm_d,
        *w_glu, *w_bra, *w_brs, *w_out, *w_rg, *w_re, *w_eg, *w_eu, *w_ed, *g_final;
};
struct Frame {
    LAS unsigned char* lds;
    gu32* ctl;
    unsigned char* ws;
    int tid, lane, wave;
    int vcu, G;
    float* out;
};
__device__ __forceinline__ float row16_sum(float v) {
    v += __uint_as_float((unsigned)__builtin_amdgcn_update_dpp(0, (int)__float_as_uint(v), 0x128, 0xf, 0xf, false));
    v += __uint_as_float((unsigned)__builtin_amdgcn_update_dpp(0, (int)__float_as_uint(v), 0x124, 0xf, 0xf, false));
    v += __uint_as_float((unsigned)__builtin_amdgcn_update_dpp(0, (int)__float_as_uint(v), 0x122, 0xf, 0xf, false));
    v += __uint_as_float((unsigned)__builtin_amdgcn_update_dpp(0, (int)__float_as_uint(v), 0x121, 0xf, 0xf, false));
    return v; }
__device__ __forceinline__ float swap32_sum(float lo_keep, float hi_keep) {
    auto r = __builtin_amdgcn_permlane32_swap(__float_as_uint(lo_keep), __float_as_uint(hi_keep), false, false); return __uint_as_float(r[0]) + __uint_as_float(r[1]); }
__device__ __forceinline__ float swap16_sum(float even_keep, float odd_keep) {
    auto r = __builtin_amdgcn_permlane16_swap(__float_as_uint(even_keep), __float_as_uint(odd_keep), false, false); return __uint_as_float(r[0]) + __uint_as_float(r[1]); }
__device__ __forceinline__ float wave_sum(float v) { v = row16_sum(v); v = swap16_sum(v, v); return swap32_sum(v, v); }
__device__ __forceinline__ int which_of_row(int r) { return r < NTOK ? (r >> 13) : 2; }
__device__ __forceinline__ unsigned f2bf_rne(float f) { unsigned u = __builtin_bit_cast(unsigned, f); return (u + 0x7fffu + ((u >> 16) & 1u)) >> 16; }
__device__ __forceinline__ unsigned pk2(float lo, float hi) { return f2bf_rne(lo) | (f2bf_rne(hi) << 16); }
typedef float f32x2g __attribute__((ext_vector_type(2)));
#ifndef CHAIN
#define CHAIN 1
#endif
#define CHAIN_WMODE (CHAIN ? 3 : 0)
__device__ __forceinline__ void transpose_item(const float* W, int K, int N, bf16* WT, int mode, int item, int lane) {
    const int nblk = N / 128, kb = item / nblk, nb = item % nblk, k0 = 64 * kb, n = 128 * nb + 2 * lane;
    const int row = (mode == 0 || mode == 3) ? n : (8 * (n >> 2) + (n & 3) + (mode == 2 ? 4 : 0));
    const float* wp = W + (size_t)k0 * N + n;
    f32x2g v[64];
#pragma unroll
    for (int j = 0; j < 64; ++j) v[j] = __builtin_nontemporal_load((const f32x2g*)(wp + (size_t)j * N));
    if (mode == 3) {
        GAS v4u* ob = (GAS v4u*)WT + ((size_t)(row >> 4) * (K >> 5) + (k0 >> 5)) * 64 + (row & 15);
#pragma unroll
        for (int q = 0; q < 8; ++q) { v4u o; o.x = cvt_pk_bf16(v[8 * q].x, v[8 * q + 1].x); o.y = cvt_pk_bf16(v[8 * q + 2].x, v[8 * q + 3].x); o.z = cvt_pk_bf16(v[8 * q + 4].x, v[8 * q + 5].x); o.w = cvt_pk_bf16(v[8 * q + 6].x, v[8 * q + 7].x); ob[(q >> 2) * 64 + 16 * (q & 3)] = o; }
#pragma unroll
        for (int q = 0; q < 8; ++q) { v4u o; o.x = cvt_pk_bf16(v[8 * q].y, v[8 * q + 1].y); o.y = cvt_pk_bf16(v[8 * q + 2].y, v[8 * q + 3].y); o.z = cvt_pk_bf16(v[8 * q + 4].y, v[8 * q + 5].y); o.w = cvt_pk_bf16(v[8 * q + 6].y, v[8 * q + 7].y); ob[(q >> 2) * 64 + 16 * (q & 3) + 1] = o; }
        return;
    }
    GAS v4u* op0 = (GAS v4u*)(WT + (size_t)row * K + k0); GAS v4u* op1 = (GAS v4u*)(WT + (size_t)(row + 1) * K + k0);
#pragma unroll
    for (int q = 0; q < 8; ++q) { v4u o; o.x = cvt_pk_bf16(v[8 * q].x, v[8 * q + 1].x); o.y = cvt_pk_bf16(v[8 * q + 2].x, v[8 * q + 3].x); o.z = cvt_pk_bf16(v[8 * q + 4].x, v[8 * q + 5].x); o.w = cvt_pk_bf16(v[8 * q + 6].x, v[8 * q + 7].x); op0[q] = o; }
#pragma unroll
    for (int q = 0; q < 8; ++q) { v4u o; o.x = cvt_pk_bf16(v[8 * q].y, v[8 * q + 1].y); o.y = cvt_pk_bf16(v[8 * q + 2].y, v[8 * q + 3].y); o.z = cvt_pk_bf16(v[8 * q + 4].y, v[8 * q + 5].y); o.w = cvt_pk_bf16(v[8 * q + 6].y, v[8 * q + 7].y); op1[q] = o; }
}
constexpr int CV_IN = (D / 64) * (DIN / 128), CV_GLU = 8 * 4, CV_BR = 8 * 8, CV_OUT = 16 * 8, CV_G1 = 16 * 4, CV_D1 = 8 * 8;
constexpr int CV_TOTAL = CV_IN + CV_GLU + 2 * CV_BR + CV_OUT + NE * (2 * CV_G1 + CV_D1);
__device__ __forceinline__ void convert_item(const Inputs& I, unsigned char* ws, int l, int it, int lane) {
    int r = it;
    if (r < NE * CV_G1) { const int e = r / CV_G1; transpose_item(I.w_eg + ((size_t)l * NE + e) * D * DE, D, DE, (bf16*)(ws + W_GU) + (size_t)e * 1024 * 1024, 1, r % CV_G1, lane); return; } r -= NE * CV_G1;
    if (r < NE * CV_G1) { const int e = r / CV_G1; transpose_item(I.w_eu + ((size_t)l * NE + e) * D * DE, D, DE, (bf16*)(ws + W_GU) + (size_t)e * 1024 * 1024, 2, r % CV_G1, lane); return; } r -= NE * CV_G1;
    if (r < NE * CV_D1) { const int e = r / CV_D1; transpose_item(I.w_ed + ((size_t)l * NE + e) * DE * D, DE, D, (bf16*)(ws + W_DN) + (size_t)e * 1024 * 512, 0, r % CV_D1, lane); return; } r -= NE * CV_D1;
    if (r < CV_IN) { transpose_item(I.w_in + (size_t)l * D * DIN, D, DIN, (bf16*)(ws + W_IN), 0, r, lane); return; } r -= CV_IN;
    if (r < CV_GLU) { transpose_item(I.w_glu + (size_t)l * 512 * 512, 512, 512, (bf16*)(ws + W_GLU), CHAIN_WMODE, r, lane); return; } r -= CV_GLU;
    if (r < CV_BR) { transpose_item(I.w_bra + (size_t)l * 512 * D, 512, D, (bf16*)(ws + W_BRA), CHAIN_WMODE, r, lane); return; } r -= CV_BR;
    if (r < CV_BR) { transpose_item(I.w_brs + (size_t)l * 512 * D, 512, D, (bf16*)(ws + W_BRS), CHAIN_WMODE, r, lane); return; } r -= CV_BR;
    transpose_item(I.w_out + (size_t)l * D * D, D, D, (bf16*)(ws + W_OUT), CHAIN_WMODE, r, lane);
}
__device__ __forceinline__ void convert_weights(Frame& F, const Inputs& I, int l) {
    if (F.vcu < NG) return;
    const int gw = (F.vcu - NG) * NWAVES + F.wave, NGW = (F.G - NG) * NWAVES;
    for (int r = 0, base = 0; base < CV_TOTAL; ++r, base += NGW) {
        const int it = base + ((r & 1) ? (NGW - 1 - gw) : gw);
        if (it < CV_TOTAL) convert_item(I, F.ws, l, it, F.lane);
    }
}

__device__ __forceinline__ void ssm_cs(float li, float dt, int tau, float& c, float& s) {
    const double x = (double)tau * ((double)li * (double)dt);
    const double k = __builtin_rint(x * 0.15915494309189535);
    const float r = (float)(x - k * 6.283185307179586);
    c = cosf(r); s = sinf(r);
}
constexpr int APS = 130;
__device__ __forceinline__ void ssmgen_job(Frame& F, const Inputs& I, int l, int g) {
    LAS float* Kt = (LAS float*)(F.lds);
    LAS float* apw = (LAS float*)(F.lds + 65536);
    LAS float* Bb = (LAS float*)(F.lds + 99872);
    LAS float* Ct = (LAS float*)(F.lds + 116256);
    const int tid = F.tid, lane = tid & 63, wave = tid >> 6;
    __syncthreads();
    if (tid < 128) {
        const int dir = tid >> 6, p = tid & 63, pg = (l * 2 + dir) * NG + g;
        const float lr = I.lam_re[pg * NST + p], li = I.lam_im[pg * NST + p], dt = expf(I.log_dt[pg]);
        float c1, s1; ssm_cs(li, dt, 1, c1, s1);
        const float mag = expf(lr * dt), sh = sinf(0.5f * li * dt);
        const float aim = mag * s1, nr = expm1f(lr * dt) * c1 - 2.f * sh * sh, den = lr * lr + li * li;
        const float fre = (nr * lr + aim * li) / den, fim = (aim * lr - nr * li) / den;
#pragma unroll 4
        for (int m = 0; m < 16; ++m) {
            const float br = I.sb_re[((size_t)pg * NST + p) * GS + m], bi = I.sb_im[((size_t)pg * NST + p) * GS + m];
            Bb[((dir * 64 + p) * 16 + m) * 2 + 0] = fre * br - fim * bi;
            Bb[((dir * 64 + p) * 16 + m) * 2 + 1] = fre * bi + fim * br;
            Ct[((dir * 64 + p) * 16 + m) * 2 + 0] = I.sc_re[((size_t)pg * GS + m) * NST + p];
            Ct[((dir * 64 + p) * 16 + m) * 2 + 1] = I.sc_im[((size_t)pg * GS + m) * NST + p];
        }
        float* tab = (float*)(F.ws + SM_SSMTAB);
        float c32, s32; ssm_cs(li, dt, 32, c32, s32);
        const float m32 = expf(32.f * lr * dt), a32r = m32 * c32, a32i = m32 * s32;
        float pr = a32r, pi = a32i;
        float two = 2.f; asm volatile("" : "+v"(two));
#pragma unroll
        for (int q = 0; q < 5; ++q) { const float nr2 = pr * pr - pi * pi, ni2 = two * pr * pi; pr = nr2; pi = ni2; }
        const float sr = pr * a32r - pi * a32i, si = pr * a32i + pi * a32r;
        const size_t ti = ((((size_t)l * NG + g) * 2 + dir) * 64 + p) * 2;
        tab[ti] = a32r; tab[ti + 1] = a32i; tab[16384 + ti] = sr; tab[16384 + ti + 1] = si;
    }
    for (int idx = tid; idx < 2 * 33 * 64; idx += 512) {
        const int p = idx & 63, tau = (idx >> 6) % 33, dir = idx / (33 * 64), pg = (l * 2 + dir) * NG + g;
        const float lr = I.lam_re[pg * NST + p], li = I.lam_im[pg * NST + p], dt = expf(I.log_dt[pg]);
        float c, sn; ssm_cs(li, dt, tau, c, sn);
        const float mg = expf((float)tau * lr * dt);
        apw[(dir * 33 + tau) * APS + p * 2] = mg * c; apw[(dir * 33 + tau) * APS + p * 2 + 1] = mg * sn;
    }
    __syncthreads();
    for (int idx = tid; idx < 1024; idx += 512) {
        const int dir = idx >> 9, tau = (idx >> 4) & 31, mp = idx & 15;
        float acc[16];
#pragma unroll
        for (int m = 0; m < 16; ++m) acc[m] = 0.f;
        for (int p = 0; p < 64; ++p) {
            const float ar = apw[(dir * 33 + tau) * APS + p * 2], ai = apw[(dir * 33 + tau) * APS + p * 2 + 1];
            const float br = Bb[((dir * 64 + p) * 16 + mp) * 2], bi = Bb[((dir * 64 + p) * 16 + mp) * 2 + 1];
            const float tr = ar * br - ai * bi, ti = ar * bi + ai * br;
            const LAS f32x4* cp = (const LAS f32x4*)(Ct + (dir * 64 + p) * 32);
#pragma unroll
            for (int q = 0; q < 8; ++q) { const f32x4 cv = cp[q]; acc[2 * q] += cv.x * tr - cv.y * ti; acc[2 * q + 1] += cv.z * tr - cv.w * ti; }
        }
#pragma unroll
        for (int m = 0; m < 16; ++m) Kt[((dir * 16 + m) * 32 + tau) * 16 + mp] = acc[m];
    }
    __syncthreads();
    bf16* W3 = (bf16*)(F.ws + W_S3) + (size_t)g * 512 * 768;
    const float* dsk = I.ssm_d + l * DSSM + g * 16;
    for (int n = wave; n < 512; n += 8) {
        const int t = n >> 4, m = n & 15;
        {
            const int s_ = lane >> 1, mp0 = (lane & 1) * 8;
            float v[8];
            if (s_ != t) { const int dir = s_ < t ? 0 : 1, tau = s_ < t ? t - s_ : s_ - t; const LAS f32x4* kp = (const LAS f32x4*)(Kt + ((dir * 16 + m) * 32 + tau) * 16 + mp0);
                const f32x4 a = kp[0], b = kp[1]; v[0] = a.x; v[1] = a.y; v[2] = a.z; v[3] = a.w; v[4] = b.x; v[5] = b.y; v[6] = b.z; v[7] = b.w; }
            else { const LAS f32x4* k0p = (const LAS f32x4*)(Kt + ((0 * 16 + m) * 32 + 0) * 16 + mp0); const LAS f32x4* k1p = (const LAS f32x4*)(Kt + ((1 * 16 + m) * 32 + 0) * 16 + mp0); const float dv = dsk[m];
                const f32x4 a = k0p[0] + k1p[0], b = k0p[1] + k1p[1]; v[0] = a.x; v[1] = a.y; v[2] = a.z; v[3] = a.w; v[4] = b.x; v[5] = b.y; v[6] = b.z; v[7] = b.w;
#pragma unroll
                for (int j = 0; j < 8; ++j) v[j] += (mp0 + j) == m ? dv : 0.f; }
            v4u o; o.x = cvt_pk_bf16(v[0], v[1]); o.y = cvt_pk_bf16(v[2], v[3]); o.z = cvt_pk_bf16(v[4], v[5]); o.w = cvt_pk_bf16(v[6], v[7]);
            *(GAS v4u*)(W3 + (size_t)n * 768 + lane * 8) = o;
        }
        if (lane < 32) {
            const int dir = lane >> 4, ri = (lane >> 3) & 1, p0 = (lane & 7) * 8, tw = dir == 0 ? t + 1 : 32 - t, pg = (l * 2 + dir) * NG + g;
            const GAS f32x4* crp = (const GAS f32x4*)(I.sc_re + ((size_t)pg * GS + m) * NST + p0); const GAS f32x4* cip = (const GAS f32x4*)(I.sc_im + ((size_t)pg * GS + m) * NST + p0);
            const f32x4 cr0 = crp[0], cr1 = crp[1], ci0 = cip[0], ci1 = cip[1];
            const float crv[8] = {cr0.x, cr0.y, cr0.z, cr0.w, cr1.x, cr1.y, cr1.z, cr1.w}, civ[8] = {ci0.x, ci0.y, ci0.z, ci0.w, ci1.x, ci1.y, ci1.z, ci1.w};
            float v[8];
#pragma unroll
            for (int j = 0; j < 8; ++j) { const float ar = apw[(dir * 33 + tw) * APS + (p0 + j) * 2], ai = apw[(dir * 33 + tw) * APS + (p0 + j) * 2 + 1];
                v[j] = ri == 0 ? (crv[j] * ar - civ[j] * ai) : -(crv[j] * ai + civ[j] * ar); }
            v4u o; o.x = cvt_pk_bf16(v[0], v[1]); o.y = cvt_pk_bf16(v[2], v[3]); o.z = cvt_pk_bf16(v[4], v[5]); o.w = cvt_pk_bf16(v[6], v[7]);
            *(GAS v4u*)(W3 + (size_t)n * 768 + 512 + lane * 8) = o;
        }
    }
    bf16* E = (bf16*)(F.ws + W_SE) + (size_t)g * 256 * 512;
    for (int n = wave; n < 256; n += 8) {
        const int dir = n >> 7, ri = (n >> 6) & 1, p = n & 63, s_ = lane >> 1, mp0 = (lane & 1) * 8, te = dir == 0 ? 31 - s_ : s_;
        const float ar = apw[(dir * 33 + te) * APS + p * 2], ai = apw[(dir * 33 + te) * APS + p * 2 + 1];
        float v[8];
#pragma unroll
        for (int j = 0; j < 8; ++j) { const float br = Bb[((dir * 64 + p) * 16 + mp0 + j) * 2], bi = Bb[((dir * 64 + p) * 16 + mp0 + j) * 2 + 1];
            v[j] = ri == 0 ? (ar * br - ai * bi) : (ar * bi + ai * br); }
        v4u o; o.x = cvt_pk_bf16(v[0], v[1]); o.y = cvt_pk_bf16(v[2], v[3]); o.z = cvt_pk_bf16(v[4], v[5]); o.w = cvt_pk_bf16(v[6], v[7]);
        *(GAS v4u*)(E + (size_t)n * 512 + lane * 8) = o;
    }
    __syncthreads();
}

__device__ __forceinline__ void mod_item(Frame& F, const Inputs& I, int item) {
    LAS float* sl = (LAS float*)(F.lds);
    LAS float* part = (LAS float*)(F.lds + 16384);
    __syncthreads();
    for (int i = F.tid; i < 3 * 1024; i += 512) { const int w = i >> 10, k = i & 1023; const float v = w < 2 ? I.c[w * D + k] : I.c_ctx[k]; sl[i] = v / (1.f + expf(-v)); }
    __syncthreads();
    const int l = item / 96, cb = item % 96, col = cb * 64 + F.lane;
    const float* W = I.w_mod + (size_t)l * D * 6144;
    float a0 = 0.f, a1 = 0.f, a2 = 0.f;
#pragma unroll 16
    for (int kk = 0; kk < 128; ++kk) { const int k = F.wave * 128 + kk; const float wv = W[(size_t)k * 6144 + col]; a0 += sl[k] * wv; a1 += sl[1024 + k] * wv; a2 += sl[2048 + k] * wv; }
    part[(F.wave * 3 + 0) * 64 + F.lane] = a0; part[(F.wave * 3 + 1) * 64 + F.lane] = a1; part[(F.wave * 3 + 2) * 64 + F.lane] = a2;
    __syncthreads();
    if (F.tid < 192) { const int w = F.tid >> 6, c = F.tid & 63; float s = 0.f;
#pragma unroll
        for (int v = 0; v < 8; ++v) s += part[(v * 3 + w) * 64 + c];
        ((float*)(F.ws + SM_MOD))[(l * 3 + w) * 6144 + cb * 64 + c] = s + I.b_mod[l * 6144 + cb * 64 + c]; }
    __syncthreads();
}
__device__ __forceinline__ void p0_small(Frame& F, const Inputs& I) {
    const int b = F.vcu - 224;
    if (b < 0) return;
    const int t = b * 512 + F.tid, NT = 32 * 512;
    float* rope = (float*)(F.ws + SM_ROPE);
    for (int i = t; i < 128 * 16; i += NT) { const int pos = i >> 4, j = i & 15; const float freq = exp2f(-(float)j * (13.287712379549449f / 16.f)); const float ang = (float)pos * freq;
        const double x = (double)ang; const double k = __builtin_rint(x * 0.15915494309189535); const float r = (float)(x - k * 6.283185307179586);
        rope[i] = cosf(r); rope[2048 + i] = sinf(r); }
    float* wrt = (float*)(F.ws + SM_WRT);
    for (int i = t; i < 2 * 36 * 1024; i += NT) { const int k = i & 1023, j = (i >> 10) % 36, l = i / (36 * 1024);
        wrt[i] = j < 4 ? I.w_rg[((size_t)l * D + k) * 4 + j] : I.w_re[((size_t)l * D + k) * 32 + (j - 4)]; }
}
struct RowVec { f32x4 v[4]; };
__device__ __forceinline__ RowVec load_row_f32(const float* p, int lane) { RowVec r; const GAS f32x4* q = (const GAS f32x4*)p + lane;
#pragma unroll
    for (int j = 0; j < 4; ++j) r.v[j] = q[64 * j]; return r; }
__device__ __forceinline__ void store_row_f32(float* p, int lane, const RowVec& r) { GAS f32x4* q = (GAS f32x4*)p + lane;
#pragma unroll
    for (int j = 0; j < 4; ++j) q[64 * j] = r.v[j]; }
__device__ __forceinline__ RowVec load_row_bf16(const bf16* p, int lane) { RowVec r; const GAS v2u* q = (const GAS v2u*)p + lane;
#pragma unroll
    for (int j = 0; j < 4; ++j) { const v2u w = q[64 * j]; r.v[j] = (f32x4){bf_lo(w.x), bf_hi(w.x), bf_lo(w.y), bf_hi(w.y)}; } return r; }
__device__ __forceinline__ void store_row_bf16(bf16* p, int lane, const RowVec& r) { GAS v2u* q = (GAS v2u*)p + lane;
#pragma unroll
    for (int j = 0; j < 4; ++j) { v2u w; w.x = cvt_pk_bf16(r.v[j].x, r.v[j].y); w.y = cvt_pk_bf16(r.v[j].z, r.v[j].w); q[64 * j] = w; } }
__device__ __forceinline__ float row_rinv(const RowVec& r) { float s = 0.f;
#pragma unroll
    for (int j = 0; j < 4; ++j) s += (r.v[j].x * r.v[j].x + r.v[j].y * r.v[j].y) + (r.v[j].z * r.v[j].z + r.v[j].w * r.v[j].w);
    return rsqrtf(wave_sum(s) * (1.f / D) + 1e-6f); }
__device__ __forceinline__ RowVec norm_mod(const RowVec& x, float rinv, const float* g, const float* shift, const float* scale, int lane) {
    RowVec o; const GAS f32x4* gp = (const GAS f32x4*)g + lane; const GAS f32x4* sh = (const GAS f32x4*)shift + lane; const GAS f32x4* sc = (const GAS f32x4*)scale + lane;
#pragma unroll
    for (int j = 0; j < 4; ++j) o.v[j] = x.v[j] * rinv * gp[64 * j] * (1.f + sc[64 * j]) + sh[64 * j];
    return o; }
__device__ __forceinline__ void moe_combine(RowVec& x, const bf16* ye, const int* rdest, int row, const float* gate, int lane) {
    const int d0 = rdest[row * 2], d1 = rdest[row * 2 + 1];
    const RowVec a = load_row_bf16(ye + (size_t)d0 * D, lane), b = load_row_bf16(ye + (size_t)d1 * D, lane);
    const GAS f32x4* gp = (const GAS f32x4*)gate + lane;
#pragma unroll
    for (int j = 0; j < 4; ++j) x.v[j] = x.v[j] + gp[64 * j] * (a.v[j] + b.v[j]);
}
__device__ __forceinline__ void moe_tables(Frame& F, int l);
__device__ __forceinline__ void phase_norm1(Frame& F, const Inputs& I, int l) {
    const int gw = F.vcu * NWAVES + F.wave, NGW = F.G * NWAVES;
    const float* mod = (const float*)(F.ws + SM_MOD);
    float* XC = (float*)(F.ws + WS_XC); bf16* H = (bf16*)(F.ws + WS_H);
    const bf16* YE = (const bf16*)(F.ws + B_YE); const int* RE = (const int*)(F.ws + SM_RE); const int* RS = (const int*)(F.ws + SM_RSLOT);
    if (l > 0) moe_tables(F, l - 1);
    const volatile LAS int* tp = (const volatile LAS int*)(F.lds + L_MOETAB);
#define ROW_DEST(i_) (256 * tp[RE[i_]] + RS[i_])
    for (int r0 = gw; r0 < NALL; r0 += 2 * NGW) {
        const int r1 = r0 + NGW; const bool two = r1 < NALL; const int r1c = two ? r1 : r0;
        RowVec x0, x1;
        if (l == 0) { x0 = load_row_f32(r0 < NTOK ? I.x + (size_t)r0 * D : I.ctx + (size_t)(r0 - NTOK) * D, F.lane); x1 = load_row_f32(r1c < NTOK ? I.x + (size_t)r1c * D : I.ctx + (size_t)(r1c - NTOK) * D, F.lane); }
        else {
            const int d00 = ROW_DEST(r0 * 2), d01 = ROW_DEST(r0 * 2 + 1), d10 = ROW_DEST(r1c * 2), d11 = ROW_DEST(r1c * 2 + 1);
            x0 = load_row_f32(XC + (size_t)r0 * D, F.lane); x1 = load_row_f32(XC + (size_t)r1c * D, F.lane);
            const RowVec a0 = load_row_bf16(YE + (size_t)d00 * D, F.lane), b0 = load_row_bf16(YE + (size_t)d01 * D, F.lane), a1 = load_row_bf16(YE + (size_t)d10 * D, F.lane), b1 = load_row_bf16(YE + (size_t)d11 * D, F.lane);
            const GAS f32x4* g0 = (const GAS f32x4*)(mod + (0 * 3 + which_of_row(r0)) * 6144 + 5 * D) + F.lane; const GAS f32x4* g1p = (const GAS f32x4*)(mod + (0 * 3 + which_of_row(r1c)) * 6144 + 5 * D) + F.lane;
#pragma unroll
            for (int j = 0; j < 4; ++j) { x0.v[j] = x0.v[j] + g0[64 * j] * (a0.v[j] + b0.v[j]); x1.v[j] = x1.v[j] + g1p[64 * j] * (a1.v[j] + b1.v[j]); }
            store_row_f32(XC + (size_t)r0 * D, F.lane, x0); if (two) store_row_f32(XC + (size_t)r1 * D, F.lane, x1);
        }
        const float ri0 = row_rinv(x0), ri1 = row_rinv(x1);
        const float* m0 = mod + (l * 3 + which_of_row(r0)) * 6144; const float* m1 = mod + (l * 3 + which_of_row(r1c)) * 6144;
        const RowVec h0 = norm_mod(x0, ri0, I.g1 + l * D, m0 + 0 * D, m0 + 1 * D, F.lane), h1 = norm_mod(x1, ri1, I.g1 + l * D, m1 + 0 * D, m1 + 1 * D, F.lane);
        store_row_bf16(H + (size_t)r0 * D, F.lane, h0); if (two) store_row_bf16(H + (size_t)r1 * D, F.lane, h1);
    }
}
__device__ __forceinline__ void phase_final(Frame& F, const Inputs& I) {
    const int gw = F.vcu * NWAVES + F.wave, NGW = F.G * NWAVES;
    const float* mod = (const float*)(F.ws + SM_MOD);
    const float* XC = (const float*)(F.ws + WS_XC);
    const bf16* YE = (const bf16*)(F.ws + B_YE); const int* RE = (const int*)(F.ws + SM_RE); const int* RS = (const int*)(F.ws + SM_RSLOT);
    moe_tables(F, 1);
    const volatile LAS int* tp = (const volatile LAS int*)(F.lds + L_MOETAB);
    for (int r0 = gw; r0 < NTOK; r0 += 2 * NGW) {
        const int r1 = r0 + NGW; const bool two = r1 < NTOK; const int r1c = two ? r1 : r0;
        const int d00 = ROW_DEST(r0 * 2), d01 = ROW_DEST(r0 * 2 + 1), d10 = ROW_DEST(r1c * 2), d11 = ROW_DEST(r1c * 2 + 1);
        RowVec x0 = load_row_f32(XC + (size_t)r0 * D, F.lane), x1 = load_row_f32(XC + (size_t)r1c * D, F.lane);
        const RowVec a0 = load_row_bf16(YE + (size_t)d00 * D, F.lane), b0 = load_row_bf16(YE + (size_t)d01 * D, F.lane), a1 = load_row_bf16(YE + (size_t)d10 * D, F.lane), b1 = load_row_bf16(YE + (size_t)d11 * D, F.lane);
        const GAS f32x4* g0 = (const GAS f32x4*)(mod + (1 * 3 + which_of_row(r0)) * 6144 + 5 * D) + F.lane; const GAS f32x4* g1p = (const GAS f32x4*)(mod + (1 * 3 + which_of_row(r1c)) * 6144 + 5 * D) + F.lane;
#pragma unroll
        for (int j = 0; j < 4; ++j) { x0.v[j] = x0.v[j] + g0[64 * j] * (a0.v[j] + b0.v[j]); x1.v[j] = x1.v[j] + g1p[64 * j] * (a1.v[j] + b1.v[j]); }
        const float ri0 = row_rinv(x0), ri1 = row_rinv(x1);
        RowVec o0, o1; const GAS f32x4* gp = (const GAS f32x4*)I.g_final + F.lane;
#pragma unroll
        for (int j = 0; j < 4; ++j) { o0.v[j] = x0.v[j] * ri0 * gp[64 * j]; o1.v[j] = x1.v[j] * ri1 * gp[64 * j]; }
        store_row_f32(F.out + (size_t)r0 * D, F.lane, o0); if (two) store_row_f32(F.out + (size_t)r1 * D, F.lane, o1);
    }
}

__device__ __forceinline__ void phase_norm2_route(Frame& F, const Inputs& I, int l, int dbgf = 0) {
    const int nrows = l == 0 ? NALL : NTOK, R = nrows / 256, row_base = F.vcu * R, nextra = R - 64;
    const float* mod = (const float*)(F.ws + SM_MOD);
    const float* XC = (const float*)(F.ws + WS_XC); bf16* H = (bf16*)(F.ws + WS_H);
    const float* wrt = (const float*)(F.ws + SM_WRT) + (size_t)l * 36 * 1024;
    volatile LAS int* lcnt = (volatile LAS int*)(F.lds + L_WGCNT);
    LAS float* wt = (LAS float*)(F.lds);
    LAS float* lg = (LAS float*)(F.lds + 131072 + F.wave * 1296);
    int* RE = (int*)(F.ws + SM_RE); float* RW = (float*)(F.ws + SM_RW); int* RSLOT = (int*)(F.ws + SM_RSLOT);
    __syncthreads();
    if (F.tid < 64) lcnt[F.tid] = 0;
    { const GAS f32x4* src = (const GAS f32x4*)(wrt + 4 * 1024); LAS f32x4* dst = (LAS f32x4*)wt;
#pragma unroll 8
      for (int i = F.tid; i < 32 * 256; i += 512) dst[i] = src[i]; }
    __syncthreads();
    const int ngroups = F.wave < nextra ? 3 : 2;
#pragma unroll 1
    for (int grp = 0; grp < ngroups; ++grp) {
        RowVec h[4];
        const int rfirst = row_base + (grp < 2 ? F.wave * 8 + grp * 4 : 64 + F.wave), rstep = grp < 2 ? 1 : 0;
#pragma unroll
        for (int rr = 0; rr < 4; ++rr) h[rr] = load_row_f32(XC + (size_t)(rfirst + rr * rstep) * D, F.lane);
        const float* ml = mod + (l * 3 + which_of_row(rfirst)) * 6144;
        RowVec gsc, gsh;
        { const GAS f32x4* gp = (const GAS f32x4*)(I.g2 + l * D) + F.lane; const GAS f32x4* sc = (const GAS f32x4*)(ml + 4 * D) + F.lane; const GAS f32x4* sh = (const GAS f32x4*)(ml + 3 * D) + F.lane;
#pragma unroll
          for (int j = 0; j < 4; ++j) { gsc.v[j] = gp[64 * j] * (1.f + sc[64 * j]); gsh.v[j] = sh[64 * j]; } }
#pragma unroll
        for (int rr = 0; rr < 4; ++rr) {
            const int r = rfirst + rr * rstep;
            const float rinv = row_rinv(h[rr]);
            if (which_of_row(r) == which_of_row(rfirst)) {
#pragma unroll
                for (int j = 0; j < 4; ++j) h[rr].v[j] = h[rr].v[j] * rinv * gsc.v[j] + gsh.v[j];
            } else { const float* m2 = mod + (l * 3 + which_of_row(r)) * 6144; h[rr] = norm_mod(h[rr], rinv, I.g2 + l * D, m2 + 3 * D, m2 + 4 * D, F.lane); }
            if (grp < 2 || rr == 0) store_row_bf16(H + (size_t)r * D, F.lane, h[rr]);
        }
#pragma unroll
        for (int j = 0; j < 4; ++j) { const GAS f32x4* wp = (const GAS f32x4*)(wrt + j * 1024) + F.lane; f32x4 wv[4];
#pragma unroll
            for (int q = 0; q < 4; ++q) wv[q] = wp[64 * q];
            float a_[4];
#pragma unroll
            for (int rr = 0; rr < 4; ++rr) { f32x4 s4 = h[rr].v[0] * wv[0]; s4 = s4 + h[rr].v[1] * wv[1]; s4 = s4 + h[rr].v[2] * wv[2]; s4 = s4 + h[rr].v[3] * wv[3]; a_[rr] = (s4.x + s4.y) + (s4.z + s4.w); }
            const float c20 = swap32_sum(a_[0], a_[2]), c21 = swap32_sum(a_[1], a_[3]); float c1 = swap16_sum(c20, c21); c1 = row16_sum(c1);
            if ((F.lane & 15) == 0) { const int rr = F.lane >> 4; if (grp < 2) lg[(grp * 4 + rr) * 36 + j] = c1; else if (rr == 0) lg[8 * 36 + j] = c1; } }
        LDS_WAIT(); asm volatile("" ::: "memory");
#pragma unroll
        for (int rr = 0; rr < 4; ++rr) {
            if (grp == 2 && rr > 0) break;
            const int lrow = grp < 2 ? grp * 4 + rr : 8;
            const LAS float* q = lg + lrow * 36;
            int gi = 0; float gm = q[0];
#pragma unroll
            for (int i = 1; i < 4; ++i) { const float v = q[i]; if (v > gm) { gm = v; gi = i; } }
            gi = __builtin_amdgcn_readfirstlane(gi);
            float a_[8];
#pragma unroll
            for (int e = 0; e < 8; ++e) { const LAS f32x4* wp = (const LAS f32x4*)(wt + (gi * 8 + e) * 1024) + F.lane;
                f32x4 s4 = h[rr].v[0] * wp[0]; s4 = s4 + h[rr].v[1] * wp[64]; s4 = s4 + h[rr].v[2] * wp[128]; s4 = s4 + h[rr].v[3] * wp[192]; a_[e] = (s4.x + s4.y) + (s4.z + s4.w); }
            const float c40 = swap32_sum(a_[0], a_[4]), c41 = swap32_sum(a_[1], a_[5]), c42 = swap32_sum(a_[2], a_[6]), c43 = swap32_sum(a_[3], a_[7]);
            float c20 = swap16_sum(c40, c42), c21 = swap16_sum(c41, c43);
            c20 = row16_sum(c20); c21 = row16_sum(c21);
            if ((F.lane & 15) == 0) { const int e0 = (F.lane >> 4) * 2; lg[lrow * 36 + 4 + e0] = c20; lg[lrow * 36 + 4 + e0 + 1] = c21; }
        }
    }
    LDS_WAIT(); asm volatile("" ::: "memory");
    int my_e0 = 0, my_e1 = 0, my_l0 = 0, my_l1 = 0, my_row = -1; float my_w0 = 0.f, my_w1 = 0.f;
    if (F.lane < 8 || (F.lane == 8 && F.wave < nextra)) {
        const LAS float* q = lg + F.lane * 36;
        int gi = 0; float gm = q[0];
#pragma unroll
        for (int i = 1; i < 4; ++i) if (q[i] > gm) { gm = q[i]; gi = i; }
        float gs = 0.f;
#pragma unroll
        for (int i = 0; i < 4; ++i) gs += expf(q[i] - gm);
        const float gprob = 1.f / gs;
        const LAS float* el = q + 4;
        int i1 = 0; float v1 = el[0];
#pragma unroll
        for (int i = 1; i < 8; ++i) if (el[i] > v1) { v1 = el[i]; i1 = i; }
        int i2 = 0; float v2 = -INFINITY;
#pragma unroll
        for (int i = 0; i < 8; ++i) if (i != i1 && el[i] > v2) { v2 = el[i]; i2 = i; }
        const float e2 = expf(v2 - v1), p1 = 1.f / (1.f + e2), p2 = e2 / (1.f + e2);
        const int r = row_base + (F.lane < 8 ? F.wave * 8 + F.lane : 64 + F.wave), e0 = gi * 8 + i1, e1 = gi * 8 + i2;
        RE[r * 2] = e0; RE[r * 2 + 1] = e1; RW[r * 2] = gprob * p1; RW[r * 2 + 1] = gprob * p2;
        my_row = r; my_e0 = e0; my_e1 = e1; my_w0 = gprob * p1; my_w1 = gprob * p2;
        my_l0 = __hip_atomic_fetch_add((LAS int*)(F.lds + L_WGCNT) + e0, 1, __ATOMIC_RELAXED, __HIP_MEMORY_SCOPE_WORKGROUP);
        my_l1 = __hip_atomic_fetch_add((LAS int*)(F.lds + L_WGCNT) + e1, 1, __ATOMIC_RELAXED, __HIP_MEMORY_SCOPE_WORKGROUP);
    }
    __syncthreads();
    if (F.tid < 32) { const int c = lcnt[F.tid]; int base = 0; if (c > 0) base = (int)__hip_atomic_fetch_add(F.ctl + CW_CNT + 64 * l + F.tid, (unsigned)c, RLX_AGENT); lcnt[32 + F.tid] = base; }
    __syncthreads();
    if (my_row >= 0) { const int s0 = lcnt[32 + my_e0] + my_l0, s1 = lcnt[32 + my_e1] + my_l1; RSLOT[my_row * 2] = s0; RSLOT[my_row * 2 + 1] = s1;
        int* LIST = (int*)(F.ws + B_LIST); float* LISTW = (float*)(F.ws + B_LISTW);
        LIST[my_e0 * CAPL + s0] = my_row; LISTW[my_e0 * CAPL + s0] = my_w0; LIST[my_e1 * CAPL + s1] = my_row; LISTW[my_e1 * CAPL + s1] = my_w1; }
    __syncthreads();
}

__device__ __forceinline__ void moe_tables(Frame& F, int l) {
    volatile LAS int* tp = (volatile LAS int*)(F.lds + L_MOETAB);
    __syncthreads();
    if (F.tid == 0) { int acc = 0;
        for (int e = 0; e < NE; ++e) { tp[e] = acc; const int c = (int)__hip_atomic_load(F.ctl + CW_CNT + 64 * l + e, RLX_AGENT); tp[NE + 1 + e] = c; acc += (c + 255) >> 8; }
        tp[NE] = acc; }
    __syncthreads();
}
__device__ __forceinline__ void phase_gather(Frame& F, int l) {
    moe_tables(F, l);
    const volatile LAS int* tp = (const volatile LAS int*)(F.lds + L_MOETAB);
    const int nrows = l == 0 ? NALL : NTOK;
    const int gw = F.vcu * NWAVES + F.wave, NGW = F.G * NWAVES;
    const bf16* H = (const bf16*)(F.ws + WS_H); bf16* HS = (bf16*)(F.ws + B_HS);
    const int* RE = (const int*)(F.ws + SM_RE); const float* RW = (const float*)(F.ws + SM_RW); const int* RSLOT = (const int*)(F.ws + SM_RSLOT);
    int* RDEST = (int*)(F.ws + SM_RDEST); float* RWS = (float*)(F.ws + SM_RWS);
    for (int r0 = gw; r0 < nrows; r0 += 2 * NGW) {
        const int r1 = r0 + NGW; const bool two = r1 < nrows; const int r1c = two ? r1 : r0;
        const GAS v4u* s0 = (const GAS v4u*)(H + (size_t)r0 * D) + F.lane; const GAS v4u* s1 = (const GAS v4u*)(H + (size_t)r1c * D) + F.lane;
        const v4u a0 = s0[0], b0 = s0[64], a1 = s1[0], b1 = s1[64];
        const int e00 = RE[r0 * 2], e01 = RE[r0 * 2 + 1], e10 = RE[r1c * 2], e11 = RE[r1c * 2 + 1];
        const int dd[4] = {256 * tp[e00] + RSLOT[r0 * 2], 256 * tp[e01] + RSLOT[r0 * 2 + 1], 256 * tp[e10] + RSLOT[r1c * 2], 256 * tp[e11] + RSLOT[r1c * 2 + 1]};
#pragma unroll
        for (int k = 0; k < 4; ++k) {
            if (k >= 2 && !two) break;
            GAS v4u* dst = (GAS v4u*)(HS + (size_t)dd[k] * D) + F.lane;
            dst[0] = k < 2 ? a0 : a1; dst[64] = k < 2 ? b0 : b1;
            const int r = k < 2 ? r0 : r1;
            if (F.lane == 0) { RDEST[r * 2 + (k & 1)] = dd[k]; RWS[dd[k]] = RW[r * 2 + (k & 1)]; }
        }
    }
}
__device__ __forceinline__ int carry_cidx(int dir, int b, int v) { return dir == 0 ? (v < 8 ? 512 + b * 8 + v : b * 256 + (v - 8)) : (v < 8 ? 512 + b * 8 + (7 - v) : b * 256 + 255 - (v - 8)); }
template <bool WT> __device__ __forceinline__ void phase_ssm_carry(Frame& F, int l, int job = -1) {
    if (job < 0) job = F.vcu;
    if (job >= 128) return;
    const int g = job >> 2, b = (job >> 1) & 1, dir = job & 1, seg = F.tid >> 6, p = F.tid & 63;
    const float* tab = (const float*)(F.ws + SM_SSMTAB);
    const size_t ti = ((((size_t)l * NG + g) * 2 + dir) * 64 + p) * 2;
    const float a32r = tab[ti], a32i = tab[ti + 1], asr = tab[16384 + ti], asi = tab[16384 + ti + 1];
    const float* send = (const float*)(F.ws + B_SEND) + (size_t)g * NCH * 256 + dir * 128 + p;
    bf16* A3 = (bf16*)(F.ws + B_A3) + (size_t)g * NCH * 768 + 512 + dir * 128 + p;
    LAS float* segend = (LAS float*)(F.lds);
    float xr = 0.f, xi = 0.f;
#pragma unroll 1
    for (int k0 = 0; k0 < 33; k0 += 11) {
        float sr[11], si[11];
#pragma unroll
        for (int k = 0; k < 11; ++k) { const unsigned c = (unsigned)carry_cidx(dir, b, seg * 33 + k0 + k); sr[k] = send[c * 256u]; si[k] = send[c * 256u + 64u]; }
#pragma unroll
        for (int k = 0; k < 11; ++k) { const float nr = a32r * xr - a32i * xi + sr[k], ni = a32r * xi + a32i * xr + si[k]; xr = nr; xi = ni; }
    }
    __syncthreads();
    segend[(seg * 64 + p) * 2] = xr; segend[(seg * 64 + p) * 2 + 1] = xi;
    __syncthreads();
    float cr = 0.f, ci = 0.f;
    for (int k = 0; k < seg; ++k) { const float er = segend[(k * 64 + p) * 2], ei = segend[(k * 64 + p) * 2 + 1]; const float nr = asr * cr - asi * ci + er, ni = asr * ci + asi * cr + ei; cr = nr; ci = ni; }
    xr = cr; xi = ci;
#pragma unroll 1
    for (int k0 = 0; k0 < 33; k0 += 11) {
        float sr[11], si[11];
#pragma unroll
        for (int k = 0; k < 11; ++k) { const unsigned c = (unsigned)carry_cidx(dir, b, seg * 33 + k0 + k); sr[k] = send[c * 256u]; si[k] = send[c * 256u + 64u]; }
#pragma unroll
        for (int k = 0; k < 11; ++k) { const unsigned c = (unsigned)carry_cidx(dir, b, seg * 33 + k0 + k);
            if constexpr (WT) { __hip_atomic_store((GAS unsigned short*)(A3 + c * 768u), (unsigned short)f2bf_rne(xr), __ATOMIC_RELAXED, __HIP_MEMORY_SCOPE_AGENT); __hip_atomic_store((GAS unsigned short*)(A3 + c * 768u + 64u), (unsigned short)f2bf_rne(xi), __ATOMIC_RELAXED, __HIP_MEMORY_SCOPE_AGENT); }
            else { A3[c * 768u] = (bf16)f2bf_rne(xr); A3[c * 768u + 64u] = (bf16)f2bf_rne(xi); }
            const float nr = a32r * xr - a32i * xi + sr[k], ni = a32r * xi + a32i * xr + si[k]; xr = nr; xi = ni; }
    }
    __syncthreads();
}
struct KFrag { bf16x8 k[4]; };
struct VFrag { bf16x8 v[2][2]; };
__device__ __forceinline__ void k_load(KFrag& f, const bf16* kp  , int lane) {
    const int r32 = lane & 31, hi = lane >> 5;
#pragma unroll
    for (int d0 = 0; d0 < 4; ++d0) f.k[d0] = *(const GAS bf16x8*)(kp + (size_t)r32 * 128 + d0 * 16 + hi * 8);
}
__device__ __forceinline__ void v_load(VFrag& f, const bf16* vp  , int vpitch, int lane) {
    const int r32 = lane & 31, hi = lane >> 5;
#pragma unroll
    for (int db = 0; db < 2; ++db)
#pragma unroll
        for (int ks = 0; ks < 2; ++ks) f.v[db][ks] = *(const GAS bf16x8*)(vp + (size_t)(32 * db + r32) * vpitch + 16 * ks + 8 * hi);
}
__device__ __forceinline__ void attn_tile(f32x16 (&o)[2], float& m_run, float& l_run, const bf16x8 (&qf)[4], const KFrag& fk, const VFrag& f, int mask_mode  , int lane) {
    const int r32 = lane & 31, hi = lane >> 5;
    f32x16 s = {};
#pragma unroll
    for (int d0 = 0; d0 < 4; ++d0) s = __builtin_amdgcn_mfma_f32_32x32x16_bf16(fk.k[d0], qf[d0], s, 0, 0, 0);
    __builtin_amdgcn_sched_barrier(0);
    if (mask_mode != 0) {
#pragma unroll
        for (int r = 0; r < 16; ++r) { const int kidx = (r & 3) + 8 * (r >> 2) + 4 * hi; const bool valid = mask_mode == 1 ? (kidx >= r32) : (kidx <= r32); if (!valid) s[r] = -INFINITY; }
    }
    float tm = s[0];
#pragma unroll
    for (int r = 1; r < 16; ++r) tm = fmaxf(tm, s[r]);
    { auto rr = __builtin_amdgcn_permlane32_swap(__float_as_uint(tm), __float_as_uint(tm), false, false); tm = fmaxf(__uint_as_float(rr[0]), __uint_as_float(rr[1])); }
    const float m_new = fmaxf(m_run, tm);
    const float alpha = __builtin_amdgcn_exp2f(m_run - m_new);
    m_run = m_new;
    float ps = 0.f;
#pragma unroll
    for (int r = 0; r < 16; ++r) { s[r] = __builtin_amdgcn_exp2f(s[r] - m_new); ps += s[r]; }
    l_run = l_run * alpha + ps;
    __builtin_amdgcn_sched_barrier(0);
#pragma unroll
    for (int db = 0; db < 2; ++db)
#pragma unroll
        for (int r = 0; r < 16; ++r) o[db][r] *= alpha;
    __builtin_amdgcn_sched_barrier(0);
    bf16x8 pf[2];
#pragma unroll
    for (int ks = 0; ks < 2; ++ks) {
        v4u w; w.x = cvt_pk_bf16(s[8 * ks + 0], s[8 * ks + 1]); w.y = cvt_pk_bf16(s[8 * ks + 2], s[8 * ks + 3]); w.z = cvt_pk_bf16(s[8 * ks + 4], s[8 * ks + 5]); w.w = cvt_pk_bf16(s[8 * ks + 6], s[8 * ks + 7]);
        pf[ks] = __builtin_bit_cast(bf16x8, w);
    }
#pragma unroll
    for (int db = 0; db < 2; ++db)
#pragma unroll
        for (int ks = 0; ks < 2; ++ks) o[db] = __builtin_amdgcn_mfma_f32_32x32x16_bf16(f.v[db][ks], pf[ks], o[db], 0, 0, 0);
}
__device__ __forceinline__ void tile_ptrs(int t, int nloc, int i_lo, int p0, const bf16* kl, const bf16* vl, const bf16* kc, const bf16* vc, const bf16*& kp, const bf16*& vp, int& vpitch, int& mm) {
    if (t < nloc) { const int i = i_lo + t, kt = p0 - 128 + 32 * i; kp = kl + (size_t)kt * 128; vp = vl + kt; vpitch = S; mm = i == 0 ? 1 : (i == 8 ? 2 : 0); }
    else { const int c = t - nloc; kp = kc + (size_t)(32 * c) * 128; vp = vc + 32 * c; vpitch = CTX; mm = 0; }
}
__device__ __forceinline__ void attn_wave(Frame& F, int qrow0, int h0, int b, int p0, float sink0, float sink1) {
    const int lane = F.lane, r32 = lane & 31, hi = lane >> 5, kvh = h0 >> 2;
    const bf16* Q = (const bf16*)(F.ws + B_Q); const bf16* KB = (const bf16*)(F.ws + B_K); const bf16* VT = (const bf16*)(F.ws + B_VT);
    bf16x8 qa[4], qb[4];
#pragma unroll
    for (int d0 = 0; d0 < 4; ++d0) { qa[d0] = *(const GAS bf16x8*)(Q + (size_t)(qrow0 + r32) * 512 + h0 * 64 + d0 * 16 + hi * 8); qb[d0] = *(const GAS bf16x8*)(Q + (size_t)(qrow0 + r32) * 512 + (h0 + 1) * 64 + d0 * 16 + hi * 8); }
    f32x16 oa[2], ob[2]; oa[0] = f32x16{}; oa[1] = f32x16{}; ob[0] = f32x16{}; ob[1] = f32x16{};
    float ma = sink0 * LOG2E, mb = sink1 * LOG2E, la = hi == 0 ? 1.f : 0.f, lb = la;
    const bf16* kl = KB + (size_t)(b * S) * 128 + kvh * 64; const bf16* vl = VT + (size_t)((b * 2 + kvh) * 64) * S;
    const bf16* kc = KB + (size_t)(NTOK + b * CTX) * 128 + kvh * 64; const bf16* vc = VT + (size_t)NTOK * 128 + (size_t)((b * 2 + kvh) * 64) * CTX;
    int i_lo = 0, nloc = 0;
    if (p0 >= 0) { i_lo = 4 - (p0 >> 5); if (i_lo < 0) i_lo = 0; int i_hi = (S + 128 - p0) >> 5; if (i_hi > 9) i_hi = 9; nloc = i_hi - i_lo; }
    const int nt = nloc + 8;
    KFrag ka, kb; VFrag vv;
    { const bf16* kp; const bf16* vp; int vpitch, mm; tile_ptrs(0, nloc, i_lo, p0, kl, vl, kc, vc, kp, vp, vpitch, mm); k_load(ka, kp, lane); }
#pragma unroll 1
    for (int t = 0; t < nt; t += 2) {
        const bf16* kp; const bf16* vp; int vpitch, mm0, mm1 = 0, mmx;
        tile_ptrs(t, nloc, i_lo, p0, kl, vl, kc, vc, kp, vp, vpitch, mm0); v_load(vv, vp, vpitch, lane);
        if (t + 1 < nt) { tile_ptrs(t + 1, nloc, i_lo, p0, kl, vl, kc, vc, kp, vp, vpitch, mm1); k_load(kb, kp, lane); }
        attn_tile(oa, ma, la, qa, ka, vv, mm0, lane); attn_tile(ob, mb, lb, qb, ka, vv, mm0, lane);
        if (t + 1 < nt) {
            v_load(vv, vp, vpitch, lane);
            if (t + 2 < nt) { tile_ptrs(t + 2, nloc, i_lo, p0, kl, vl, kc, vc, kp, vp, vpitch, mmx); k_load(ka, kp, lane); }
            attn_tile(oa, ma, la, qa, kb, vv, mm1, lane); attn_tile(ob, mb, lb, qb, kb, vv, mm1, lane);
        }
    }
    bf16* O = (bf16*)(F.ws + B_ATT) + (size_t)(qrow0 + r32) * 512 + h0 * 64;
    { const float inv = 1.f / (la + xor32_f(la, lane));
#pragma unroll
      for (int db = 0; db < 2; ++db)
#pragma unroll
        for (int g4 = 0; g4 < 4; ++g4) { v2u w; w.x = cvt_pk_bf16(oa[db][4 * g4 + 0] * inv, oa[db][4 * g4 + 1] * inv); w.y = cvt_pk_bf16(oa[db][4 * g4 + 2] * inv, oa[db][4 * g4 + 3] * inv); *(GAS v2u*)(O + 32 * db + 8 * g4 + 4 * hi) = w; } }
    { const float inv = 1.f / (lb + xor32_f(lb, lane));
#pragma unroll
      for (int db = 0; db < 2; ++db)
#pragma unroll
        for (int g4 = 0; g4 < 4; ++g4) { v2u w; w.x = cvt_pk_bf16(ob[db][4 * g4 + 0] * inv, ob[db][4 * g4 + 1] * inv); w.y = cvt_pk_bf16(ob[db][4 * g4 + 2] * inv, ob[db][4 * g4 + 3] * inv); *(GAS v2u*)(O + 64 + 32 * db + 8 * g4 + 4 * hi) = w; } }
}
constexpr int ATT_V_OFF = 49152;
__device__ __forceinline__ void lds_frag_load(KFrag& kf, VFrag& vf, const LAS unsigned char* kt, const LAS unsigned char* vt, int lane) {
    const int r32 = lane & 31, hi = lane >> 5;
#pragma unroll
    for (int d0 = 0; d0 < 4; ++d0) kf.k[d0] = *(const LAS bf16x8*)(kt + r32 * 128 + (((2 * d0 + hi) ^ ((r32 >> 1) & 7)) * 16));
#pragma unroll
    for (int db = 0; db < 2; ++db)
#pragma unroll
        for (int ks = 0; ks < 2; ++ks) { const int d = 32 * db + r32; vf.v[db][ks] = *(const LAS bf16x8*)(vt + d * 64 + (((2 * ks + hi) ^ ((d >> 2) & 3)) * 16)); }
}
__device__ __forceinline__ void attn_wg_task(Frame& F, const Inputs& I, int l, int v) {
    int lane_ = F.lane, wave_ = F.wave; asm volatile("" : "+v"(lane_), "+s"(wave_));
    const int lane = lane_, wave = wave_, r32 = lane & 31, hi = lane >> 5;
    const int bk = v >> 6, b = bk >> 1, kvh = bk & 1, q0 = (v & 63) * 128, h0 = kvh * 4 + 2 * (wave & 1), qt = wave >> 1, p0 = q0 + 32 * qt, kb0 = q0 - 128;
    const bf16* Q = (const bf16*)(F.ws + B_Q); const bf16* KB = (const bf16*)(F.ws + B_K); const bf16* VT = (const bf16*)(F.ws + B_VT);
    const bf16* kl = KB + (size_t)(b * S) * 128 + kvh * 64; const bf16* vl = VT + (size_t)((b * 2 + kvh) * 64) * S;
    const bf16* kc = KB + (size_t)(NTOK + b * CTX) * 128 + kvh * 64; const bf16* vc = VT + (size_t)NTOK * 128 + (size_t)((b * 2 + kvh) * 64) * CTX;
    LAS unsigned char* L = F.lds;
    {
        v4u kr[6], vr[6];
#pragma unroll
        for (int j = 0; j < 6; ++j) { const int slot = wave * 6 + j, T = slot >> 2, part = slot & 3, kt = kb0 + 32 * T; const bool ok = kt >= 0 && kt < S;
            kr[j] = (v4u){0u, 0u, 0u, 0u}; vr[j] = kr[j];
            if (ok) { kr[j] = *(const GAS v4u*)(kl + (unsigned)((kt + 8 * part + (lane >> 3)) * 128 + (lane & 7) * 8)); vr[j] = *(const GAS v4u*)(vl + (unsigned)((16 * part + (lane >> 2)) * S + kt + (lane & 3) * 8)); } }
#pragma unroll
        for (int j = 0; j < 6; ++j) { const int slot = wave * 6 + j, T = slot >> 2, part = slot & 3, kq = 8 * part + (lane >> 3), d = 16 * part + (lane >> 2);
            *(LAS v4u*)(L + T * 4096 + kq * 128 + (((lane & 7) ^ ((kq >> 1) & 7)) * 16)) = kr[j];
            *(LAS v4u*)(L + ATT_V_OFF + T * 4096 + d * 64 + (((lane & 3) ^ ((d >> 2) & 3)) * 16)) = vr[j]; }
    }
    asm volatile("" ::: "memory");
    {
        v4u ckr[4];
#pragma unroll
        for (int j = 0; j < 4; ++j) { const int slot = wave * 4 + j, T = slot >> 2, part = slot & 3; ckr[j] = *(const GAS v4u*)(kc + (unsigned)((32 * T + 8 * part + (lane >> 3)) * 128 + (lane & 7) * 8)); }
#pragma unroll
        for (int j = 0; j < 4; ++j) { const int slot = wave * 4 + j, T = slot >> 2, part = slot & 3, kq = 8 * part + (lane >> 3);
            *(LAS v4u*)(L + 98304 + T * 4096 + kq * 128 + (((lane & 7) ^ ((kq >> 1) & 7)) * 16)) = ckr[j]; }
    }
    asm volatile("" ::: "memory");
    bf16x8 qa[4], qb[4];
#pragma unroll
    for (int d0 = 0; d0 < 4; ++d0) { qa[d0] = *(const GAS bf16x8*)(Q + (size_t)(b * S + p0 + r32) * 512 + h0 * 64 + d0 * 16 + hi * 8); qb[d0] = *(const GAS bf16x8*)(Q + (size_t)(b * S + p0 + r32) * 512 + (h0 + 1) * 64 + d0 * 16 + hi * 8); }
    __syncthreads();
    f32x16 oa[2], ob[2]; oa[0] = f32x16{}; oa[1] = f32x16{}; ob[0] = f32x16{}; ob[1] = f32x16{};
    float ma = I.sink[l * NH + h0] * LOG2E, mb = I.sink[l * NH + h0 + 1] * LOG2E, la = hi == 0 ? 1.f : 0.f, lb = la;
#pragma unroll 1
    for (int i = 0; i < 9; ++i) {
        const int kt = p0 - 128 + 32 * i; if (kt < 0 || kt >= S) continue;
        const int T = qt + i; KFrag kf; VFrag vf;
        lds_frag_load(kf, vf, L + T * 4096, L + ATT_V_OFF + T * 4096, lane);
        const int mm = i == 0 ? 1 : (i == 8 ? 2 : 0);
        attn_tile(oa, ma, la, qa, kf, vf, mm, lane); __builtin_amdgcn_sched_barrier(0); attn_tile(ob, mb, lb, qb, kf, vf, mm, lane); __builtin_amdgcn_sched_barrier(0);
    }
    { v4u cvr[4];
#pragma unroll
      for (int j = 0; j < 4; ++j) { const int slot = wave * 4 + j, T = slot >> 2, part = slot & 3; cvr[j] = *(const GAS v4u*)(vc + (unsigned)((16 * part + (lane >> 2)) * CTX + 32 * T + (lane & 3) * 8)); }
      __syncthreads();
#pragma unroll
      for (int j = 0; j < 4; ++j) { const int slot = wave * 4 + j, T = slot >> 2, part = slot & 3, d = 16 * part + (lane >> 2);
        *(LAS v4u*)(L + T * 4096 + d * 64 + (((lane & 3) ^ ((d >> 2) & 3)) * 16)) = cvr[j]; } }
    __syncthreads();
#pragma unroll 1
    for (int T = 0; T < 8; ++T) { KFrag kf; VFrag vf; lds_frag_load(kf, vf, L + 98304 + T * 4096, L + T * 4096, lane);
        attn_tile(oa, ma, la, qa, kf, vf, 0, lane); __builtin_amdgcn_sched_barrier(0); attn_tile(ob, mb, lb, qb, kf, vf, 0, lane); __builtin_amdgcn_sched_barrier(0); }
    __syncthreads();
    bf16* O = (bf16*)(F.ws + B_ATT) + (size_t)(b * S + p0 + r32) * 512 + h0 * 64;
    { const float inv = 1.f / (la + xor32_f(la, lane));
#pragma unroll
      for (int db = 0; db < 2; ++db)
#pragma unroll
        for (int g4 = 0; g4 < 4; ++g4) { v2u w; w.x = cvt_pk_bf16(oa[db][4 * g4 + 0] * inv, oa[db][4 * g4 + 1] * inv); w.y = cvt_pk_bf16(oa[db][4 * g4 + 2] * inv, oa[db][4 * g4 + 3] * inv); *(GAS v2u*)(O + 32 * db + 8 * g4 + 4 * hi) = w; } }
    { const float inv = 1.f / (lb + xor32_f(lb, lane));
#pragma unroll
      for (int db = 0; db < 2; ++db)
#pragma unroll
        for (int g4 = 0; g4 < 4; ++g4) { v2u w; w.x = cvt_pk_bf16(ob[db][4 * g4 + 0] * inv, ob[db][4 * g4 + 1] * inv); w.y = cvt_pk_bf16(ob[db][4 * g4 + 2] * inv, ob[db][4 * g4 + 3] * inv); *(GAS v2u*)(O + 64 + 32 * db + 8 * g4 + 4 * hi) = w; } }
}
__device__ __forceinline__ void phase_attn_latent(Frame& F, const Inputs& I, int l) {
    __syncthreads();
    for (int v = F.vcu; v < 256; v += F.G) attn_wg_task(F, I, l, v);
}
__device__ __forceinline__ void phase_attn_ctx(Frame& F, const Inputs& I, int l, int first_wg) {
    const int wv = (F.vcu - first_wg) * NWAVES + F.wave;
    if (F.vcu < first_wg || wv >= 64) return;
    const int b = wv >> 5, h0 = ((wv >> 3) & 3) * 2, qt = wv & 7;
    attn_wave(F, NTOK + b * CTX + qt * 32, h0, b, -1, I.sink[l * NH + h0], I.sink[l * NH + h0 + 1]);
}
__device__ __forceinline__ f32x16 small_prod(const bf16* A, int lda, const bf16* Bt, int ldb, int kbeg, int ksteps, int lane) {
    const int r32 = lane & 31, hi = lane >> 5;
    const bf16* ap = A + (size_t)r32 * lda + kbeg + hi * 8; const bf16* bp = Bt + (size_t)r32 * ldb + kbeg + hi * 8;
    f32x16 acc = {};
#pragma unroll 1
    for (int k0 = 0; k0 < ksteps; k0 += 8) {
        bf16x8 af[8], bf_[8];
#pragma unroll
        for (int j = 0; j < 8; ++j) { af[j] = *(const GAS bf16x8*)(ap + (k0 + j) * 16); bf_[j] = *(const GAS bf16x8*)(bp + (k0 + j) * 16); }
#pragma unroll
        for (int j = 0; j < 8; ++j) acc = __builtin_amdgcn_mfma_f32_32x32x16_bf16(af[j], bf_[j], acc, 0, 0, 0);
    }
    return acc;
}
__device__ __forceinline__ void ctx_small_gemm(Frame& F, const Inputs& I, int kind) {
    if (F.vcu >= 256) return;
    const int tm = F.vcu >> 4, tn = F.vcu & 15, nb = F.wave & 1, kq = F.wave >> 1, lane = F.lane, r32 = lane & 31, hi = lane >> 5;
    const int row0 = NTOK + 32 * tm, col0 = 64 * tn + 32 * nb;
    LAS float* red = (LAS float*)(F.lds);
    f32x16 p1, p2 = {};
    if (kind == 0) {
        p1 = small_prod((const bf16*)(F.ws + B_ATT) + (size_t)row0 * 512, 512, (const bf16*)(F.ws + W_BRA) + (size_t)col0 * 512, 512, kq * 128, 8, lane);
        p2 = small_prod((const bf16*)(F.ws + B_SG) + (size_t)row0 * 512, 512, (const bf16*)(F.ws + W_BRS) + (size_t)col0 * 512, 512, kq * 128, 8, lane);
    } else p1 = small_prod((const bf16*)(F.ws + B_MB) + (size_t)row0 * D, D, (const bf16*)(F.ws + W_OUT) + (size_t)col0 * D, D, kq * 256, 16, lane);
    __syncthreads();
#pragma unroll
    for (int r = 0; r < 16; ++r) { red[((0 * 8 + F.wave) * 16 + r) * 64 + lane] = p1[r]; if (kind == 0) red[((1 * 8 + F.wave) * 16 + r) * 64 + lane] = p2[r]; }
    __syncthreads();
    if (F.wave < 2) {
        const int col = col0 + r32;
#pragma unroll
        for (int r = 0; r < 16; ++r) {
            const int row = row0 + (r & 3) + 8 * (r >> 2) + 4 * hi;
            float s1 = 0.f, s2 = 0.f;
#pragma unroll
            for (int q = 0; q < 4; ++q) { s1 += red[((0 * 8 + 2 * q + nb) * 16 + r) * 64 + lane]; if (kind == 0) s2 += red[((1 * 8 + 2 * q + nb) * 16 + r) * 64 + lane]; }
            if (kind == 0) {
                const float ga = bf_lo((unsigned)((const bf16*)(F.ws + B_GA))[(size_t)row * D + col]), gs = bf_lo((unsigned)((const bf16*)(F.ws + B_GS))[(size_t)row * D + col]);
                __hip_atomic_store((GAS unsigned short*)((bf16*)(F.ws + B_MB) + (size_t)row * D + col), (unsigned short)f2bf_rne(ga * s1 + gs * s2), __ATOMIC_RELAXED, __HIP_MEMORY_SCOPE_AGENT);
            } else {
                const float gate = ((const float*)(F.ws + SM_MOD))[(0 * 3 + 2) * 6144 + 2 * D + col];
                ((float*)(F.ws + WS_XC))[(size_t)row * D + col] = I.ctx[(size_t)(row - NTOK) * D + col] + gate * s1;
            }
        }
        if (kind == 0) { asm volatile("s_waitcnt vmcnt(0)" ::: "memory"); if (lane == 0) __hip_atomic_fetch_add((gu32*)(F.ws + WS_CTL) + 49152 + 64 * (0 * 160 + 130 + tm), 1u, RLX_AGENT); }
    }
    __syncthreads();
}
#define CH_LD(dst, ptr, off) if (!(dry & 2)) asm volatile("global_load_dwordx4 %0, %1, off offset:%2" : "=v"(dst) : "v"(ptr), "n"(off) : "memory")
#define CH_WAIT(n, g) asm volatile("s_waitcnt vmcnt(" #n ")" : "+v"(g[0][0]), "+v"(g[0][1]), "+v"(g[1][0]), "+v"(g[1][1]) :: "memory")
#define CH_FILL(s, P, off) do { CH_LD(Bq[s][P][0][0], pb[2 * (P)], (off)); CH_LD(Bq[s][P][0][1], pb[2 * (P)], (off) + 1024); CH_LD(Bq[s][P][1][0], pb[2 * (P) + 1], (off)); CH_LD(Bq[s][P][1][1], pb[2 * (P) + 1], (off) + 1024); } while (0)
template <int MT, int KS>
__device__ __forceinline__ void chain_mma(f32x4 (&acc)[MT][4], const LAS unsigned char* A, const unsigned (&rb)[MT], const unsigned (&rs)[MT], const int kq, const char* wl  , const int tn0  , const int dry = 0) {
    bf16x8 Bq[2][2][2][2];
    const char* pb[4];
#pragma unroll
    for (int nt = 0; nt < 4; ++nt) pb[nt] = wl + (size_t)(tn0 + nt) * (KS * 2) * 1024;
    CH_FILL(0, 0, 0); CH_FILL(0, 1, 0); CH_FILL(1, 0, 2048); CH_FILL(1, 1, 2048);
#pragma unroll
    for (int nt = 0; nt < 4; ++nt) pb[nt] += 4096;
#define CH_HALF(s, P, W, REFILL) do { CH_WAIT(W, Bq[s][P]); \
        _Pragma("unroll") for (int j = 0; j < 2; ++j) _Pragma("unroll") for (int h = 0; h < 2; ++h) _Pragma("unroll") for (int mt = 0; mt < MT; ++mt) \
            acc[mt][2 * (P) + j] = __builtin_amdgcn_mfma_f32_16x16x32_bf16(Bq[s][P][j][h], Af[h][mt], acc[mt][2 * (P) + j], 0, 0, 0); \
        if (REFILL) CH_FILL(s, P, (s) * 2048); } while (0)
#define CH_STEP(s, k, W0, W1, REFILL) do { bf16x8 Af[2][MT]; \
        _Pragma("unroll") for (int h = 0; h < 2; ++h) _Pragma("unroll") for (int mt = 0; mt < MT; ++mt) Af[h][mt] = *(const LAS bf16x8*)(A + rb[mt] + ((unsigned)(((k) * 8 + h * 4 + kq) ^ rs[mt]) << 4)); \
        CH_HALF(s, 0, W0, REFILL); CH_HALF(s, 1, W1, REFILL); } while (0)
#pragma unroll 1
    for (int k0 = 0; k0 < KS - 2; k0 += 2) {
        CH_STEP(0, k0, 12, 12, true); CH_STEP(1, k0 + 1, 12, 12, true);
#pragma unroll
        for (int nt = 0; nt < 4; ++nt) pb[nt] += 4096;
    }
    CH_STEP(0, KS - 2, 12, 8, false); CH_STEP(1, KS - 1, 4, 0, false);
#undef CH_STEP
#undef CH_HALF
}
__device__ __forceinline__ f32x4 unpack4(const v2u w) { return (f32x4){bf_lo(w.x), bf_hi(w.x), bf_lo(w.y), bf_hi(w.y)}; }
__device__ __forceinline__ v2u pack4(const f32x4& a) { v2u w; w.x = cvt_pk_bf16(a.x, a.y); w.y = cvt_pk_bf16(a.z, a.w); return w; }

__device__ __forceinline__ f32x4 ch_perm(const f32x4& v, int idx4) {
    f32x4 o; o.x = __int_as_float(__builtin_amdgcn_ds_bpermute(idx4, __float_as_int(v.x))); o.y = __int_as_float(__builtin_amdgcn_ds_bpermute(idx4, __float_as_int(v.y)));
    o.z = __int_as_float(__builtin_amdgcn_ds_bpermute(idx4, __float_as_int(v.z))); o.w = __int_as_float(__builtin_amdgcn_ds_bpermute(idx4, __float_as_int(v.w))); return o; }
template <int MT, int DRY = 0>
__device__ __forceinline__ void phase_chain(Frame& F, const Inputs& I, int l) {
    constexpr int dry = DRY;
    constexpr int RP = MT == 5 ? 66 : 64;
    const int w = F.wave, r0 = RP * F.vcu;
    LAS unsigned char* lds = F.lds;
    unsigned char* ws = F.ws;
#define CH_LANE(PITCH) const int ln_ = lane_now(), i = ln_ & 15, q = ln_ >> 4; unsigned rb[MT], rs[MT]; bool ok[MT]; \
    _Pragma("unroll") for (int mt = 0; mt < MT; ++mt) { const int r = 16 * mt + i, rc = r < RP ? r : RP - 1; ok[mt] = r < RP; rb[mt] = (unsigned)rc * (PITCH); rs[mt] = (unsigned)(rc & 15); }
#define CH_ZERO() do { _Pragma("unroll") for (int mt = 0; mt < MT; ++mt) _Pragma("unroll") for (int nt = 0; nt < 4; ++nt) acc[mt][nt] = (f32x4){0.f, 0.f, 0.f, 0.f}; } while (0)
    {
        const bf16* Zg = (const bf16*)(ws + B_Z) + (size_t)r0 * 512; const bf16* Ag = (const bf16*)(ws + B_ATT) + (size_t)r0 * 512;
#pragma unroll 1
        for (int idx = w * 64 + lane_now(); idx < RP * 64; idx += 512) { const int row = idx >> 6, ch = idx & 63;
            const v4u z = *(const GAS v4u*)(Zg + (size_t)row * 512 + ch * 8), a = *(const GAS v4u*)(Ag + (size_t)row * 512 + ch * 8);
            const unsigned o = (unsigned)(row * 1024 + ((ch ^ (row & 15)) << 4));
            *(LAS v4u*)(lds + o) = z; *(LAS v4u*)(lds + RP * 1024 + o) = a; }
    }
    __syncthreads();
    f32x4 acc[MT][4];
    {
        CH_LANE(1024u);
        CH_ZERO();
        chain_mma<MT, 8>(acc, lds, rb, rs, q, (const char*)(ws + W_GLU) + ln_ * 16, 4 * w, dry);
        __syncthreads();
#pragma unroll
        for (int mt = 0; mt < MT; ++mt)
#pragma unroll
            for (int nt = 0; nt < 4; ++nt) if (ok[mt]) {
                const int c = 64 * w + 16 * nt + 4 * q; LAS v2u* p = (LAS v2u*)(lds + rb[mt] + ((unsigned)((c >> 3) ^ rs[mt]) << 4) + (c & 7) * 2);
                const f32x4 z = unpack4(*p), a = acc[mt][nt];
                *p = pack4((f32x4){z.x * sigmoid_f(a.x), z.y * sigmoid_f(a.y), z.z * sigmoid_f(a.z), z.w * sigmoid_f(a.w)});
            }
    }
    __syncthreads();
#ifndef CH_STAG_BR
#define CH_STAG_BR 0
#endif
#ifndef CH_STAG_OUT
#define CH_STAG_OUT 0
#endif
    if (CH_STAG_BR > 0 && w >= 4) __builtin_amdgcn_s_sleep(CH_STAG_BR);
#pragma unroll 1
    for (int p = 0; p < 2; ++p) {
        const int cb = 512 * p + 64 * w;
        CH_LANE(1024u);
        CH_ZERO();
        chain_mma<MT, 8>(acc, lds + RP * 1024, rb, rs, q, (const char*)(ws + W_BRA) + ln_ * 16, cb >> 4, dry);
        __builtin_amdgcn_sched_barrier(0);
        {
            const int sr = ln_ >> 2, sa = ln_ & 3, inv4 = (4 * (ln_ & 15) + (ln_ >> 4)) << 2;
            v2u gaq[2][4], gsq[2][4];
#define CH_E1_LOAD(mt_) do { const int R_ = 16 * (mt_) + sr, rc_ = (MT == 4 || R_ < RP) ? R_ : RP - 1; const size_t ro_ = (size_t)(r0 + rc_) * D + cb + 4 * sa; \
                _Pragma("unroll") for (int nt = 0; nt < 4; ++nt) { gaq[(mt_) & 1][nt] = (dry & 1) ? (v2u){0x3f803f80u, 0x3f803f80u} : *(const GAS v2u*)((const bf16*)(ws + B_GA) + ro_ + 16 * nt); \
                    gsq[(mt_) & 1][nt] = (dry & 1) ? (v2u){0x3f803f80u, 0x3f803f80u} : *(const GAS v2u*)((const bf16*)(ws + B_GS) + ro_ + 16 * nt); } } while (0)
            CH_E1_LOAD(0);
#pragma unroll
            for (int mt = 0; mt < MT; ++mt) {
                if (mt + 1 < MT) CH_E1_LOAD(mt + 1);
#pragma unroll
                for (int nt = 0; nt < 4; ++nt) { const f32x4 ga = unpack4(gaq[mt & 1][nt]), gs = unpack4(gsq[mt & 1][nt]);
                    f32x4 rt; rt.x = ga.x * __builtin_amdgcn_rcpf(fmaxf(gs.x, 0x1p-100f)); rt.y = ga.y * __builtin_amdgcn_rcpf(fmaxf(gs.y, 0x1p-100f));
                    rt.z = ga.z * __builtin_amdgcn_rcpf(fmaxf(gs.z, 0x1p-100f)); rt.w = ga.w * __builtin_amdgcn_rcpf(fmaxf(gs.w, 0x1p-100f));
                    acc[mt][nt] = acc[mt][nt] * ch_perm(rt, inv4); } }
#undef CH_E1_LOAD
        }
        __builtin_amdgcn_sched_barrier(0);
        chain_mma<MT, 8>(acc, lds, rb, rs, q, (const char*)(ws + W_BRS) + ln_ * 16, cb >> 4, dry);
        int r0e = r0; asm volatile("" : "+s"(r0e));
        {
            const int sr = ln_ >> 2, sa = ln_ & 3, fwd4 = ((ln_ >> 2) + 16 * (ln_ & 3)) << 2;
            v2u gsq[2][4];
#define CH_E2_LOAD(mt_) do { const int R_ = 16 * (mt_) + sr, rc_ = (MT == 4 || R_ < RP) ? R_ : RP - 1; const size_t ro_ = (size_t)(r0e + rc_) * D + cb + 4 * sa; \
                _Pragma("unroll") for (int nt = 0; nt < 4; ++nt) gsq[(mt_) & 1][nt] = (dry & 1) ? (v2u){0x3f803f80u, 0x3f803f80u} : *(const GAS v2u*)((const bf16*)(ws + B_GS) + ro_ + 16 * nt); } while (0)
            CH_E2_LOAD(0);
#pragma unroll
            for (int mt = 0; mt < MT; ++mt) { const int R = 16 * mt + sr; const size_t ro = (size_t)(r0e + R) * D + cb + 4 * sa;
                if (mt + 1 < MT) CH_E2_LOAD(mt + 1);
#pragma unroll
                for (int nt = 0; nt < 4; ++nt) { const f32x4 a = ch_perm(acc[mt][nt], fwd4), gs = unpack4(gsq[mt & 1][nt]);
                    if ((MT == 4 || R < RP) && !(dry & 1))
                        *(GAS v2u*)((bf16*)(ws + B_MB) + ro + 16 * nt) = pack4((f32x4){a.x * fmaxf(gs.x, 0x1p-100f), a.y * fmaxf(gs.y, 0x1p-100f), a.z * fmaxf(gs.z, 0x1p-100f), a.w * fmaxf(gs.w, 0x1p-100f)}); } }
#undef CH_E2_LOAD
        }
    }
    asm volatile("s_waitcnt vmcnt(0)" ::: "memory");
    __syncthreads();
    {
        const bf16* Mg = (const bf16*)(ws + B_MB) + (size_t)r0 * D;
#pragma unroll 1
        for (int idx = w * 64 + lane_now(); idx < RP * 128; idx += 512) { const int row = idx >> 7, ch = idx & 127;
            *(LAS v4u*)(lds + row * 2048 + ((ch ^ (row & 15)) << 4)) = *(const GAS v4u*)(Mg + (size_t)row * D + ch * 8); }
    }
    __syncthreads();
    if (CH_STAG_OUT > 0 && w >= 4) __builtin_amdgcn_s_sleep(CH_STAG_OUT);
#pragma unroll 1
    for (int p = 0; p < 2; ++p) {
        const int cb = 512 * p + 64 * w;
        CH_LANE(2048u);
        CH_ZERO();
        chain_mma<MT, 16>(acc, lds, rb, rs, q, (const char*)(ws + W_OUT) + ln_ * 16, cb >> 4, dry);
        int r0e = r0; asm volatile("" : "+s"(r0e));
        {
            const int sr = ln_ >> 2, sa = ln_ & 3, fwd4 = ((ln_ >> 2) + 16 * (ln_ & 3)) << 2;
            f32x4 xq[2][4], gq[2][4];
#define CH_E3_LOAD(mt_) do { const int R_ = 16 * (mt_) + sr, rc_ = (MT == 4 || R_ < RP) ? R_ : RP - 1, r_ = r0e + rc_, ws_ = r_ < S ? 0 : r_ < NTOK ? 1 : 2; \
                const float* xin_ = (l == 0 ? (r_ < NTOK ? I.x + (size_t)r_ * D : I.ctx + (size_t)(r_ - NTOK) * D) : (const float*)(ws + WS_XC) + (size_t)r_ * D) + cb + 4 * sa; \
                const float* gate_ = (const float*)(ws + SM_MOD) + (l * 3 + ws_) * 6144 + 2 * D + cb + 4 * sa; \
                _Pragma("unroll") for (int nt = 0; nt < 4; ++nt) { xq[(mt_) & 1][nt] = (dry & 1) ? (f32x4){0.f, 0.f, 0.f, 0.f} : *(const GAS f32x4*)(xin_ + 16 * nt); gq[(mt_) & 1][nt] = (dry & 1) ? (f32x4){0.f, 0.f, 0.f, 0.f} : *(const GAS f32x4*)(gate_ + 16 * nt); } } while (0)
            CH_E3_LOAD(0);
#pragma unroll
            for (int mt = 0; mt < MT; ++mt) { const int R = 16 * mt + sr, r = r0e + R;
                float* xo = (float*)(ws + WS_XC) + (size_t)r * D + cb + 4 * sa;
                if (mt + 1 < MT) CH_E3_LOAD(mt + 1);
#pragma unroll
                for (int nt = 0; nt < 4; ++nt) { const f32x4 a = ch_perm(acc[mt][nt], fwd4);
                    if ((MT == 4 || R < RP) && !(dry & 1)) *(GAS f32x4*)(xo + 16 * nt) = xq[mt & 1][nt] + gq[mt & 1][nt] * a; } }
#undef CH_E3_LOAD
        }
    }
#undef CH_ZERO
#undef CH_LANE
    __syncthreads();
}
using pg8::Unit;
#ifndef GEMM_ALIGN
#define GEMM_ALIGN true
#endif
#ifndef MOE_FUSED
#define MOE_FUSED 1
#endif
#ifndef E2_FUSED
#define E2_FUSED 0
#endif
#ifndef S1_IN_G1
#define S1_IN_G1 1
#endif
constexpr int CW_U = 94208;
#ifndef MOE_GATHER
#define MOE_GATHER 1
#endif
#ifndef CHAIN
#define CHAIN 1
#endif
#ifndef CARRY_IN_G1
#define CARRY_IN_G1 0
#endif
#ifndef S3_IN_AT
#define S3_IN_AT 1
#endif
#ifndef S2_FUSED
#define S2_FUSED 1
#endif
constexpr int CW_S1 = 90112;
#ifndef GEMM_SP2
#define GEMM_SP2 true
#endif
__device__ __forceinline__ v4u pack8(const f32x4& a, const f32x4& b) { v4u w; w.x = cvt_pk_bf16(a.x, a.y); w.y = cvt_pk_bf16(a.z, a.w); w.z = cvt_pk_bf16(b.x, b.y); w.w = cvt_pk_bf16(b.z, b.w); return w; }
__device__ __forceinline__ void unpack8(const v4u w, f32x4& a, f32x4& b) { a = (f32x4){bf_lo(w.x), bf_hi(w.x), bf_lo(w.y), bf_hi(w.y)}; b = (f32x4){bf_lo(w.z), bf_hi(w.z), bf_lo(w.w), bf_hi(w.w)}; }
__device__ __forceinline__ f32x4 sig4(const f32x4& v) { return (f32x4){sigmoid_f(v.x), sigmoid_f(v.y), sigmoid_f(v.z), sigmoid_f(v.w)}; }
__device__ __forceinline__ f32x4 gelu4(const f32x4& v) { return (f32x4){gelu_tanh_f(v.x), gelu_tanh_f(v.y), gelu_tanh_f(v.z), gelu_tanh_f(v.w)}; }

enum GemmKind { GK_INPROJ = 0, GK_S1, GK_S3, GK_GLU, GK_BR, GK_OUT, GK_MU, GK_MD, GK_MOE, GK_E2A, GK_E2B };
constexpr int CW_E2 = 49152;
__device__ __forceinline__ void store16_wt(unsigned char* ws, size_t byte_off, const v4u w) {
    const __amdgpu_buffer_rsrc_t rs = __builtin_amdgcn_make_buffer_rsrc(ws, 0, (int)WS_END, 0x00020000);
    __builtin_amdgcn_raw_buffer_store_b128(w, rs, (int)byte_off, 0, 16); }
__device__ __forceinline__ void wg_wait_count(unsigned char* ws, int word, unsigned need, int wv) {
    if (wv == 0) { gu32* w = (gu32*)(ws + WS_CTL) + word; unsigned sp = 0;
        while ((unsigned)__builtin_amdgcn_readfirstlane((int)__hip_atomic_load(w, RLX_AGENT)) < need) { __builtin_amdgcn_s_sleep(2);
            if (++sp > (1u << 20)) { if (lane_now() == 0) __hip_atomic_store((gu32*)(ws + WS_CTL) + CW_TMO, 1u, RLX_AGENT); break; } }
        __builtin_amdgcn_fence(__ATOMIC_ACQUIRE, "agent"); asm volatile("s_waitcnt vmcnt(0)" ::: "memory"); }
    asm volatile("" ::: "memory"); __builtin_amdgcn_s_barrier(); asm volatile("" ::: "memory"); }
__device__ __forceinline__ void wave_arrive(unsigned char* ws, int word) { asm volatile("s_waitcnt vmcnt(0)" ::: "memory"); if (lane_now() == 0) __hip_atomic_fetch_add((gu32*)(ws + WS_CTL) + word, 1u, RLX_AGENT); }
constexpr int CW_RDY = 16384;
struct GemmDesc { int kind, layer, G, c, vc, nM, wv; const volatile LAS int* tpd; unsigned char* ws; const float* xlat; const float* xctx; };

template <int KIND> struct EpiAll {
    static constexpr bool PERM = true;
    GemmDesc d;
    typedef const f32x4 (&Acc)[2][2][4][2];
    __device__ __forceinline__ void inproj(Acc acc, const Unit& u, int wr, int wc, int fr, int fq) const {
        unsigned char* ws = d.ws;
        const int pn = u.pn, pm = u.pm, r0 = pm * 256 + wr * 64 + fr;
        const bool latent = pm < 64;
        if (pn <= 2) {
            const float* rope = (const float*)(ws + SM_ROPE);
            bf16* Q = (bf16*)(ws + B_Q); bf16* KB = (bf16*)(ws + B_K); bf16* VT = (bf16*)(ws + B_VT);
            const int jb = 8 * (fq & 1); const float sgn = fq < 2 ? -1.f : 1.f;
#pragma unroll
            for (int ai = 0; ai < 2; ++ai)
#pragma unroll
                for (int m = 0; m < 4; ++m) {
                    const int r = r0 + ai * 128 + m * 16;
                    f32x4 c0 = {1.f, 1.f, 1.f, 1.f}, c1 = c0, s0 = {0.f, 0.f, 0.f, 0.f}, s1 = s0;
                    if (latent) { const int s = r & 8191, pos = (wc & 1) ? (s & 63) : (s >> 6); const float* rp = rope + pos * 16 + jb;
                        c0 = *(const GAS f32x4*)rp; c1 = *(const GAS f32x4*)(rp + 4); s0 = *(const GAS f32x4*)(rp + 2048); s1 = *(const GAS f32x4*)(rp + 2052); }
#pragma unroll
                    for (int bj = 0; bj < 2; ++bj) {
                        f32x4 v0 = acc[ai][bj][m][0], v1 = acc[ai][bj][m][1];
                        if (pn == 2 && bj == 1) {
                            const int dd = 32 * (wc & 1) + 8 * fq, kvh = wc >> 1; bf16* vt; size_t pitch;
                            if (latent) { const int b = r >> 13, k_ = r & 8191, key = (k_ & ~12) | ((k_ & 4) << 1) | ((k_ & 8) >> 1); vt = VT + (size_t)((b * 2 + kvh) * 64 + dd) * S + key; pitch = S; }
                            else { const int rc = r - NTOK, b = rc >> 8, k_ = rc & 255, key = (k_ & ~12) | ((k_ & 4) << 1) | ((k_ & 8) >> 1); vt = VT + (size_t)NTOK * 128 + (size_t)((b * 2 + kvh) * 64 + dd) * CTX + key; pitch = CTX; }
                            vt[0] = (bf16)f2bf_rne(v0.x); vt[pitch] = (bf16)f2bf_rne(v0.y); vt[2 * pitch] = (bf16)f2bf_rne(v0.z); vt[3 * pitch] = (bf16)f2bf_rne(v0.w);
                            vt[4 * pitch] = (bf16)f2bf_rne(v1.x); vt[5 * pitch] = (bf16)f2bf_rne(v1.y); vt[6 * pitch] = (bf16)f2bf_rne(v1.z); vt[7 * pitch] = (bf16)f2bf_rne(v1.w);
                            continue;
                        }
                        if (latent) {
                            f32x4 p0, p1;
                            const int ln = fq * 16 + fr;
                            p0.x = xor32_f(v0.x, ln); p0.y = xor32_f(v0.y, ln); p0.z = xor32_f(v0.z, ln); p0.w = xor32_f(v0.w, ln);
                            p1.x = xor32_f(v1.x, ln); p1.y = xor32_f(v1.y, ln); p1.z = xor32_f(v1.z, ln); p1.w = xor32_f(v1.w, ln);
                            v0 = v0 * c0 + (p0 * s0) * sgn; v1 = v1 * c1 + (p1 * s1) * sgn;
                        }
                        if (pn < 2) { v0 = v0 * C2; v1 = v1 * C2; *(GAS v4u*)(Q + (size_t)r * 512 + pn * 256 + bj * 128 + wc * 32 + 8 * fq) = pack8(v0, v1); }
                        else *(GAS v4u*)(KB + (size_t)r * 128 + wc * 32 + 8 * fq) = pack8(v0, v1);
                    }
                }
        } else if (pn <= 4) {
            bf16* A3 = (bf16*)(ws + B_A3);
#pragma unroll
            for (int ai = 0; ai < 2; ++ai)
#pragma unroll
                for (int m = 0; m < 4; ++m) {
                    const int r = r0 + ai * 128 + m * 16, cidx = r >> 5, s = r & 31;
#pragma unroll
                    for (int bj = 0; bj < 2; ++bj) { const int c = 256 * (pn - 3) + 128 * bj + 32 * wc + 8 * fq, g = c >> 4, mp0 = c & 15;
#if S1_IN_G1
                        store16_wt(ws, B_A3 + ((size_t)(g * NCH + cidx) * 768 + s * 16 + mp0) * 2, pack8(acc[ai][bj][m][0], acc[ai][bj][m][1])); }
#else
                        *(GAS v4u*)(A3 + ((size_t)(g * NCH + cidx) * 768 + s * 16 + mp0)) = pack8(acc[ai][bj][m][0], acc[ai][bj][m][1]); }
#endif
                }
        } else {
            bf16* Gt = (bf16*)(ws + (pn <= 8 ? B_GA : B_GS)); const int cb = 256 * (pn <= 8 ? pn - 5 : pn - 9);
#pragma unroll
            for (int ai = 0; ai < 2; ++ai)
#pragma unroll
                for (int m = 0; m < 4; ++m) {
                    const int r = r0 + ai * 128 + m * 16;
#pragma unroll
                    for (int bj = 0; bj < 2; ++bj) *(GAS v4u*)(Gt + (size_t)r * D + cb + 128 * bj + 32 * wc + 8 * fq) = pack8(sig4(acc[ai][bj][m][0]), sig4(acc[ai][bj][m][1]));
                }
        }
    }
    __device__ __forceinline__ void operator()(Acc acc, const Unit& u, int wr, int wc, int fr, int fq) const {
        unsigned char* ws = d.ws;
        if constexpr (KIND == GK_INPROJ) {
            if (S1_IN_G1 && u.k2 == 1) {
                float* send = (float*)(ws + B_SEND) + (size_t)(u.aux * NCH + u.pm * 256 + wr * 64 + fr) * 256 + wc * 32 + 8 * fq;
#pragma unroll
                for (int ai = 0; ai < 2; ++ai)
#pragma unroll
                    for (int m = 0; m < 4; ++m)
#pragma unroll
                        for (int bj = 0; bj < 2; ++bj) { float* o = send + (size_t)(ai * 128 + m * 16) * 256 + bj * 128;
                            if (CARRY_IN_G1) { const size_t bo = (size_t)((unsigned char*)o - ws); store16_wt(ws, bo, __builtin_bit_cast(v4u, acc[ai][bj][m][0])); store16_wt(ws, bo + 16, __builtin_bit_cast(v4u, acc[ai][bj][m][1])); }
                            else { *(GAS f32x4*)o = acc[ai][bj][m][0]; *(GAS f32x4*)(o + 4) = acc[ai][bj][m][1]; } }
                return;
            }
            inproj(acc, u, wr, wc, fr, fq); return; }
        const int r0 = u.pm * 256 + wr * 64 + fr, c0 = u.pn * 256 + wc * 32 + 8 * fq;
        f32x4 og[2][2] = {};
        if constexpr (KIND == GK_OUT || KIND == GK_E2B) { const int w = u.pm < 64 ? (u.pm >> 5) : 2; const float* gate = (const float*)(ws + SM_MOD) + (d.layer * 3 + w) * 6144 + 2 * D + c0;
#pragma unroll
            for (int bj = 0; bj < 2; ++bj) { og[bj][0] = *(const GAS f32x4*)(gate + bj * 128); og[bj][1] = *(const GAS f32x4*)(gate + bj * 128 + 4); } }
#pragma unroll
        for (int aq = 0; aq < 4; ++aq) { const int ai = aq >> 1, mb = (aq & 1) * 2;
            v4u LA[4][2] = {}, LB[4][2] = {}; float LW[4] = {};
#pragma unroll
            for (int m = mb; m < mb + 2; ++m) {
                const int r = r0 + ai * 128 + m * 16;
                if constexpr (KIND == GK_MD) LW[m] = ((const float*)(ws + SM_RWS))[r];
                if constexpr (KIND == GK_MOE) { if (u.k2 == 1) LW[m] = MOE_GATHER ? ((const float*)(ws + B_LISTW))[u.aux * CAPL + (r - 256 * d.tpd[u.aux])] : ((const float*)(ws + SM_RWS))[r]; }
#pragma unroll
                for (int bj = 0; bj < 2; ++bj) { const int c = c0 + bj * 128;
                    if constexpr (KIND == GK_GLU) LA[m][bj] = *(const GAS v4u*)((const bf16*)(ws + B_Z) + (size_t)r * 512 + c);
                    if constexpr (KIND == GK_BR) { const size_t o = (size_t)r * D + c; if (u.aux == 0) LA[m][bj] = *(const GAS v4u*)((const bf16*)(ws + B_GA) + o); else { LA[m][bj] = *(const GAS v4u*)((const bf16*)(ws + B_GS) + o); LB[m][bj] = *(const GAS v4u*)((const bf16*)(ws + B_T1) + o); } }
                    if constexpr (KIND == GK_OUT || KIND == GK_E2B) { const float* xin = (r < NTOK ? d.xlat + (size_t)r * D : d.xctx + (size_t)(r - NTOK) * D) + c; LA[m][bj] = *(const GAS v4u*)xin; LB[m][bj] = *(const GAS v4u*)(xin + 4); }
                }
            }
#pragma unroll
            for (int m = mb; m < mb + 2; ++m) {
                const int r = r0 + ai * 128 + m * 16;
#pragma unroll
                for (int bj = 0; bj < 2; ++bj) {
                    const int c = c0 + bj * 128;
                    const f32x4 v0 = acc[ai][bj][m][0], v1 = acc[ai][bj][m][1];
                    switch (KIND) {
                    case GK_S1: {
                        const size_t o = B_SEND + ((size_t)(u.aux * NCH + r) * 256 + c) * 4;
#if S2_FUSED
                        store16_wt(ws, o, __builtin_bit_cast(v4u, v0)); store16_wt(ws, o + 16, __builtin_bit_cast(v4u, v1));
#else
                        *(GAS f32x4*)(ws + o) = v0; *(GAS f32x4*)(ws + o + 16) = v1;
#endif
                        } break;
                    case GK_S3: {
                        const int t = c >> 4, m0 = c & 15; *(GAS v4u*)((bf16*)(ws + B_Z) + (size_t)(r * 32 + t) * 512 + u.aux * 16 + m0) = pack8(gelu4(v0), gelu4(v1)); } break;
                    case GK_GLU: {
                        const size_t o = (size_t)r * 512 + c; f32x4 z0, z1; unpack8(LA[m][bj], z0, z1);
                        *(GAS v4u*)((bf16*)(ws + B_SG) + o) = pack8(z0 * sig4(v0), z1 * sig4(v1)); } break;
                    case GK_BR: {
                        const size_t o = (size_t)r * D + c;
                        if (u.aux == 0) { f32x4 g0, g1; unpack8(LA[m][bj], g0, g1); *(GAS v4u*)((bf16*)(ws + B_T1) + o) = pack8(g0 * v0, g1 * v1); }
                        else { f32x4 g0, g1, t0, t1; unpack8(LA[m][bj], g0, g1); unpack8(LB[m][bj], t0, t1);
                            *(GAS v4u*)((bf16*)(ws + B_MB) + o) = pack8(t0 + g0 * v0, t1 + g1 * v1); } } break;
                    case GK_E2B:
                    case GK_OUT: {
                        float* xo = (float*)(ws + WS_XC) + (size_t)r * D + c;
                        *(GAS f32x4*)xo = __builtin_bit_cast(f32x4, LA[m][bj]) + og[bj][0] * v0; *(GAS f32x4*)(xo + 4) = __builtin_bit_cast(f32x4, LB[m][bj]) + og[bj][1] * v1; } break;
                    case GK_MU: {
                        const f32x4 a = v0 * sig4(v0) * v1; v2u w; w.x = cvt_pk_bf16(a.x, a.y); w.y = cvt_pk_bf16(a.z, a.w);
                        *(GAS v2u*)((bf16*)(ws + B_ACT) + (size_t)r * DE + (c >> 1)) = w; } break;
                    case GK_E2A: {
                        if (u.aux == 0) { const size_t o = (size_t)r * 512 + c; f32x4 z0, z1; unpack8(*(const GAS v4u*)((const bf16*)(ws + B_Z) + o), z0, z1); store16_wt(ws, B_SG + o * 2, pack8(z0 * sig4(v0), z1 * sig4(v1))); }
                        else { const size_t o = (size_t)r * D + c;
                            if (u.aux == 1) { f32x4 g0, g1; unpack8(*(const GAS v4u*)((const bf16*)(ws + B_GA) + o), g0, g1); *(GAS v4u*)((bf16*)(ws + B_T1) + o) = pack8(g0 * v0, g1 * v1); }
                            else { f32x4 g0, g1, t0, t1; unpack8(*(const GAS v4u*)((const bf16*)(ws + B_GS) + o), g0, g1); unpack8(*(const GAS v4u*)((const bf16*)(ws + B_T1) + o), t0, t1); store16_wt(ws, B_MB + o * 2, pack8(t0 + g0 * v0, t1 + g1 * v1)); } } } break;
                    case GK_MOE: {
                        if (u.k2 == 0) { const f32x4 a = v0 * sig4(v0) * v1; const unsigned long long w = (unsigned long long)cvt_pk_bf16(a.x, a.y) | ((unsigned long long)cvt_pk_bf16(a.z, a.w) << 32);
                            __hip_atomic_store((GAS unsigned long long*)((bf16*)(ws + B_ACT) + (size_t)r * DE + (c >> 1)), w, __ATOMIC_RELAXED, __HIP_MEMORY_SCOPE_AGENT); }
                        else { const float w = LW[m]; *(GAS v4u*)((bf16*)(ws + B_YE) + (size_t)r * D + c) = pack8(v0 * w, v1 * w); } } break;
                    default: {
                        const float w = LW[m]; *(GAS v4u*)((bf16*)(ws + B_YE) + (size_t)r * D + c) = pack8(v0 * w, v1 * w); } break;
                    }
                }
            }
        }
    }
};
template <int KIND> struct SchedAll {
    static constexpr bool VARK = (KIND == GK_MOE) || (KIND == GK_INPROJ && S1_IN_G1);
    GemmDesc d; const volatile LAS int* tp;
    __device__ __forceinline__ int wave_index() const { return d.wv; }
    static constexpr bool GATHER = (KIND == GK_MOE) && MOE_GATHER;
    __device__ __forceinline__ int goff(const Unit& u, int rit) const { const int e = u.aux, slot = 256 * (u.pm - tp[e]) + rit; return slot < tp[NE + 1 + e] ? ((const int*)(d.ws + B_LIST))[e * CAPL + slot] : 0; }
    __device__ __forceinline__ void a_ready(const Unit& u) const {
        if constexpr (KIND == GK_INPROJ && S1_IN_G1) { if (u.k2 == 1) wg_wait_count(d.ws, CW_U + 64 * (d.layer * 8 + u.pm * 2 + (u.aux >> 4)), u.pm < 2 ? 256u : 16u, d.wv); }
        if constexpr (KIND == GK_S3 && S3_IN_AT && !CARRY_IN_G1) wg_wait_count(d.ws, CW_S1 + 64 * (d.layer * 32 + u.aux), 32u, d.wv);
        if constexpr (KIND == GK_E2A) { if (u.aux == 2) wg_wait_count(d.ws, CW_E2 + 64 * (d.layer * 160 + u.pm), 16u, d.wv); }
        if constexpr (KIND == GK_E2B) wg_wait_count(d.ws, CW_E2 + 64 * (d.layer * 160 + 66 + u.pm), 32u, d.wv);
        if constexpr (KIND == GK_MOE) {
            if (u.k2 == 1) {
                if (d.wv == 0) {
                    gu32* w = (gu32*)(d.ws + WS_CTL) + CW_RDY + 64 * (d.layer * 256 + u.pm); unsigned sp = 0;
                    while ((unsigned)__builtin_amdgcn_readfirstlane((int)__hip_atomic_load(w, RLX_AGENT)) < 32u) {
                        __builtin_amdgcn_s_sleep(2);
                        if (++sp > (1u << 20)) { if (lane_now() == 0) __hip_atomic_store((gu32*)(d.ws + WS_CTL) + CW_TMO, 1u, RLX_AGENT); break; } }
                    __builtin_amdgcn_fence(__ATOMIC_ACQUIRE, "agent");
                    asm volatile("s_waitcnt vmcnt(0)" ::: "memory");
                }
                asm volatile("" ::: "memory"); __builtin_amdgcn_s_barrier(); asm volatile("" ::: "memory");
            }
        }
    }
    __device__ __forceinline__ void done(const Unit& u) const {
        if constexpr (KIND == GK_INPROJ && S1_IN_G1 && CARRY_IN_G1) { if (u.k2 == 1) wave_arrive(d.ws, CW_S1 + 64 * (d.layer * 32 + u.aux)); }
        if constexpr (KIND == GK_INPROJ && S1_IN_G1) { if (u.k2 == 0 && (u.pn == 3 || u.pn == 4)) wave_arrive(d.ws, CW_U + 64 * (d.layer * 8 + (u.pm < 32 ? 0 : u.pm < 64 ? 1 : 2) * 2 + (u.pn - 3))); }
        if constexpr (KIND == GK_S1 && S2_FUSED) wave_arrive(d.ws, CW_S1 + 64 * (d.layer * 32 + u.aux));
        if constexpr (KIND == GK_E2A) { if (u.aux == 0) wave_arrive(d.ws, CW_E2 + 64 * (d.layer * 160 + u.pm)); else if (u.aux == 2) wave_arrive(d.ws, CW_E2 + 64 * (d.layer * 160 + 66 + u.pm)); }
        if constexpr (KIND == GK_MOE) {
            if (u.k2 == 0) {
                asm volatile("s_waitcnt vmcnt(0)" ::: "memory");
                if (lane_now() == 0) __hip_atomic_fetch_add((gu32*)(d.ws + WS_CTL) + CW_RDY + 64 * (d.layer * 256 + u.pm), 1u, RLX_AGENT);
            }
        }
    }
    __device__ __forceinline__ bool next(int i, Unit& u) const {
        unsigned char* ws = d.ws; int pm, pn, aux = 0; size_t ao, bo;
        switch (KIND) {
#if S1_IN_G1
        case GK_INPROJ: {
            const int nctx = d.layer == 0 ? 26 : 6, total = 64 * 13 + nctx, L = i * d.G + d.c;
            if (L >= total) { const int n1 = d.c < total ? (total - 1 - d.c) / d.G + 1 : 0, j = (i - n1) * d.G + (d.G - 1 - d.c); if (j >= NG * 3) return false;
                aux = j / 3; pm = j % 3; pn = 0;
                u.pm = pm; u.pn = pn; u.aux = aux; u.k2 = 1; u.A = (const char*)ws + B_A3 + (size_t)(aux * NCH + pm * 256) * 768 * 2; u.B = (const char*)ws + W_SE + (size_t)(aux * 256) * 512 * 2; return true; }
            if (L < nctx) { if (d.layer == 0) { pm = 64 + L / 13; pn = L % 13; } else { pm = 64 + L / 3; pn = 2 + L % 3; } }
            else pg8::tile_of(L - nctx, 64, 13, pm, pn);
            ao = WS_H + (size_t)pm * 256 * D * 2; bo = W_IN + (size_t)pn * 256 * D * 2; } break;
#else
        case GK_INPROJ: { const int L = i * d.G + d.c;
            if (L < 64 * 13) pg8::tile_of(L, 64, 13, pm, pn);
            else { const int k = L - 64 * 13; if (d.layer == 0) { if (k >= 26) return false; pm = 64 + k / 13; pn = k % 13; } else { if (k >= 6) return false; pm = 64 + k / 3; pn = 2 + k % 3; } }
            ao = WS_H + (size_t)pm * 256 * D * 2; bo = W_IN + (size_t)pn * 256 * D * 2; } break;
#endif
        case GK_S1: { const int L = i * d.G + (S2_FUSED ? (d.G - 1 - d.vc) : d.vc); if (L >= NG * 3) return false; aux = L / 3; pm = L % 3; pn = 0;
            ao = B_A3 + (size_t)(aux * NCH + pm * 256) * 768 * 2; bo = W_SE + (size_t)(aux * 256) * 512 * 2; } break;
#if S3_IN_AT
        case GK_S3: {
#if CARRY_IN_G1
            const int v = d.vc; if (i > 0 || v >= (d.layer == 0 ? 192 : 128)) return false;
            if (v < 128) { aux = v >> 2; pm = (v >> 1) & 1; pn = v & 1; } else { aux = (v - 128) >> 1; pm = 2; pn = v & 1; }
#else
            const int v = d.vc - 128; if (v < 0 || i > 1) return false;
            if (i == 0) { aux = v >> 2; pm = (v >> 1) & 1; pn = v & 1; } else { if (d.layer != 0 || v < 64) return false; aux = (v - 64) >> 1; pm = 2; pn = v & 1; }
#endif
#else
        case GK_S3: { const int L = i * d.G + d.vc; if (L >= NG * 6) return false; aux = L / 6; const int rem = L % 6; pm = rem >> 1; pn = rem & 1;
#endif
            ao = B_A3 + (size_t)(aux * NCH + pm * 256) * 768 * 2; bo = W_S3 + (size_t)(aux * 512 + pn * 256) * 768 * 2; } break;
        case GK_GLU: { const int L = i * d.G + d.c; if (L >= d.nM * 2) return false; pg8::tile_of(L, d.nM, 2, pm, pn);
            ao = B_Z + (size_t)pm * 256 * 512 * 2; bo = W_GLU + (size_t)pn * 256 * 512 * 2; } break;
        case GK_BR: { const int Lp = (i >> 1) * d.G + d.c; aux = i & 1; if (Lp >= d.nM * 4) return false; pg8::tile_of(Lp, d.nM, 4, pm, pn);
            ao = (aux ? B_SG : B_ATT) + (size_t)pm * 256 * 512 * 2; bo = (aux ? W_BRS : W_BRA) + (size_t)pn * 256 * 512 * 2; } break;
        case GK_OUT: { const int L = i * d.G + d.c; if (L >= d.nM * 4) return false; pg8::tile_of(L, d.nM, 4, pm, pn);
            ao = B_MB + (size_t)pm * 256 * D * 2; bo = W_OUT + (size_t)pn * 256 * D * 2; } break;
        case GK_E2A: {
            const int G = d.G, c = d.c, NGL = d.nM * 2, nglu = c < NGL ? (NGL - 1 - c) / G + 1 : 0;
            if (i < nglu) { const int L = i * G + c; pg8::tile_of(L, d.nM, 2, pm, pn); aux = 0; ao = B_Z + (size_t)pm * 256 * 512 * 2; bo = W_GLU + (size_t)pn * 256 * 512 * 2; }
            else { const int k = i - nglu, Lp = (k >> 1) * G + c; if (Lp >= 256) return false; aux = 1 + (k & 1); pg8::tile_of(Lp, 64, 4, pm, pn);
                ao = (aux == 2 ? B_SG : B_ATT) + (size_t)pm * 256 * 512 * 2; bo = (aux == 2 ? W_BRS : W_BRA) + (size_t)pn * 256 * 512 * 2; } } break;
        case GK_E2B: { const int L = i * d.G + d.c; if (L >= 256) return false; pg8::tile_of(L, 64, 4, pm, pn);
            ao = B_MB + (size_t)pm * 256 * D * 2; bo = W_OUT + (size_t)pn * 256 * D * 2; } break;
        case GK_MOE: {
            const int G = d.G, vc = d.vc, U = tp[NE] * 4, q = U / G, r = U % G, nmu = q + (vc < r ? 1 : 0);
            int L, k2;
            if (i < nmu) { L = i * G + vc; k2 = 0; }
            else { const int k = i - nmu; int first = 2 * (G - r); if (first > U) first = U; k2 = 1;
                if (vc >= r && k < 2) { L = k * (G - r) + (vc - r); if (L >= first) return false; }
                else { const int kb = vc >= r ? k - 2 : k; L = first + kb * G + vc; if (L >= U) return false; } }
            pm = L >> 2; pn = L & 3;
            int e = 0;
#pragma unroll 1
            for (int kk = 1; kk < NE; ++kk) if (tp[kk] <= pm) e = kk;
            aux = e;
            if (k2 == 0) { ao = MOE_GATHER ? WS_H : B_HS + (size_t)pm * 256 * D * 2; bo = W_GU + (size_t)e * 1024 * 1024 * 2 + (size_t)pn * 256 * D * 2; }
            else { ao = B_ACT + (size_t)pm * 256 * DE * 2; bo = W_DN + (size_t)e * 1024 * 512 * 2 + (size_t)pn * 256 * DE * 2; }
            u.pm = pm; u.pn = pn; u.aux = aux; u.k2 = k2; u.A = (const char*)ws + ao; u.B = (const char*)ws + bo; return true; }
        default: {
            const int L = i * d.G + d.vc, TT = tp[NE]; if (L >= TT * 4) return false; pm = L >> 2; pn = L & 3;
            int e = 0;
#pragma unroll 1
            for (int k = 1; k < NE; ++k) if (tp[k] <= pm) e = k;
            aux = e;
            if (KIND == GK_MU) { ao = B_HS + (size_t)pm * 256 * D * 2; bo = W_GU + (size_t)e * 1024 * 1024 * 2 + (size_t)pn * 256 * D * 2; }
            else { ao = B_ACT + (size_t)pm * 256 * DE * 2; bo = W_DN + (size_t)e * 1024 * 512 * 2 + (size_t)pn * 256 * DE * 2; } } break;
        }
        u.pm = pm; u.pn = pn; u.aux = aux; u.k2 = 0; u.A = (const char*)ws + ao; u.B = (const char*)ws + bo; return true;
    }
};

#ifndef PHMASK
#define PHMASK 0xFFFFFFFFu
#endif
#define PHON(b) (((PHMASK) >> (b)) & 1u)
struct Args { Inputs in; float* out; unsigned char* ws; int ph_lo, ph_hi; };
enum { T_P0 = 0, T_N1, T_G1, T_AT, T_S2, T_S3, T_GLU, T_BR, T_OUT, T_N2, T_MG, T_MU, T_MD, T_FINAL };
constexpr int PH_PER_LAYER = 12, PH_FINAL = 1 + 2 * PH_PER_LAYER, N_PHASES = PH_FINAL + 1;
__global__ void __launch_bounds__(NWAVES * 64, 2) mega_fwd(Args args) {
    extern __shared__ __attribute__((aligned(16))) unsigned char lds[];
    Frame F;
    F.lds = (LAS unsigned char*)lds;
    F.tid = threadIdx.x; F.lane = F.tid & 63; F.wave = __builtin_amdgcn_readfirstlane(F.tid >> 6);
    F.G = gridDim.x; { const int bx = blockIdx.x; F.vcu = (F.G % 8 == 0) ? (bx % 8) * (F.G / 8) + bx / 8 : bx; }
    F.ws = args.ws; F.ctl = (gu32*)(args.ws + WS_CTL); F.out = args.out;
    const Inputs& I = args.in;
    for (int u = F.tid; u < (LDS_BYTES - LDSCTL_OFF) / 4; u += NWAVES * 64) ((LAS unsigned*)(F.lds + LDSCTL_OFF))[u] = 0u;
    __syncthreads();
    const int lo = args.ph_lo & 0xff, hi = args.ph_hi, dbgf = args.ph_lo >> 8;
    XcdBarrier bar; bar.bar = (unsigned*)(F.ctl + CW_BAR); bar.x = 0; bar.st = nullptr;
    if (hi - lo > 1) bar = xcd_barrier_post((unsigned*)(F.ctl + CW_BAR), (volatile LAS unsigned*)(F.lds + L_BARST));
#ifdef TSTAMP
    if (blockIdx.x == 0 && threadIdx.x == 0) ((unsigned long long*)(F.ws + 131072))[0] = __builtin_amdgcn_s_memrealtime();
#endif
#pragma unroll 1
    for (int ph = lo; ph < hi; ++ph) {
        int t, l;
        { unsigned char* w_ = F.ws; gu32* c_ = F.ctl; float* o_ = F.out; LAS unsigned char* l_ = F.lds; int v_ = F.vcu, g_ = F.G;
          asm volatile("" : "+s"(w_), "+s"(c_), "+s"(o_), "+s"(l_), "+s"(v_), "+s"(g_)); F.ws = w_; F.ctl = c_; F.out = o_; F.lds = l_; F.vcu = v_; F.G = g_;
          int wv_ = F.wave; asm volatile("" : "+s"(wv_)); F.wave = wv_; F.lane = lane_now(); F.tid = wv_ * 64 + F.lane; }
        if (ph == 0) { t = T_P0; l = 0; } else if (ph == PH_FINAL) { t = T_FINAL; l = 1; } else { l = (ph - 1) / PH_PER_LAYER; t = (ph - 1) % PH_PER_LAYER + 1; }
        if (t == T_P0 || (t == T_N1 && l == 1)) {
            if (PHON(0) && !(dbgf & 1) && F.vcu < NG) ssmgen_job(F, I, l, F.vcu);
            if (t == T_P0 && !(dbgf & 4)) { if (PHON(1) && F.vcu >= NG && F.vcu < NG + 192) mod_item(F, I, F.vcu - NG); if (PHON(2)) p0_small(F, I); }
            if (PHON(3) && !(dbgf & 2)) convert_weights(F, I, l);
        }
        if (t == T_N1) { if (PHON(4)) phase_norm1(F, I, l); }
#if CHAIN
#ifdef PROBE_DRY
        else if (t == T_GLU) { if (PHON(11)) { if (l == 0) {
                    phase_chain<5, (PROBE_DRY)>(F, I, 0); phase_chain<5>(F, I, 0); } else phase_chain<4>(F, I, 1); } }
#else
        else if (t == T_GLU) { if (PHON(11)) { if (l == 0) phase_chain<5>(F, I, 0); else phase_chain<4>(F, I, 1); } }
#endif
        else if (t == T_BR || t == T_OUT) {}
#endif
        else if (t >= T_G1 && t <= T_MD && t != T_S2 && t != T_N2 && t != T_MG) {
            GemmDesc d; d.layer = l; d.G = F.G; d.c = (int)blockIdx.x; d.vc = F.vcu; d.nM = l == 0 ? 66 : 64; d.ws = F.ws; d.wv = F.wave; d.tpd = (const volatile LAS int*)(F.lds + L_MOETAB);
            d.xlat = l == 0 ? I.x : (const float*)(F.ws + WS_XC); d.xctx = l == 0 ? I.ctx : (const float*)(F.ws + WS_XC) + (size_t)NTOK * D;
#ifdef SUBSTAMP
#define SUBST(id) do { if (l == 0 && F.tid == 0 && (blockIdx.x == 0 || blockIdx.x == 255)) ((unsigned long long*)(F.ws + 131072 + 1024))[(blockIdx.x == 0 ? 0 : 16) + (id)] = __builtin_amdgcn_s_memrealtime(); } while (0)
#else
#define SUBST(id) do {} while (0)
#endif
            if (t == T_MU || (t == T_MD && !MOE_FUSED)) moe_tables(F, l);
            const volatile LAS int* tp = (const volatile LAS int*)(F.lds + L_MOETAB);
#define RUN_GEMM(KIND_, K_, LDA_, LDB_) do { d.kind = KIND_; SchedAll<KIND_> Sc{d, tp}; EpiAll<KIND_> E{d}; pg8::gemm_phase<EpiAll<KIND_>, SchedAll<KIND_>, GEMM_ALIGN, GEMM_SP2>(F.lds, K_, LDA_, LDB_, Sc, E); } while (0)
#define RUN_GEMM2 RUN_GEMM
            switch (t) {
#if S1_IN_G1
            case T_G1: if (PHON(5)) { d.kind = GK_INPROJ; SchedAll<GK_INPROJ> Sc{d, tp}; EpiAll<GK_INPROJ> E{d}; pg8::gemm_phase<EpiAll<GK_INPROJ>, SchedAll<GK_INPROJ>, GEMM_ALIGN, true>(F.lds, D, D, D, Sc, E, 512, 768, 512);
                    if (CARRY_IN_G1 && (int)blockIdx.x >= 128) { const int job = (int)blockIdx.x - 128; wg_wait_count(F.ws, CW_S1 + 64 * (l * 32 + (job >> 2)), 24u, F.wave); if (PHON(8)) phase_ssm_carry<false>(F, l, job); } } break;
            case T_AT: break;
            case T_S3: if (!S3_IN_AT && PHON(10)) RUN_GEMM(GK_S3, 768, 768, 768); break;
#else
            case T_G1: if (PHON(5)) RUN_GEMM(GK_INPROJ, D, D, D); break;
            case T_AT: SUBST(0); if (PHON(6)) RUN_GEMM(GK_S1, 512, 768, 512); SUBST(1); break;
#endif
#if !S1_IN_G1
            case T_S3: if (PHON(10)) RUN_GEMM(GK_S3, 768, 768, 768); break;
#endif
#if E2_FUSED
            case T_GLU: if (PHON(11)) { RUN_GEMM(GK_E2A, 512, 512, 512);
                    if (l == 0) { wg_wait_count(F.ws, CW_E2 + 64 * (0 * 160 + 64 + (F.vcu >> 7)), 16u, F.wave); ctx_small_gemm(F, I, 0); }
                    RUN_GEMM(GK_E2B, D, D, D);
                    if (l == 0) { wg_wait_count(F.ws, CW_E2 + 64 * (0 * 160 + 130 + (F.vcu >> 4)), 32u, F.wave); ctx_small_gemm(F, I, 1); } } break;
            case T_BR: case T_OUT: break;
#else
            case T_GLU: if (PHON(11)) RUN_GEMM(GK_GLU, 512, 512, 512); break;
            case T_BR: d.nM = 64; if (PHON(12)) RUN_GEMM(GK_BR, 512, 512, 512); if (l == 0) ctx_small_gemm(F, I, 0); break;
            case T_OUT: d.nM = 64; if (PHON(13)) RUN_GEMM(GK_OUT, D, D, D); if (l == 0) ctx_small_gemm(F, I, 1); break;
#endif
#if MOE_FUSED
            case T_MU: if (PHON(16)) { d.kind = GK_MOE; SchedAll<GK_MOE> Sc{d, tp}; EpiAll<GK_MOE> E{d}; pg8::gemm_phase<EpiAll<GK_MOE>, SchedAll<GK_MOE>, GEMM_ALIGN, true>(F.lds, D, D, D, Sc, E, DE, DE, DE); } break;
            default: break;
#else
            case T_MU: if (PHON(16)) RUN_GEMM(GK_MU, D, D, D); break;
            default: if (PHON(17)) RUN_GEMM(GK_MD, DE, DE, DE); break;
#endif
            }
#if S3_IN_AT
            if (t == T_AT) {
                if (!CARRY_IN_G1 && F.vcu < 128) { if (PHON(8)) phase_ssm_carry<true>(F, l); wave_arrive(F.ws, CW_S1 + 64 * (l * 32 + (F.vcu >> 2))); }
                if (PHON(7)) phase_attn_latent(F, I, l);
                if (PHON(9) && l == 0) phase_attn_ctx(F, I, l, 128);
                __syncthreads();
                if (PHON(10)) RUN_GEMM2(GK_S3, 768, 768, 768);
            }
#else
            if (t == T_AT && PHON(7)) phase_attn_latent(F, I, l);
            if (t == T_AT) SUBST(2);
#endif
#if S2_FUSED && !S3_IN_AT
            if (t == T_AT) { if (F.vcu < 128) { if (!S1_IN_G1) wg_wait_count(F.ws, CW_S1 + 64 * (l * 32 + (F.vcu >> 2)), 24u, F.wave); if (PHON(8)) phase_ssm_carry<false>(F, l); } if (PHON(9) && l == 0) phase_attn_ctx(F, I, l, 128); SUBST(3); }
#endif
        }
        else if (t == T_S2) {
#if !S2_FUSED
            if (PHON(8)) phase_ssm_carry<false>(F, l); if (PHON(9) && l == 0) phase_attn_ctx(F, I, l, 128);
#endif
        }
        else if (t == T_N2) { if (PHON(14)) phase_norm2_route(F, I, l, dbgf); }
        else if (t == T_MG) { if (!MOE_GATHER && PHON(15)) phase_gather(F, l); }
        else if (t == T_FINAL) { if (PHON(18)) phase_final(F, I); }
        if (ph + 1 < hi && !(MOE_FUSED && t == T_MD) && !(E2_FUSED && (t == T_BR || t == T_OUT)) && !(S2_FUSED && t == T_S2) && !(S3_IN_AT && t == T_S3) && !(CHAIN && (t == T_BR || t == T_OUT)) && !(MOE_GATHER && t == T_MG)) { bar.bar = (unsigned*)(F.ctl + CW_BAR); xcd_barrier(bar, F.wave * 64 + lane_now() == 0);
#ifdef DOUBLE_BAR
            xcd_barrier(bar, F.wave * 64 + lane_now() == 0); xcd_barrier(bar, F.wave * 64 + lane_now() == 0);
#endif
        }
#ifdef TSTAMP
        if (blockIdx.x == 0 && F.wave * 64 + lane_now() == 0) ((unsigned long long*)(F.ws + 131072))[1 + ph] = __builtin_amdgcn_s_memrealtime();
#endif
    }
#if defined(TSTAMP) && defined(TS_SPIN_SET)
    if (blockIdx.x == 0 && F.wave * 64 + lane_now() == 0) {
        const unsigned long long* ts = (const unsigned long long*)(F.ws + 131072); unsigned long long d = 0;
        for (int p = 0; p < N_PHASES; ++p) if (((unsigned long long)(TS_SPIN_SET) >> p) & 1ull) d += ts[1 + p] - ts[p];
#ifdef SUBSTAMP
        { const unsigned long long* t2 = (const unsigned long long*)(F.ws + 131072 + 1024); d += t2[SUB_B] - t2[SUB_A]; }
#endif
        const unsigned long long t0 = __builtin_amdgcn_s_memrealtime(), want = d * (TS_SPIN_K);
        while (__builtin_amdgcn_s_memrealtime() - t0 < want) __builtin_amdgcn_s_sleep(16);
    }
#endif
}

#ifdef DBG_STOP
__global__ void dbg_copy(const unsigned char* ws, float* out, size_t n) {
    for (size_t i = (size_t)blockIdx.x * blockDim.x + threadIdx.x; i < n; i += (size_t)gridDim.x * blockDim.x) {
        const size_t j = i % (size_t)(DBG_ELEMS);
#ifdef DBG_F32
        out[i] = ((const float*)(ws + (DBG_OFF)))[j];
#else
        out[i] = __uint_as_float((unsigned)((const unsigned short*)(ws + (DBG_OFF)))[j] << 16);
#endif
    }
}
#endif
#ifdef TSTAMP
__global__ void dbg_times(const unsigned char* ws, float* out, size_t n, unsigned set1, unsigned set2) {
    const unsigned long long* ts = (const unsigned long long*)(ws + 131072);
    unsigned long long s1 = 0, s2 = 0;
    for (int p = 0; p < N_PHASES; ++p) { const unsigned long long d = ts[1 + p] - ts[p]; if ((set1 >> p) & 1) s1 += d; if ((set2 >> p) & 1) s2 += d; }
    const float v1 = sqrtf((float)s1), v2 = (float)s2;
    for (size_t i = (size_t)blockIdx.x * blockDim.x + threadIdx.x; i < n; i += (size_t)gridDim.x * blockDim.x) out[i] = i == 0 ? v2 : v1;
}
#endif
#if defined(REP_SET) && defined(REP_FLUSH)
__global__ void dbg_flush(const float* p, size_t n, float* sink) {
    float a = 0.f;
    for (size_t i = (size_t)blockIdx.x * blockDim.x + threadIdx.x; i < n; i += (size_t)gridDim.x * blockDim.x) a += p[i];
    if (a == 12345.678f) sink[0] = a;
}
#endif
extern "C" void kernel_launch(void* const* d_in, const int* in_sizes, int n_in, void* d_out, int out_size, void* d_ws, size_t ws_size, hipStream_t stream) {
    static int grid = 0;
    if (grid == 0) {
        int dev = 0, cus = 0, per_cu = 0;
        if (n_in != 28 || out_size != NTOK * D || ws_size < WS_END) { grid = -1; return; }
        if (hipGetDevice(&dev) != hipSuccess || hipDeviceGetAttribute(&cus, hipDeviceAttributeMultiprocessorCount, dev) != hipSuccess) { grid = -1; return; }
        if (hipFuncSetAttribute((const void*)mega_fwd, hipFuncAttributeMaxDynamicSharedMemorySize, LDS_BYTES) != hipSuccess) { grid = -1; return; }
        if (hipOccupancyMaxActiveBlocksPerMultiprocessor(&per_cu, (const void*)mega_fwd, NWAVES * 64, LDS_BYTES) != hipSuccess || per_cu < 1) { (void)hipGetLastError(); grid = -1; return; }
        (void)hipGetLastError();
        grid = cus;
    }
    if (grid < 0) return;
    (void)hipMemsetAsync((char*)d_ws + WS_CTL, 0, CTL_ZERO_BYTES, stream);
    Args a{};
    const float** ip = (const float**)&a.in;
    for (int i = 0; i < 28; ++i) ip[i] = (const float*)d_in[i];
    a.out = (float*)d_out; a.ws = (unsigned char*)d_ws;
#ifdef DBG_STOP
    for (int p = 0; p <= (DBG_STOP); ++p) { a.ph_lo = p; a.ph_hi = p + 1; hipLaunchKernelGGL(mega_fwd, dim3(grid), dim3(NWAVES * 64), LDS_BYTES, stream, a); }
    hipLaunchKernelGGL(dbg_copy, dim3(2048), dim3(256), 0, stream, (const unsigned char*)d_ws, (float*)d_out, (size_t)out_size);
#elif defined(REP_SET)
#ifndef REP_FLAGS
#define REP_FLAGS 0
#endif
    for (int p = 0; p < N_PHASES; ++p) {
        const int n = (((unsigned long long)(REP_SET) >> p) & 1ull) ? 1 + (REP_N) : 1;
        for (int k = 0; k < n; ++k) {
            if (k > 0 && p == 0) (void)hipMemsetAsync((char*)d_ws + (CW_WORK) * 4, 0, 256, stream);
            if (k > 0 && (p == 9 || p == 21)) (void)hipMemsetAsync((char*)d_ws + (CW_CNT + 64 * (p == 21)) * 4, 0, 128, stream);
#ifdef REP_FLUSH
            if (n > 1 || (REP_FLUSH) == 2) for (int f_ = 24; f_ <= 26; ++f_) hipLaunchKernelGGL(dbg_flush, dim3(2048), dim3(256), 0, stream, (const float*)d_in[f_], (size_t)32 * 1024 * 1024, (float*)d_ws + 1000);
#endif
            a.ph_lo = p | (k > 0 ? ((REP_FLAGS) << 8) : 0); a.ph_hi = p + 1; hipLaunchKernelGGL(mega_fwd, dim3(grid), dim3(NWAVES * 64), LDS_BYTES, stream, a);
        }
    }
#elif MK_PER_PHASE
    for (int p = 0; p < N_PHASES; ++p) { a.ph_lo = p; a.ph_hi = p + 1; hipLaunchKernelGGL(mega_fwd, dim3(grid), dim3(NWAVES * 64), LDS_BYTES, stream, a); }
#else
    a.ph_lo = 0; a.ph_hi = N_PHASES;
    hipLaunchKernelGGL(mega_fwd, dim3(grid), dim3(NWAVES * 64), LDS_BYTES, stream, a);
#if defined(TSTAMP) && !defined(TS_SPIN_SET)
    hipLaunchKernelGGL(dbg_times, dim3(1024), dim3(256), 0, stream, (const unsigned char*)d_ws, (float*)d_out, (size_t)out_size, (unsigned)(TS_SET1), (unsigned)(TS_SET2));
#endif
#endif
}
```
